# Optimizing an MI355X kernel written in HIP

```python
import math
import jax
import jax.numpy as jnp
from jax import lax
import numpy as np

D_MODEL = 1024
BATCH = 1
SEQ = 16384
DEPTH = 2

GRID_W = 64
CTX_LEN = 256
N_EVEN = (DEPTH + 1) // 2
N_ODD = DEPTH // 2
D_S5 = D_MODEL // 2
S5_GROUP = 16
S5_GROUPS = D_S5 // S5_GROUP
S5_STATE = 64
DT_MIN = 0.001
DT_MAX = 0.1
D_POOL = D_MODEL - D_S5
POOL_WINDOWS = (2, 4, 8, 16)
POOL_GROUP = D_POOL // len(POOL_WINDOWS)
HEAD_DIM = 64
N_HEADS = D_MODEL // HEAD_DIM
N_KV_HEADS = N_HEADS // 4
KV_GROUP = N_HEADS // N_KV_HEADS
D_ATTN = N_HEADS * HEAD_DIM
D_KV = N_KV_HEADS * HEAD_DIM
ROPE_AXIS_DIM = HEAD_DIM // 2
ROPE_THETA = 10000.0
Q_BLOCK = 128
D_FF = 4 * D_MODEL
N_MOD = 6
EPS = 1e-6

kernel_name = "hybrid_s5_pool_gqa_dit_block"

F32 = jnp.float32


def rmsnorm(x, g):
    xf = x.astype(F32)
    y = xf * lax.rsqrt(jnp.mean(jnp.square(xf), axis=-1, keepdims=True) + EPS) * g.astype(F32)
    return y.astype(x.dtype)


def modulate(h, shift, scale):
    return h * (1.0 + scale) + shift


def sq_relu_mlp(h, w1, w2):
    return jnp.square(jax.nn.relu(h @ w1)) @ w2


def axial_rope_tables(row_ids, col_ids):
    inv_freq = ROPE_THETA ** (-jnp.arange(0, ROPE_AXIS_DIM, 2, dtype=F32) / ROPE_AXIS_DIM)
    ang_r = row_ids[:, None] * inv_freq[None, :]
    ang_c = col_ids[:, None] * inv_freq[None, :]
    return (jnp.cos(ang_r), jnp.sin(ang_r), jnp.cos(ang_c), jnp.sin(ang_c))


def rope_1d(x, cos, sin):
    half = x.shape[-1] // 2
    x1, x2 = x[..., :half], x[..., half:]
    cos = cos[None, :, None, :].astype(x.dtype)
    sin = sin[None, :, None, :].astype(x.dtype)
    return jnp.concatenate([x1 * cos - x2 * sin, x1 * sin + x2 * cos], axis=-1)


def apply_axial_rope(x, rope):
    xr = rope_1d(x[..., :ROPE_AXIS_DIM], rope[0], rope[1])
    xc = rope_1d(x[..., ROPE_AXIS_DIM:], rope[2], rope[3])
    return jnp.concatenate([xr, xc], axis=-1)


def s5_discretize(lam_re, lam_im, log_dt, b_re, b_im):
    lam_re = lam_re.astype(F32)
    lam_im = lam_im.astype(F32)
    dt = jnp.exp(log_dt.astype(F32))[:, None]
    mag = jnp.exp(lam_re * dt)
    a_re = mag * jnp.cos(lam_im * dt)
    a_im = mag * jnp.sin(lam_im * dt)
    den = lam_re * lam_re + lam_im * lam_im
    f_re = ((a_re - 1.0) * lam_re + a_im * lam_im) / den
    f_im = (a_im * lam_re - (a_re - 1.0) * lam_im) / den
    b_re = b_re.astype(F32)
    b_im = b_im.astype(F32)
    bb_re = f_re[..., None] * b_re - f_im[..., None] * b_im
    bb_im = f_re[..., None] * b_im + f_im[..., None] * b_re
    return a_re, a_im, bb_re, bb_im


def complex_affine_combine(e1, e2):
    a1r, a1i, b1r, b1i = e1
    a2r, a2i, b2r, b2i = e2
    return (a2r * a1r - a2i * a1i,
            a2r * a1i + a2i * a1r,
            a2r * b1r - a2i * b1i + b2r,
            a2r * b1i + a2i * b1r + b2i)


def diag_scan(a_re, a_im, b_re, b_im, s0_re, s0_im, reverse):
    first = -1 if reverse else 0
    b_re = b_re.at[:, first].add(a_re * s0_re - a_im * s0_im)
    b_im = b_im.at[:, first].add(a_re * s0_im + a_im * s0_re)
    A_re = jnp.broadcast_to(a_re, b_re.shape)
    A_im = jnp.broadcast_to(a_im, b_im.shape)
    _, _, h_re, h_im = lax.associative_scan(complex_affine_combine, (A_re, A_im, b_re, b_im),
                                            reverse=reverse, axis=1)
    last = 0 if reverse else -1
    return h_re, h_im, h_re[:, last], h_im[:, last]


def s5_readout(h_re, h_im, c_re, c_im):
    return (jnp.einsum('blgp,gcp->blgc', h_re, c_re.astype(F32))
            - jnp.einsum('blgp,gcp->blgc', h_im, c_im.astype(F32)))


def s5_mixer(u, uc, lam_re, lam_im, log_dt, b_re, b_im, c_re, c_im, d, glu_w, ctx_out):
    dtype = u.dtype
    bsz, n_lat = u.shape[:2]
    n_ctx = uc.shape[1]
    ug = u.astype(F32).reshape(bsz, n_lat, S5_GROUPS, S5_GROUP)
    ugc = uc.astype(F32).reshape(bsz, n_ctx, S5_GROUPS, S5_GROUP)
    dg = d.astype(F32).reshape(S5_GROUPS, S5_GROUP)
    y = ug * dg
    yc = ugc * dg
    zero = jnp.zeros((bsz, S5_GROUPS, S5_STATE), F32)
    for dr in range(2):
        rev = dr == 1
        a_re, a_im, bb_re, bb_im = s5_discretize(lam_re[dr], lam_im[dr], log_dt[dr], b_re[dr], b_im[dr])
        bc_re = jnp.einsum('blgc,gpc->blgp', ugc, bb_re)
        bc_im = jnp.einsum('blgc,gpc->blgp', ugc, bb_im)
        hc_re, hc_im, s_re, s_im = diag_scan(a_re, a_im, bc_re, bc_im, zero, zero, rev)
        bl_re = jnp.einsum('blgc,gpc->blgp', ug, bb_re)
        bl_im = jnp.einsum('blgc,gpc->blgp', ug, bb_im)
        hl_re, hl_im, _, _ = diag_scan(a_re, a_im, bl_re, bl_im, s_re, s_im, rev)
        y = y + s5_readout(hl_re, hl_im, c_re[dr], c_im[dr])
        if ctx_out:
            yc = yc + s5_readout(hc_re, hc_im, c_re[dr], c_im[dr])

    def glu(z):
        z = jax.nn.gelu(z)
        zz = z @ glu_w.astype(F32)
        return (zz[..., :D_S5] * jax.nn.sigmoid(zz[..., D_S5:])).astype(dtype)

    y_out = glu(y.reshape(bsz, n_lat, D_S5))
    yc_out = glu(yc.reshape(bsz, n_ctx, D_S5)) if ctx_out else None
    return y_out, yc_out


def centred_pool_residual(u, window):
    n = u.shape[1]
    lo = window // 2
    hi = window - 1 - lo
    csum = jnp.concatenate([jnp.zeros_like(u[:, :1]), jnp.cumsum(u, axis=1)], axis=1)
    t = jnp.arange(n)
    start = jnp.clip(t - lo, 0, n)
    end = jnp.clip(t + hi + 1, 0, n)
    count = (end - start).astype(u.dtype)
    mean = (jnp.take(csum, end, axis=1) - jnp.take(csum, start, axis=1)) / count[None, :, None]
    return mean - u


def pool_mixer(u, w, scale):
    dtype = u.dtype
    uf = u.astype(F32)
    outs = []
    for gi, window in enumerate(POOL_WINDOWS):
        seg = uf[..., gi * POOL_GROUP:(gi + 1) * POOL_GROUP]
        outs.append(centred_pool_residual(seg, window) @ w[gi].astype(F32))
    return (jnp.concatenate(outs, axis=-1) * scale.astype(F32)).astype(dtype)


def even_mixer(h, hc, w_in, w_out, lam_re, lam_im, log_dt, b_re, b_im, c_re, c_im, d, glu_w,
               pw, pscale, ctx_out):
    u = h @ w_in
    uc = hc @ w_in
    ya, yac = s5_mixer(u[..., :D_S5], uc[..., :D_S5], lam_re, lam_im, log_dt, b_re, b_im,
                       c_re, c_im, d, glu_w, ctx_out)
    yb = pool_mixer(u[..., D_S5:], pw, pscale)
    y = jnp.concatenate([ya, yb], axis=-1) @ w_out
    if ctx_out:
        ybc = pool_mixer(uc[..., D_S5:], pw, pscale)
        yc = jnp.concatenate([yac, ybc], axis=-1) @ w_out
    else:
        yc = None
    return y, yc


def gqa_attend(q, k, v):
    s = jnp.einsum('bqkgd,bskd->bkgqs', q, k, preferred_element_type=F32) * (HEAD_DIM ** -0.5)
    p = jax.nn.softmax(s, axis=-1).astype(v.dtype)
    return jnp.einsum('bkgqs,bskd->bqkgd', p, v)


def attention_mixer(h, hc, w_qkv, w_out, qn, kn, rope, ctx_out):
    bsz, n_lat = h.shape[:2]
    n_ctx = hc.shape[1]

    def project(z, n):
        qkv = z @ w_qkv
        q = rmsnorm(qkv[..., :D_ATTN].reshape(bsz, n, N_HEADS, HEAD_DIM), qn)
        k = rmsnorm(qkv[..., D_ATTN:D_ATTN + D_KV].reshape(bsz, n, N_KV_HEADS, HEAD_DIM), kn)
        v = qkv[..., D_ATTN + D_KV:].reshape(bsz, n, N_KV_HEADS, HEAD_DIM)
        return q, k, v

    q, k, v = project(h, n_lat)
    q = apply_axial_rope(q, rope)
    k = apply_axial_rope(k, rope)
    qc, kc, vc = project(hc, n_ctx)
    k_all = jnp.concatenate([kc, k], axis=1)
    v_all = jnp.concatenate([vc, v], axis=1)
    nb = n_lat // Q_BLOCK
    qb = jnp.moveaxis(q.reshape(bsz, nb, Q_BLOCK, N_KV_HEADS, KV_GROUP, HEAD_DIM), 1, 0)
    ob = lax.map(lambda qi: gqa_attend(qi, k_all, v_all), qb)
    y = jnp.moveaxis(ob, 0, 1).reshape(bsz, n_lat, D_ATTN) @ w_out
    if ctx_out:
        oc = gqa_attend(qc.reshape(bsz, n_ctx, N_KV_HEADS, KV_GROUP, HEAD_DIM), kc, vc)
        yc = oc.reshape(bsz, n_ctx, D_ATTN) @ w_out
    else:
        yc = None
    return y, yc


def setup_inputs(seed: int = 0) -> dict:
    key = jax.random.key(seed)
    ks = jax.random.split(key, 32)
    nrm = jax.random.normal
    G, P, GC = S5_GROUPS, S5_STATE, S5_GROUP
    return {
        "x": nrm(ks[0], (BATCH, SEQ, D_MODEL), F32),
        "c": nrm(ks[1], (BATCH, D_MODEL), F32),
        "ctx": nrm(ks[2], (BATCH, CTX_LEN, D_MODEL), F32),
        "c_ctx": nrm(ks[3], (D_MODEL,), F32),
        "ada_w": nrm(ks[4], (DEPTH, D_MODEL, N_MOD * D_MODEL), F32) * D_MODEL ** -0.5,
        "ada_b": nrm(ks[5], (DEPTH, N_MOD * D_MODEL), F32) * 0.01,
        "norm_g": 1.0 + 0.02 * nrm(ks[6], (DEPTH, 4, D_MODEL), F32),
        "mlp_w1": nrm(ks[7], (DEPTH, D_MODEL, D_FF), F32) * D_MODEL ** -0.5,
        "mlp_w2": nrm(ks[8], (DEPTH, D_FF, D_MODEL), F32) * D_FF ** -0.5,
        "mix_in_w": nrm(ks[9], (N_EVEN, D_MODEL, D_S5 + D_POOL), F32) * D_MODEL ** -0.5,
        "mix_out_w": nrm(ks[10], (N_EVEN, D_S5 + D_POOL, D_MODEL), F32) * (D_S5 + D_POOL) ** -0.5,
        "s5_lambda_re": -0.5 + 0.01 * nrm(ks[11], (N_EVEN, 2, G, P), F32),
        "s5_lambda_im": jnp.pi * jnp.arange(P, dtype=F32) + 0.01 * nrm(ks[12], (N_EVEN, 2, G, P), F32),
        "s5_log_dt": jax.random.uniform(ks[13], (N_EVEN, 2, G), F32, math.log(DT_MIN), math.log(DT_MAX)),
        "s5_b_re": nrm(ks[14], (N_EVEN, 2, G, P, GC), F32) * (2 * GC) ** -0.5,
        "s5_b_im": nrm(ks[15], (N_EVEN, 2, G, P, GC), F32) * (2 * GC) ** -0.5,
        "s5_c_re": nrm(ks[16], (N_EVEN, 2, G, GC, P), F32) * P ** -0.5,
        "s5_c_im": nrm(ks[17], (N_EVEN, 2, G, GC, P), F32) * P ** -0.5,
        "s5_d": nrm(ks[18], (N_EVEN, D_S5), F32),
        "s5_glu_w": nrm(ks[19], (N_EVEN, D_S5, 2 * D_S5), F32) * D_S5 ** -0.5,
        "pool_w": nrm(ks[20], (N_EVEN, len(POOL_WINDOWS), POOL_GROUP, POOL_GROUP), F32) * POOL_GROUP ** -0.5,
        "pool_scale": 1.0 + 0.1 * nrm(ks[21], (N_EVEN, D_POOL), F32),
        "attn_qkv_w": nrm(ks[22], (N_ODD, D_MODEL, D_ATTN + 2 * D_KV), F32) * D_MODEL ** -0.5,
        "attn_out_w": nrm(ks[23], (N_ODD, D_ATTN, D_MODEL), F32) * D_ATTN ** -0.5,
        "attn_q_norm": 1.0 + 0.02 * nrm(ks[24], (N_ODD, HEAD_DIM), F32),
        "attn_k_norm": 1.0 + 0.02 * nrm(ks[25], (N_ODD, HEAD_DIM), F32),
    }


def reference(x, c, ctx, c_ctx, ada_w, ada_b, norm_g, mlp_w1, mlp_w2, mix_in_w, mix_out_w,
              s5_lambda_re, s5_lambda_im, s5_log_dt, s5_b_re, s5_b_im, s5_c_re, s5_c_im, s5_d,
              s5_glu_w, pool_w, pool_scale, attn_qkv_w, attn_out_w, attn_q_norm, attn_k_norm):
    n_lat = x.shape[1]
    rows = n_lat // GRID_W
    row_ids = jnp.repeat(jnp.arange(rows), GRID_W).astype(F32)
    col_ids = jnp.tile(jnp.arange(GRID_W), rows).astype(F32)
    rope = axial_rope_tables(row_ids, col_ids)
    xc = ctx
    for l in range(DEPTH):
        last = l == DEPTH - 1
        ctx_out = not last
        mod = jax.nn.silu(c) @ ada_w[l] + ada_b[l]
        modc = jax.nn.silu(c_ctx) @ ada_w[l] + ada_b[l]
        sh_m, sc_m, g_m, sh_f, sc_f, g_f = jnp.split(mod[:, None, :], N_MOD, axis=-1)
        csh_m, csc_m, cg_m, csh_f, csc_f, cg_f = jnp.split(modc, N_MOD, axis=-1)
        h = modulate(rmsnorm(x, norm_g[l, 0]), sh_m, sc_m)
        hc = modulate(rmsnorm(xc, norm_g[l, 0]), csh_m, csc_m)
        if l % 2 == 0:
            e = l // 2
            y, yc = even_mixer(h, hc, mix_in_w[e], mix_out_w[e], s5_lambda_re[e], s5_lambda_im[e],
                               s5_log_dt[e], s5_b_re[e], s5_b_im[e], s5_c_re[e], s5_c_im[e], s5_d[e],
                               s5_glu_w[e], pool_w[e], pool_scale[e], ctx_out)
        else:
            o = l // 2
            y, yc = attention_mixer(h, hc, attn_qkv_w[o], attn_out_w[o], attn_q_norm[o],
                                    attn_k_norm[o], rope, ctx_out)
        x = x + g_m * rmsnorm(y, norm_g[l, 1])
        hf = modulate(rmsnorm(x, norm_g[l, 2]), sh_f, sc_f)
        x = x + g_f * rmsnorm(sq_relu_mlp(hf, mlp_w1[l], mlp_w2[l]), norm_g[l, 3])
        if ctx_out:
            xc = xc + cg_m * rmsnorm(yc, norm_g[l, 1])
            hfc = modulate(rmsnorm(xc, norm_g[l, 2]), csh_f, csc_f)
            xc = xc + cg_f * rmsnorm(sq_relu_mlp(hfc, mlp_w1[l], mlp_w2[l]), norm_g[l, 3])
    return x
```

```cpp
#include <hip/hip_runtime.h>
#include <hip/hip_cooperative_groups.h>
#include <cstdio>
#include <cstdint>
namespace cg = cooperative_groups;
namespace pg8 {
#define PG8_LAS __attribute__((address_space(3)))
typedef unsigned short bf16_t;
typedef short bf16x8 __attribute__((ext_vector_type(8)));
typedef float f32x4 __attribute__((ext_vector_type(4)));
typedef unsigned u32x4 __attribute__((ext_vector_type(4)));
constexpr int BM = 256, BK = 64, HALF = 128, HTB = HALF * BK * 2  , STAGE_BYTES = 8 * HTB, NXCD = 8, WGM = 8;

__host__ __device__ __forceinline__ int lds_byte(int r, int c) { const int st = (r >> 4) * 2 + (c >> 5), rr = r & 15, cc = c & 31, ob = rr * 64 + cc * 2; return st * 1024 + (ob ^ (((ob >> 9) & 1) << 5)); }
__host__ __device__ __forceinline__ void stage_rc(int b, int& R, int& C) { const int st = b / 1024, sb = b % 1024, swz = sb ^ (((sb >> 9) & 1) << 5); R = (st >> 1) * 16 + swz / 64; C = (st & 1) * 32 + (swz % 64) / 2; }
__host__ __device__ __forceinline__ int perm32(int rho) { const int n = rho >> 4, i = rho & 15; return 8 * (i >> 2) + 4 * n + (i & 3); }

struct Unit { int pm, pn; };
struct Gemm { const bf16_t* A; const bf16_t* Bt; int M, N, K; };

struct StaticOrder {
    int nM, nN, nwg, G, c;
    __host__ __device__ void init(int M, int N, int G_, int c_) { nM = M / BM; nN = N / BM; nwg = nM * nN; G = G_; c = c_; }
    __host__ __device__ bool next(int i, Unit& u) const {
        const long L = (long)i * G + c; if (L >= nwg) return false;
        int wgid = (int)L; { const int q = nwg / NXCD, r = nwg % NXCD, xcd = wgid % NXCD, off = wgid / NXCD; wgid = (xcd < r ? xcd * (q + 1) : r * (q + 1) + (xcd - r) * q) + off; }
        const int nig = WGM * nN, gid = wgid / nig, fm = gid * WGM, gsz = (nM - fm) < WGM ? (nM - fm) : WGM;
        u.pm = fm + ((wgid % nig) % gsz); u.pn = (wgid % nig) / gsz; return true;
    }
    __device__ __forceinline__ void a_ready(const Unit&) const {}
    __device__ __forceinline__ void done(const Unit&) const {}
};

__device__ __forceinline__ unsigned cvt_pk_bf16(float lo, float hi) { unsigned r; asm volatile("v_cvt_pk_bf16_f32 %0, %1, %2" : "=v"(r) : "v"(lo), "v"(hi)); return r; }
typedef float f32x2 __attribute__((ext_vector_type(2)));
template <int ACT> struct EpiBf16 {
    static constexpr bool PERM = true, AFTER_DRAIN = false;
    bf16_t* O; int ldc;
    __device__ __forceinline__ void operator()(const f32x4 (&acc)[2][2][4][2], const Unit& u, int wr, int wc, int fr, int fq) const {
        const int row0 = u.pm * BM + wr * 64 + fr; const int col0 = u.pn * BM + wc * 32 + 8 * fq;
#pragma unroll
        for (int ai = 0; ai < 2; ++ai)
#pragma unroll
            for (int m = 0; m < 4; ++m) { bf16_t* rowp = O + (size_t)(row0 + ai * HALF + m * 16) * ldc + col0;
#pragma unroll
                for (int bj = 0; bj < 2; ++bj) { f32x4 v0 = acc[ai][bj][m][0], v1 = acc[ai][bj][m][1];
                    if (ACT == 2) {
#pragma unroll
                        for (int e = 0; e < 4; ++e) { float a = v0[e] > 0.f ? v0[e] : 0.f; v0[e] = a * a; float b = v1[e] > 0.f ? v1[e] : 0.f; v1[e] = b * b; } }
                    u32x4 w; w.x = cvt_pk_bf16(v0[0], v0[1]); w.y = cvt_pk_bf16(v0[2], v0[3]); w.z = cvt_pk_bf16(v1[0], v1[1]); w.w = cvt_pk_bf16(v1[2], v1[3]);
                    *(u32x4*)(rowp + bj * HALF) = w; } }
    }
};
struct EpiGlu {
    static constexpr bool PERM = true, AFTER_DRAIN = false;
    bf16_t* O; int ldc;
    __device__ __forceinline__ void operator()(const f32x4 (&acc)[2][2][4][2], const Unit& u, int wr, int wc, int fr, int fq) const {
        const int row0 = u.pm * BM + wr * 64 + fr; const int col0 = u.pn * HALF + wc * 32 + 8 * fq;
#pragma unroll
        for (int ai = 0; ai < 2; ++ai)
#pragma unroll
            for (int m = 0; m < 4; ++m) { bf16_t* rowp = O + (size_t)(row0 + ai * HALF + m * 16) * ldc + col0;
                f32x4 v0 = acc[ai][0][m][0], v1 = acc[ai][0][m][1]; const f32x4 g0 = acc[ai][1][m][0], g1 = acc[ai][1][m][1];
#pragma unroll
                for (int e = 0; e < 4; ++e) { v0[e] = v0[e] / (1.f + __expf(-g0[e])); v1[e] = v1[e] / (1.f + __expf(-g1[e])); }
                u32x4 w; w.x = cvt_pk_bf16(v0[0], v0[1]); w.y = cvt_pk_bf16(v0[2], v0[3]); w.z = cvt_pk_bf16(v1[0], v1[1]); w.w = cvt_pk_bf16(v1[2], v1[3]);
                *(u32x4*)rowp = w; }
    }
};
template <class Epi, class Sched, bool ALIGN_EPI = false, bool SP2 = false>
__device__ __forceinline__ void gemm_phase(PG8_LAS unsigned char* lds, const Gemm g, const Sched& S, const Epi& E) {
    int tid_ = threadIdx.x; asm volatile("" : "+v"(tid_)); const int tid = tid_, wid = __builtin_amdgcn_readfirstlane(tid >> 6), lane = tid & 63, wr = wid >> 2, wc = wid & 3, fr = lane & 15, fq = lane >> 4;
    const int K = g.K, nt = K / BK;
    unsigned voffA[2], voffB[2];
#pragma unroll
    for (int i = 0; i < 2; ++i) { int R, C; stage_rc(tid * 16 + i * 8192, R, C); const int Rb = Epi::PERM ? ((R & ~31) + perm32(R & 31)) : R;
        voffA[i] = (unsigned)(R * K + C) * 2u; voffB[i] = (unsigned)(Rb * K + C) * 2u; }
    const size_t kstep = (size_t)(BK * 2);
    const size_t hstep = (size_t)HALF * K * 2;
    const size_t tstep = 2 * hstep;
    const unsigned ldsw = (unsigned)wid * 1024u;
    const int aoff = lds_byte(wr * 64 + fr, fq * 8), boff = lds_byte(wc * 32 + fr, fq * 8);
#define PG8_SA(b, h) (((b) * 2 + (h)) * HTB)
#define PG8_SB(b, h) ((4 + (b) * 2 + (h)) * HTB)
#define PG8_STAGE(bufoff, gbase, voff) do { _Pragma("unroll") for (int _i = 0; _i < 2; ++_i) \
        __builtin_amdgcn_global_load_lds((const unsigned*)((const char*)(gbase) + (voff)[_i]), (PG8_LAS unsigned*)(lds + (bufoff) + ldsw + _i * 8192), 16, 0, 0); } while (0)
#define PG8_LDA(dst, b, h) do { _Pragma("unroll") for (int m = 0; m < 4; ++m) _Pragma("unroll") for (int k = 0; k < 2; ++k) dst[m][k] = *(const PG8_LAS bf16x8*)(lds + PG8_SA(b, h) + aoff + m * 2048 + k * 1024); } while (0)
#define PG8_LDB(dst, b, h) do { _Pragma("unroll") for (int n = 0; n < 2; ++n) _Pragma("unroll") for (int k = 0; k < 2; ++k) dst[n][k] = *(const PG8_LAS bf16x8*)(lds + PG8_SB(b, h) + boff + n * 2048 + k * 1024); } while (0)
#define PG8_MMA(ai, bj, At, Bt) do { __builtin_amdgcn_s_setprio(1); _Pragma("unroll") for (int m = 0; m < 4; ++m) _Pragma("unroll") for (int n = 0; n < 2; ++n) _Pragma("unroll") for (int k = 0; k < 2; ++k) \
        acc[ai][bj][m][n] = __builtin_amdgcn_mfma_f32_16x16x32_bf16(Bt[n][k], At[m][k], acc[ai][bj][m][n], 0, 0, 0); __builtin_amdgcn_s_setprio(0); } while (0)
#define PG8_WAIT_V(n) asm volatile("s_waitcnt vmcnt(" #n ")" ::: "memory")
#define PG8_WAIT_L(n) asm volatile("s_waitcnt lgkmcnt(" #n ")" ::: "memory")
#define PG8_BAR __builtin_amdgcn_s_barrier()
#define PG8_SCHED __builtin_amdgcn_sched_barrier(0)
    Unit cur, nxt; int ui = 0;
    if (!S.next(0, cur)) return;
    f32x4 acc[2][2][4][2];
#pragma unroll
    for (int a = 0; a < 2; ++a)
#pragma unroll
        for (int b = 0; b < 2; ++b)
#pragma unroll
            for (int m = 0; m < 4; ++m)
#pragma unroll
                for (int n = 0; n < 2; ++n) acc[a][b][m][n] = (f32x4){0.f, 0.f, 0.f, 0.f};
    bf16x8 At[4][2], B0[2][2], B1[2][2];
    const char* cA = (const char*)g.A + (size_t)cur.pm * tstep; const char* cB = (const char*)g.Bt + (size_t)cur.pn * tstep;
    S.a_ready(cur);
    if constexpr (SP2) {
        PG8_STAGE(PG8_SB(0, 0), cB, voffB); PG8_STAGE(PG8_SB(0, 1), cB + hstep, voffB); PG8_STAGE(PG8_SA(0, 0), cA, voffA); PG8_STAGE(PG8_SA(0, 1), cA + hstep, voffA);
        if (wr == 1) PG8_BAR;
        PG8_WAIT_V(2); PG8_BAR;
        PG8_STAGE(PG8_SB(1, 0), cB + kstep, voffB); PG8_STAGE(PG8_SA(1, 0), cA + kstep, voffA); PG8_STAGE(PG8_SB(1, 1), cB + hstep + kstep, voffB);
        PG8_WAIT_V(6); PG8_BAR;
    } else {
        PG8_STAGE(PG8_SB(0, 0), cB, voffB); PG8_STAGE(PG8_SA(0, 0), cA, voffA); PG8_STAGE(PG8_SB(0, 1), cB + hstep, voffB); PG8_STAGE(PG8_SA(0, 1), cA + hstep, voffA);
        if (wr == 1) PG8_BAR;
        PG8_WAIT_V(4); PG8_BAR;
        PG8_STAGE(PG8_SB(1, 0), cB + kstep, voffB); PG8_STAGE(PG8_SA(1, 0), cA + kstep, voffA); PG8_STAGE(PG8_SB(1, 1), cB + hstep + kstep, voffB);
        PG8_WAIT_V(6); PG8_BAR;
    }
    for (;;) {
        const bool has_next = S.next(ui + 1, nxt);
        const char* nA = has_next ? (const char*)g.A + (size_t)nxt.pm * tstep : cA; const char* nB = has_next ? (const char*)g.Bt + (size_t)nxt.pn * tstep : cB;
        for (int t = 0; t < nt; t += 2) {
            const bool last = (t == nt - 2);
            const char* a1 = cA + (size_t)(t + 1) * kstep;
            const char* a2 = last ? nA : cA + (size_t)(t + 2) * kstep; const char* b2 = last ? nB : cB + (size_t)(t + 2) * kstep;
            const char* a3 = a2 + kstep; const char* b3 = b2 + kstep;
            if (last && has_next) S.a_ready(nxt);
            if constexpr (SP2) {
            PG8_LDB(B0, 0, 0); PG8_LDB(B1, 0, 1); PG8_SCHED; PG8_LDA(At, 0, 0); PG8_STAGE(PG8_SA(1, 1), a1 + hstep, voffA);
            PG8_WAIT_V(8); PG8_WAIT_L(0); PG8_BAR; PG8_MMA(0, 0, At, B0); PG8_MMA(0, 1, At, B1); PG8_BAR; PG8_SCHED;
            PG8_LDA(At, 0, 1); PG8_STAGE(PG8_SB(0, 0), b2, voffB); PG8_STAGE(PG8_SB(0, 1), b2 + hstep, voffB); PG8_STAGE(PG8_SA(0, 0), a2, voffA);
            PG8_WAIT_V(8); PG8_WAIT_L(0); PG8_BAR; PG8_MMA(1, 0, At, B0); PG8_MMA(1, 1, At, B1); PG8_BAR; PG8_SCHED;
            PG8_LDB(B0, 1, 0); PG8_LDB(B1, 1, 1); PG8_SCHED; PG8_LDA(At, 1, 0); PG8_STAGE(PG8_SA(0, 1), a2 + hstep, voffA);
            PG8_WAIT_V(8); PG8_WAIT_L(0); PG8_BAR; PG8_MMA(0, 0, At, B0); PG8_MMA(0, 1, At, B1); PG8_BAR; PG8_SCHED;
            PG8_LDA(At, 1, 1); PG8_STAGE(PG8_SB(1, 0), b3, voffB); PG8_STAGE(PG8_SB(1, 1), b3 + hstep, voffB); PG8_STAGE(PG8_SA(1, 0), a3, voffA);
            PG8_WAIT_V(8); PG8_WAIT_L(0); PG8_BAR; PG8_MMA(1, 0, At, B0); PG8_MMA(1, 1, At, B1); PG8_BAR; PG8_SCHED;
            } else {
            PG8_LDB(B0, 0, 0); PG8_SCHED; PG8_LDA(At, 0, 0); PG8_STAGE(PG8_SA(1, 1), a1 + hstep, voffA);
            PG8_WAIT_L(8); PG8_BAR; PG8_WAIT_L(0); PG8_MMA(0, 0, At, B0); PG8_BAR; PG8_SCHED;
            PG8_LDB(B1, 0, 1); PG8_STAGE(PG8_SB(0, 0), b2, voffB);
            PG8_BAR; PG8_WAIT_L(0); PG8_MMA(0, 1, At, B1); PG8_BAR;
            PG8_LDA(At, 0, 1); PG8_STAGE(PG8_SA(0, 0), a2, voffA);
            PG8_BAR; PG8_WAIT_L(0); PG8_MMA(1, 0, At, B0); PG8_BAR; PG8_SCHED;
            PG8_STAGE(PG8_SB(0, 1), b2 + hstep, voffB);
            PG8_WAIT_V(6); PG8_BAR; PG8_MMA(1, 1, At, B1); PG8_BAR;
            PG8_LDB(B0, 1, 0); PG8_SCHED; PG8_LDA(At, 1, 0); PG8_STAGE(PG8_SA(0, 1), a2 + hstep, voffA);
            PG8_WAIT_L(8); PG8_BAR; PG8_WAIT_L(0); PG8_MMA(0, 0, At, B0); PG8_BAR; PG8_SCHED;
            PG8_LDB(B1, 1, 1); PG8_STAGE(PG8_SB(1, 0), b3, voffB);
            PG8_BAR; PG8_WAIT_L(0); PG8_MMA(0, 1, At, B1); PG8_BAR;
            PG8_LDA(At, 1, 1); PG8_STAGE(PG8_SA(1, 0), a3, voffA);
            PG8_BAR; PG8_WAIT_L(0); PG8_MMA(1, 0, At, B0); PG8_BAR; PG8_SCHED;
            PG8_STAGE(PG8_SB(1, 1), b3 + hstep, voffB);
            PG8_WAIT_V(6); PG8_BAR; PG8_MMA(1, 1, At, B1); PG8_BAR;
            }
        }
        if constexpr (ALIGN_EPI) { if (wr == 0) PG8_BAR; }
        if constexpr (!Epi::AFTER_DRAIN) { E(acc, cur, wr, wc, fr, fq); S.done(cur); }
        if (!has_next) break;
#pragma unroll
        for (int a = 0; a < 2; ++a)
#pragma unroll
            for (int b = 0; b < 2; ++b)
#pragma unroll
                for (int m = 0; m < 4; ++m)
#pragma unroll
                    for (int n = 0; n < 2; ++n) acc[a][b][m][n] = (f32x4){0.f, 0.f, 0.f, 0.f};
        cur = nxt; cA = nA; cB = nB; ++ui;
        if constexpr (ALIGN_EPI) { if (wr == 1) PG8_BAR; }
    }
    PG8_WAIT_V(0);
    if constexpr (!ALIGN_EPI) { if (wr == 0) PG8_BAR; }
    PG8_BAR;
    if constexpr (Epi::AFTER_DRAIN) { E.fused(acc, cur, wr, wc, fr, fq, lds, wid, lane); S.done(cur); }
#undef PG8_SA
#undef PG8_SB
#undef PG8_STAGE
#undef PG8_LDA
#undef PG8_LDB
#undef PG8_MMA
#undef PG8_WAIT_V
#undef PG8_WAIT_L
#undef PG8_BAR
#undef PG8_SCHED
}
}
#include <hip/hip_bf16.h>
#include <cmath>
namespace attn_body {
using bf16=__hip_bfloat16;
using bf16x8=__attribute__((ext_vector_type(8)))short;
using s16x4=__attribute__((ext_vector_type(4)))short;
using f32x16=__attribute__((ext_vector_type(16)))float;
using u32x4=__attribute__((ext_vector_type(4)))unsigned;
constexpr int BATCH=1,NHEAD=16,SEQ=16384,D=64,DM=NHEAD*D,KVP=256,NKT=260;
constexpr int NW=8,QBLK=32,QB=QBLK*NW,KVBLK=64,NQB=SEQ/QB;
constexpr int ATTN_PITCH=DM, ATTN_UNIT_ROWS=QB;
__device__ __forceinline__ int crow(int r,int hi){return (r&3)+8*(r>>2)+4*hi;}
#define SBAR() __builtin_amdgcn_sched_barrier(0)
__device__ __forceinline__ void cmask(f32x16&p0,f32x16&p1,int jb,int qrel,int hi){
  const float NEG=-INFINITY; int kb=64*jb+4*hi;
  #pragma unroll
  for(int r=0;r<16;++r){int kv=kb+(r&3)+8*(r>>2); if(kv>qrel)p0[r]=NEG; if(kv+32>qrel)p1[r]=NEG;}
}

constexpr int NSLOT=3, SLOTB=8192;
constexpr int LDS_K=0, LDS_V=NSLOT*SLOTB, LDS_WS=2*NSLOT*SLOTB, LDS_OST=LDS_WS+NW*64*4, LDS_BYTES=LDS_OST+NW*4096;
constexpr float C2=0.125f*1.4426950408889634f;
__device__ __forceinline__ void glds16(const void*gsrc,unsigned lds_dst){unsigned keep;
  asm volatile("s_mov_b32 %0, m0\n\ts_mov_b32 m0, %2\n\ts_nop 0\n\tglobal_load_lds_dwordx4 %1, off\n\ts_mov_b32 m0, %0":"=&s"(keep):"v"(gsrc),"s"(lds_dst):"memory");}
__device__ __forceinline__ float max3f(float a,float b,float c){float r;asm("v_max3_f32 %0, %1, %2, %3":"=v"(r):"v"(a),"v"(b),"v"(c));return r;}
__device__ __forceinline__ float max2f(float a,float b){float r;asm("v_max_f32_e32 %0, %1, %2":"=v"(r):"v"(a),"v"(b));return r;}
__device__ __forceinline__ float fadd_s(float a,float b){float r;asm("v_add_f32_e32 %0, %1, %2":"=v"(r):"v"(a),"v"(b));return r;}
__device__ __forceinline__ float fsub_s(float a,float b){float r;asm("v_sub_f32_e32 %0, %1, %2":"=v"(r):"v"(a),"v"(b));return r;}
typedef float f32x2_t __attribute__((ext_vector_type(2))); typedef __bf16 bf16x2_t __attribute__((ext_vector_type(2)));
__device__ __forceinline__ unsigned cvtpk_s(float lo,float hi){f32x2_t v={lo,hi};bf16x2_t b=__builtin_convertvector(v,bf16x2_t);return __builtin_bit_cast(unsigned,b);}
#define WAIT_BAR(N) asm volatile("s_waitcnt vmcnt(" #N ") lgkmcnt(0)\n\ts_barrier":::"memory")

__device__ __forceinline__ void qkt(f32x16&p0,f32x16&p1,const char*Kslot,const bf16x8*qr,const f32x16&negm,int r32,int hi){
  const char*kb=Kslot+hi*1024+r32*16;
  #pragma unroll
  for(int d0=0;d0<4;++d0){
    const bf16x8 b0=*reinterpret_cast<const bf16x8*>(kb+d0*2048);
    const bf16x8 b1=*reinterpret_cast<const bf16x8*>(kb+d0*2048+512);
    if(d0==0){p0=__builtin_amdgcn_mfma_f32_32x32x16_bf16(b0,qr[0],negm,0,0,0);p1=__builtin_amdgcn_mfma_f32_32x32x16_bf16(b1,qr[0],negm,0,0,0);}
    else{p0=__builtin_amdgcn_mfma_f32_32x32x16_bf16(b0,qr[d0],p0,0,0,0);p1=__builtin_amdgcn_mfma_f32_32x32x16_bf16(b1,qr[d0],p1,0,0,0);}}
}
typedef __attribute__((address_space(3))) const char* lds_cptr;
typedef short v4i16_t __attribute__((ext_vector_type(4)));
__device__ __forceinline__ void kload8(bf16x8*kf,lds_cptr kp){
  kf[0]=*(const __attribute__((address_space(3))) bf16x8*)(kp);      kf[1]=*(const __attribute__((address_space(3))) bf16x8*)(kp+512);
  kf[2]=*(const __attribute__((address_space(3))) bf16x8*)(kp+2048); kf[3]=*(const __attribute__((address_space(3))) bf16x8*)(kp+2560);
  kf[4]=*(const __attribute__((address_space(3))) bf16x8*)(kp+4096); kf[5]=*(const __attribute__((address_space(3))) bf16x8*)(kp+4608);
  kf[6]=*(const __attribute__((address_space(3))) bf16x8*)(kp+6144); kf[7]=*(const __attribute__((address_space(3))) bf16x8*)(kp+6656);
}
__device__ __forceinline__ void kload2(bf16x8*kf,lds_cptr kp,int j){ kf[2*j]=*(const __attribute__((address_space(3))) bf16x8*)(kp+j*2048); kf[2*j+1]=*(const __attribute__((address_space(3))) bf16x8*)(kp+j*2048+512); }
__device__ __forceinline__ s16x4 vtr(lds_cptr p){ return __builtin_bit_cast(s16x4,__builtin_amdgcn_ds_read_tr16_b64_v4i16((__attribute__((address_space(3))) v4i16_t*)p)); }
__device__ __forceinline__ float rowmax(const f32x16&p0,const f32x16&p1){
  float a=max3f(p0[0],p0[1],p1[0]),b=max3f(p0[2],p0[3],p1[1]);a=max3f(a,p1[2],p1[3]);
  #pragma unroll
  for(int r=4;r<16;r+=4){a=max3f(a,p0[r],p0[r+1]);b=max3f(b,p0[r+2],p0[r+3]);a=max3f(a,p1[r],p1[r+1]);b=max3f(b,p1[r+2],p1[r+3]);}
  const float m=max2f(a,b);
  auto rr=__builtin_amdgcn_permlane32_swap(__float_as_uint(m),__float_as_uint(m),false,false);
  return max2f(__uint_as_float(rr[0]),__uint_as_float(rr[1]));
}
__device__ __forceinline__ void pv(f32x16*o,int vb,bf16x8 pa0,bf16x8 pa1,bf16x8 pa2,bf16x8 pa3){
  #pragma unroll
  for(int d0=0;d0<2;++d0){s16x4 lo[4],hi[4];
    #pragma unroll
    for(int ks=0;ks<4;++ks){
      asm volatile("ds_read_b64_tr_b16 %0,%1 offset:%c2":"=&v"(lo[ks]):"v"(vb),"i"(d0*4096+ks*1024):"memory");
      asm volatile("ds_read_b64_tr_b16 %0,%1 offset:%c2":"=&v"(hi[ks]):"v"(vb),"i"(d0*4096+ks*1024+512):"memory");}
    asm volatile("s_waitcnt lgkmcnt(0)":::"memory");SBAR();
    #define PK(k) (bf16x8){lo[k][0],lo[k][1],lo[k][2],lo[k][3],hi[k][0],hi[k][1],hi[k][2],hi[k][3]}
    o[d0]=__builtin_amdgcn_mfma_f32_32x32x16_bf16(pa0,PK(0),o[d0],0,0,0);
    o[d0]=__builtin_amdgcn_mfma_f32_32x32x16_bf16(pa1,PK(1),o[d0],0,0,0);
    o[d0]=__builtin_amdgcn_mfma_f32_32x32x16_bf16(pa2,PK(2),o[d0],0,0,0);
    o[d0]=__builtin_amdgcn_mfma_f32_32x32x16_bf16(pa3,PK(3),o[d0],0,0,0);
    #undef PK
  }
}

#ifndef ATTN_STORE16
#define ATTN_STORE16(p,v) (*(u32x4*)(p)=(v))
#endif
template<int THRL> __device__ __forceinline__ void attn_unit(int b,int h,int qb,const bf16*Q,const bf16*__restrict__ K,const bf16*__restrict__ V,bf16*O,char*shm){
  int tid_=threadIdx.x; asm volatile("":"+v"(tid_)); const int tid=tid_,lane=tid&63,r32=lane&31,hi=lane>>5; const int wid=__builtin_amdgcn_readfirstlane(tid>>6);
  const long rowbase=(long)b*SEQ; const int q0=qb*QB;
  const bf16*Qw=Q+(rowbase+q0+wid*QBLK)*DM+h*D;
  const bf16*Kh=K+(h>>2)*D,*Vh=V+(h>>2)*D;
  const unsigned lds0=(unsigned)(uintptr_t)shm;
  float*wsf=(float*)(shm+LDS_WS)+wid*64;
  const bf16*ksrc=Kh+(long)lane*KVP+wid*8;
  const bf16*vsrc=Vh+(long)(16*(wid&3)+(lane>>2))*KVP+(wid>>2)*32+(lane&3)*8;
  const unsigned kdst=lds0+LDS_K+wid*1024, vdst=lds0+LDS_V+wid*1024;
  #define DMA_K(t,slot) glds16(ksrc+(long)(t)*KVBLK*KVP,(unsigned)__builtin_amdgcn_readfirstlane(kdst+(slot)))
  #define DMA_V(t,slot) glds16(vsrc+(long)(t)*KVBLK*KVP,(unsigned)__builtin_amdgcn_readfirstlane(vdst+(slot)))
  const int vb0=(int)(lds0+LDS_V)+((lane>>4)&1)*32+(lane&3)*8+(4*hi+((lane&15)>>2))*64;
  const char*Kbase=shm+LDS_K; bf16x8 kf[8];
  const lds_cptr shm3=(lds_cptr)shm; const lds_cptr kp0=shm3+LDS_K+hi*1024+r32*16; const lds_cptr vp0=shm3+LDS_V+((lane>>4)&1)*32+(lane&3)*8+(4*hi+((lane&15)>>2))*64;
  const int NT=NKT;
  DMA_K(0,0);DMA_V(0,0);DMA_K(1,SLOTB);
  bf16x8 qr[4];
  #pragma unroll
  for(int d0=0;d0<4;++d0)qr[d0]=*reinterpret_cast<const bf16x8*>(&Qw[(long)r32*DM+d0*16+hi*8]);
  float mhat=0.f,l_reg=0.f;f32x16 o[2];o[0]=f32x16{};o[1]=f32x16{};f32x16 negm=f32x16{};asm volatile("":"+v"(negm));
  const int qrel=wid*QBLK+r32;
  #define CMASK(P0,P1,t) do{}while(0)
  bool resc=false;
  #define START(P0,P1) do{ const float rm=rowmax(P0,P1); resc=false; \
    { const float dl=rm; mhat=fadd_s(mhat,dl); \
      _Pragma("unroll") for(int r=0;r<16;++r){P0[r]=fsub_s(P0[r],dl);P1[r]=fsub_s(P1[r],dl);} \
      _Pragma("unroll") for(int r=0;r<16;++r)negm[r]=-mhat; asm volatile("":"+v"(negm)); } \
    _Pragma("unroll") for(int r=0;r<16;++r)P0[r]=__builtin_amdgcn_exp2f(P0[r]); }while(0)
  #define RESC() do{ if(resc){ asm volatile("s_waitcnt lgkmcnt(0)":::"memory"); \
      _Pragma("unroll") for(int d_=0;d_<2;++d_) _Pragma("unroll") for(int r=0;r<16;++r)o[d_][r]*=wsf[crow(r,hi)]; } }while(0)
  f32x16 pA0,pA1,pB0,pB1;
  int sl_prev=0,sl_cur=0,sl_next=SLOTB;
  #define ROT() do{sl_prev=sl_cur;sl_cur=sl_next;sl_next=(sl_next==(NSLOT-1)*SLOTB)?0:sl_next+SLOTB;}while(0)
  DMA_K(2,2*SLOTB);
  WAIT_BAR(3);
  qkt(pA0,pA1,Kbase,qr,negm,r32,hi);asm volatile("s_nop 15\n\ts_nop 7":"+v"(pA0),"+v"(pA1));CMASK(pA0,pA1,0);
  START(pA0,pA1);
  _Pragma("unroll") for(int r=0;r<16;++r)pA1[r]=__builtin_amdgcn_exp2f(pA1[r]);
  WAIT_BAR(0);
  DMA_K(3,0);DMA_V(1,SLOTB);
  ROT();
  kload8(kf,kp0+sl_cur);
  WAIT_BAR(2);
  s16x4 vlo[8],vhi[8]; u32x4 pw0,pw1,pw2,pw3;
  #define PKW(P,B) cvtpk_s(P[B],P[B+1])
  #define PAF(k) __builtin_bit_cast(bf16x8,pw##k)
  #define VFR(i) (bf16x8){vlo[i][0],vlo[i][1],vlo[i][2],vlo[i][3],vhi[i][0],vhi[i][1],vhi[i][2],vhi[i][3]}
  #define PIN(x) asm volatile("":"+v"(x))
  #define MX3(a,b,c) __builtin_fmaxf(__builtin_fmaxf((a),(b)),(c))
  #define GAPA(MF,A0,A1,A2,A3,W0,W1,PW) do{ MF; sacc+=A0; sacc+=A1; sacc+=A2; sacc+=A3; PIN(sacc); W0; W1; PIN(PW); SBAR(); }while(0)
  #define EX(v) __builtin_amdgcn_exp2f(v)
  #define GAPB(MF,X,B) do{ MF; X[B]=EX(X[B]); X[B+1]=EX(X[B+1]); X[B+2]=EX(X[B+2]); X[B+3]=EX(X[B+3]); PIN(X); SBAR(); }while(0)
  #define VRD(i) do{ vlo[i]=vtr(vp_+(((i)>>2)*4096+((i)&3)*1024)); vhi[i]=vtr(vp_+(((i)>>2)*4096+((i)&3)*1024+512)); }while(0)
  #define KRD(G,j) do{ if(G){ kload2(kf,kp0+sl_next,j); SBAR(); } }while(0)
  #define STEP(C0,C1,P0,P1,t,GK,GV,GL) do{ SBAR(); \
    const lds_cptr vp_=vp0+sl_prev; \
    VRD(0); SBAR(); float sacc=(P0[0]+P0[1]); \
    GAPA(C0=__builtin_amdgcn_mfma_f32_32x32x16_bf16(kf[0],qr[0],negm,0,0,0), P0[2],P0[3],P0[4],P0[5],     pw0[0]=PKW(P0,0), pw0[1]=PKW(P0,2), pw0); \
    VRD(4); SBAR(); GAPA(C1=__builtin_amdgcn_mfma_f32_32x32x16_bf16(kf[1],qr[0],negm,0,0,0), P0[6],P0[7],P0[8],P0[9],     pw0[2]=PKW(P0,4), pw0[3]=PKW(P0,6), pw0); \
    VRD(1); SBAR(); GAPA(C0=__builtin_amdgcn_mfma_f32_32x32x16_bf16(kf[2],qr[1],C0,0,0,0),   P0[10],P0[11],P0[12],P0[13], pw1[0]=PKW(P0,8), pw1[1]=PKW(P0,10), pw1); \
    VRD(5); SBAR(); GAPA(C1=__builtin_amdgcn_mfma_f32_32x32x16_bf16(kf[3],qr[1],C1,0,0,0),   P0[14],P0[15],P1[0],P1[1],   pw1[2]=PKW(P0,12),pw1[3]=PKW(P0,14), pw1); \
    VRD(2); SBAR(); GAPA(C0=__builtin_amdgcn_mfma_f32_32x32x16_bf16(kf[4],qr[2],C0,0,0,0),   P1[2],P1[3],P1[4],P1[5],     pw2[0]=PKW(P1,0), pw2[1]=PKW(P1,2), pw2); \
    VRD(6); SBAR(); GAPA(C1=__builtin_amdgcn_mfma_f32_32x32x16_bf16(kf[5],qr[2],C1,0,0,0),   P1[6],P1[7],P1[8],P1[9],     pw2[2]=PKW(P1,4), pw2[3]=PKW(P1,6), pw2); \
    VRD(3); SBAR(); GAPA(C0=__builtin_amdgcn_mfma_f32_32x32x16_bf16(kf[6],qr[3],C0,0,0,0),   P1[10],P1[11],P1[12],P1[13], pw3[0]=PKW(P1,8), pw3[1]=PKW(P1,10), pw3); \
    VRD(7); SBAR(); GAPA(C1=__builtin_amdgcn_mfma_f32_32x32x16_bf16(kf[7],qr[3],C1,0,0,0),   P1[14],P1[15],0.f,0.f,       pw3[2]=PKW(P1,12),pw3[3]=PKW(P1,14), pw3); \
    l_reg+=sacc; \
    if(GK){DMA_K((t)+3,sl_cur);} if(GV){DMA_V((t)+1,sl_next);} \
    CMASK(C0,C1,t); \
    { float a=MX3(C0[0],C0[1],C1[0]),b=MX3(C0[2],C0[3],C1[1]); a=MX3(a,C1[2],C1[3]); \
      _Pragma("unroll") for(int r=4;r<16;r+=4){a=MX3(a,C0[r],C0[r+1]);b=MX3(b,C0[r+2],C0[r+3]);a=MX3(a,C1[r],C1[r+1]);b=MX3(b,C1[r+2],C1[r+3]);} \
      float rm=__builtin_fmaxf(a,b); { auto rr=__builtin_amdgcn_permlane32_swap(__float_as_uint(rm),__float_as_uint(rm),false,false); rm=__builtin_fmaxf(__uint_as_float(rr[0]),__uint_as_float(rr[1])); } \
      resc=false; \
      if(__builtin_expect(__any(rm>(float)THRL),0)){ const float dl=__builtin_fmaxf(rm,0.f); mhat+=dl; \
        _Pragma("unroll") for(int r=0;r<16;++r){C0[r]-=dl;C1[r]-=dl;} \
        _Pragma("unroll") for(int r=0;r<16;++r)negm[r]=-mhat; asm volatile("":"+v"(negm)); \
        const float f=__builtin_amdgcn_exp2f(-dl); l_reg*=f; if(hi==0)wsf[r32]=f; resc=true; } } \
    SBAR(); \
    GAPB(o[0]=__builtin_amdgcn_mfma_f32_32x32x16_bf16(PAF(0),VFR(0),o[0],0,0,0), C0,0); \
    GAPB(o[1]=__builtin_amdgcn_mfma_f32_32x32x16_bf16(PAF(0),VFR(4),o[1],0,0,0), C0,4); \
    KRD(GL,0); GAPB(o[0]=__builtin_amdgcn_mfma_f32_32x32x16_bf16(PAF(1),VFR(1),o[0],0,0,0), C0,8); \
    KRD(GL,1); GAPB(o[1]=__builtin_amdgcn_mfma_f32_32x32x16_bf16(PAF(1),VFR(5),o[1],0,0,0), C0,12); \
    KRD(GL,2); GAPB(o[0]=__builtin_amdgcn_mfma_f32_32x32x16_bf16(PAF(2),VFR(2),o[0],0,0,0), C1,0); \
    KRD(GL,3); GAPB(o[1]=__builtin_amdgcn_mfma_f32_32x32x16_bf16(PAF(2),VFR(6),o[1],0,0,0), C1,4); \
    GAPB(o[0]=__builtin_amdgcn_mfma_f32_32x32x16_bf16(PAF(3),VFR(3),o[0],0,0,0), C1,8); \
    GAPB(o[1]=__builtin_amdgcn_mfma_f32_32x32x16_bf16(PAF(3),VFR(7),o[1],0,0,0), C1,12); \
    }while(0)
  int t=1;
  #undef CMASK
  #define CMASK(P0,P1,t) do{}while(0)
  for(;t+5<NT;t+=2){
    STEP(pB0,pB1,pA0,pA1,t,true,true,true);     WAIT_BAR(2); RESC(); ROT();
    STEP(pA0,pA1,pB0,pB1,t+1,true,true,true);   WAIT_BAR(2); RESC(); ROT();
  }
  #undef CMASK
  #define CMASK(P0,P1,t) do{}while(0)
  #define ENDW(tt) do{ if((tt)+3<NT){WAIT_BAR(2);} else if((tt)+2<NT){WAIT_BAR(1);} else {WAIT_BAR(0);} }while(0)
  for(;t+1<NT;t+=2){
    STEP(pB0,pB1,pA0,pA1,t,(t+3<NT),(t+1<NT),(t+1<NT));       ENDW(t);   RESC(); ROT();
    STEP(pA0,pA1,pB0,pB1,t+1,(t+4<NT),(t+2<NT),(t+2<NT));     ENDW(t+1); RESC(); ROT();
  }
  STEP(pB0,pB1,pA0,pA1,NT-1,false,false,false); RESC();
  { float sacc=pB0[0]+pB0[1]; _Pragma("unroll") for(int r=2;r<16;++r)sacc+=pB0[r]; _Pragma("unroll") for(int r=0;r<16;++r)sacc+=pB1[r]; l_reg+=sacc;
    pw0=(u32x4){PKW(pB0,0),PKW(pB0,2),PKW(pB0,4),PKW(pB0,6)};pw1=(u32x4){PKW(pB0,8),PKW(pB0,10),PKW(pB0,12),PKW(pB0,14)};pw2=(u32x4){PKW(pB1,0),PKW(pB1,2),PKW(pB1,4),PKW(pB1,6)};pw3=(u32x4){PKW(pB1,8),PKW(pB1,10),PKW(pB1,12),PKW(pB1,14)};
    SBAR(); pv(o,vb0+sl_cur,PAF(0),PAF(1),PAF(2),PAF(3)); }
  #undef PKW
  #undef PAF
  #undef VFR
  #undef PIN
  #undef MX3
  #undef GAPA
  #undef GAPB
  #undef EX
  #undef VRD
  #undef KRD
  #undef STEP
  #undef ENDW
  {auto rr=__builtin_amdgcn_permlane32_swap(__float_as_uint(l_reg),__float_as_uint(l_reg),false,false);l_reg=__uint_as_float(rr[0])+__uint_as_float(rr[1]);}
  if(hi==0)wsf[32+r32]=l_reg;asm volatile("s_waitcnt lgkmcnt(0)":::"memory");
  float rli[16];
  #pragma unroll
  for(int r=0;r<16;++r)rli[r]=__builtin_amdgcn_rcpf(wsf[32+crow(r,hi)]);
  bf16*Ow=O+(rowbase+q0+wid*QBLK)*DM+h*D;
  { bf16*stg=(bf16*)(shm+LDS_OST)+wid*2048;
    #pragma unroll
    for(int r=0;r<16;++r){const int orow=crow(r,hi);
      #pragma unroll
      for(int d0=0;d0<2;++d0)stg[orow*64+d0*32+r32]=__float2bfloat16(o[d0][r]*rli[r]);}
    asm volatile("s_waitcnt lgkmcnt(0)":::"memory");
    #pragma unroll
    for(int i=0;i<4;++i){const int row=i*8+(lane>>3),ch=lane&7; const u32x4 v=*(const u32x4*)(stg+row*64+ch*8); ATTN_STORE16(Ow+(long)row*DM+ch*8,v);} }
  asm volatile("s_waitcnt lgkmcnt(0)\n\ts_barrier":::"memory");
  #undef DMA_K
  #undef DMA_V
  #undef CMASK
  #undef START
  #undef RESC
  #undef ROT
}
constexpr int ATTN_LDS_BYTES=LDS_BYTES;
struct AttnTensors { const bf16* Q; const bf16* K; const bf16* V; bf16* O; };
struct AttnUnit { int bh; int qb; };
struct StaticOrder {
  int vcu;
  __device__ __forceinline__ explicit StaticOrder(int grid,int block):vcu((grid%8==0)?(block%8)*(grid/8)+block/8:block){}
  __device__ __forceinline__ bool next(int i,AttnUnit&u)const{ if(i>=4)return false; const int x=vcu>>5, c=vcu&31; const int ul=(x&1)*128+c*4+i; u.bh=(x>>1)*4+(ul>>6); u.qb=ul&63; return true; }
  __device__ __forceinline__ void a_ready(const AttnUnit&)const{}
  __device__ __forceinline__ void done(const AttnUnit&)const{}
};
template<class Sched,int THRL=8> __device__ __forceinline__ void attn_phase(char*lds,const AttnTensors&T,const Sched&S){
  AttnUnit u;
  for(int i=0;S.next(i,u);++i){ S.a_ready(u); attn_unit<THRL>(u.bh/NHEAD,u.bh%NHEAD,u.qb,T.Q,T.K,T.V,T.O,lds); S.done(u); }
}
#undef SBAR
#undef WAIT_BAR
}
typedef unsigned short bf16;
typedef float f32x4 __attribute__((ext_vector_type(4)));
typedef float f32x2 __attribute__((ext_vector_type(2)));
typedef unsigned u32x4 __attribute__((ext_vector_type(4)));
typedef unsigned u32x2 __attribute__((ext_vector_type(2)));
#define LAS3 __attribute__((address_space(3)))

constexpr int T = 16640, NCTX = 256, NLAT = 16384, DM = 1024, FF = 4096, NQKV = 1536;
constexpr float EPS = 1e-6f;
constexpr size_t MiB = 1u << 20;
constexpr size_t WS_MOD = 0, WS_S5A = 128 * 1024, WS_S5BB = 256 * 1024, WS_ROPE = 768 * 1024;
constexpr size_t WS_WIN = 2 * MiB, WS_WGLU = 4 * MiB, WS_WOUT = 5 * MiB, WS_W1_0 = 7 * MiB, WS_W2_0 = 15 * MiB, WS_WQKV = 23 * MiB, WS_WAO = 26 * MiB, WS_W1_1 = 28 * MiB, WS_W2_1 = 36 * MiB;
constexpr size_t WS_XC = 44 * MiB, WS_H = 45 * MiB, WS_Y = 78 * MiB, WS_BIG = 111 * MiB;
constexpr size_t WS_U = WS_BIG, WS_G = 144 * MiB, WS_Z = 161 * MiB, WS_S5E = 194 * MiB, WS_S5H = 203 * MiB;
constexpr size_t WS_QKV = WS_BIG, WS_Q = 160 * MiB, WS_K = 193 * MiB, WS_V = 202 * MiB;
constexpr size_t WS_END = 241 * MiB;
constexpr int LDS_TOTAL = 143360;
constexpr int NCH = 260;

struct Params { const float* in[26]; float* out; unsigned char* ws; };
typedef const __attribute__((address_space(4))) Params* KP;

__device__ __forceinline__ float wave_sum(float v) {
#pragma unroll
    for (int o = 1; o < 64; o <<= 1) v += __shfl_xor(v, o);
    return v;
}
__device__ __forceinline__ float siluf(float x) { return x / (1.f + __expf(-x)); }
__device__ __forceinline__ unsigned f2bf(float f) { unsigned u = __float_as_uint(f); return (u + 0x7fffu + ((u >> 16) & 1u)) >> 16; }
__device__ __forceinline__ unsigned pk2(float lo, float hi) { return f2bf(lo) | (f2bf(hi) << 16); }
__device__ __forceinline__ float bflo(unsigned w) { return __uint_as_float(w << 16); }
__device__ __forceinline__ float bfhi(unsigned w) { return __uint_as_float(w & 0xffff0000u); }
__device__ __forceinline__ float gelu_tanh(float x) { const float a = 0.7978845608028654f * (x + 0.044715f * x * x * x); const float th = 1.f - 2.f / (1.f + __expf(2.f * a)); return 0.5f * x * (1.f + th); }

__device__ __forceinline__ void tr_item(const float* W, int ldw, bf16* WT, int ldt, float* scr, int lane) {
#pragma unroll 8
    for (int i = 0; i < 32; ++i) { const int kk = 2 * i + (lane >> 5); scr[kk * 33 + (lane & 31)] = W[(size_t)kk * ldw + (lane & 31)]; }
    __builtin_amdgcn_wave_barrier();
    const int c = lane & 7;
#pragma unroll
    for (int j = 0; j < 4; ++j) { const int n = (lane >> 3) + 8 * j; const float* s = scr + (8 * c) * 33 + n;
        u32x4 o; o.x = pk2(s[0 * 33], s[1 * 33]); o.y = pk2(s[2 * 33], s[3 * 33]); o.z = pk2(s[4 * 33], s[5 * 33]); o.w = pk2(s[6 * 33], s[7 * 33]);
        *(u32x4*)(WT + (size_t)n * ldt + 8 * c) = o; }
    __builtin_amdgcn_wave_barrier();
}

__device__ __forceinline__ void prologue(KP p, unsigned char* lds, int tid, int lane, int wave) {
    float* misc = (float*)(lds + 131072);
    float* red = misc + 2048;
    { const float* c = p->in[1]; const float* cc = p->in[3];
      for (int i = tid; i < 1024; i += 512) { misc[i] = siluf(c[i]); misc[1024 + i] = siluf(cc[i]); } }
    __syncthreads();
    float* modv = (float*)(p->ws + WS_MOD);
    for (int it = blockIdx.x; it < 192; it += gridDim.x) {
        const int l = it / 96, cb = it % 96, cl = tid & 63, kq = tid >> 6;
        const float* w = p->in[4] + (size_t)l * 1024 * 6144 + cb * 64 + cl;
        float a0 = 0.f, a1 = 0.f;
#pragma unroll 8
        for (int k = kq * 128; k < kq * 128 + 128; ++k) { const float wv = w[(size_t)k * 6144]; a0 += misc[k] * wv; a1 += misc[1024 + k] * wv; }
        red[kq * 64 + cl] = a0; red[512 + kq * 64 + cl] = a1;
        __syncthreads();
        if (tid < 128) { const int v = tid >> 6; float s = 0.f;
#pragma unroll
            for (int q = 0; q < 8; ++q) s += red[v * 512 + q * 64 + cl];
            modv[(size_t)(l * 2 + v) * 6144 + cb * 64 + cl] = s + p->in[5][l * 6144 + cb * 64 + cl]; }
        __syncthreads();
    }
    float* scr = (float*)(lds + wave * 16384);
    const int gw = blockIdx.x * 8 + wave, NGW = gridDim.x * 8;
    constexpr int I_IN = 512, I_GLU = 256, I_OUT = 256, I_W1 = 2048, I_W2 = 2048, I_QKV = 768, I_AO = 512;
    constexpr int NITEMS = I_IN + I_GLU + I_OUT + 2 * (I_W1 + I_W2) + I_QKV + I_AO;
    for (int it = gw; it < NITEMS; it += NGW) {
        int r = it; const float* W; int N, ldt; bf16* WT; bool glu = false;
        if (r < I_IN) { W = p->in[9]; N = 1024; ldt = 1024; WT = (bf16*)(p->ws + WS_WIN); }
        else if ((r -= I_IN) < I_GLU) { W = p->in[19]; N = 1024; ldt = 512; WT = (bf16*)(p->ws + WS_WGLU); glu = true; }
        else if ((r -= I_GLU) < I_OUT) { W = p->in[10]; N = 1024; ldt = 1024; WT = (bf16*)(p->ws + WS_WOUT); }
        else if ((r -= I_OUT) < I_W1) { W = p->in[7]; N = 4096; ldt = 1024; WT = (bf16*)(p->ws + WS_W1_0); }
        else if ((r -= I_W1) < I_W2) { W = p->in[8]; N = 1024; ldt = 4096; WT = (bf16*)(p->ws + WS_W2_0); }
        else if ((r -= I_W2) < I_QKV) { W = p->in[22]; N = 1536; ldt = 1024; WT = (bf16*)(p->ws + WS_WQKV); }
        else if ((r -= I_QKV) < I_AO) { W = p->in[23]; N = 1024; ldt = 1024; WT = (bf16*)(p->ws + WS_WAO); }
        else if ((r -= I_AO) < I_W1) { W = p->in[7] + (size_t)1024 * 4096; N = 4096; ldt = 1024; WT = (bf16*)(p->ws + WS_W1_1); }
        else { r -= I_W1; W = p->in[8] + (size_t)4096 * 1024; N = 1024; ldt = 4096; WT = (bf16*)(p->ws + WS_W2_1); }
        const int nblk = N / 32, kb = r / nblk, nb = r % nblk, k0 = 64 * kb, n0 = 32 * nb;
        int drow = n0;
        if (glu) { const int bj = n0 >> 9, rem = n0 & 511; drow = 256 * (rem >> 7) + 128 * bj + (rem & 127); }
        tr_item(W + (size_t)k0 * N + n0, N, WT + (size_t)drow * ldt + k0, ldt, scr, lane);
    }
    const int gt = blockIdx.x * 512 + tid, NTH = gridDim.x * 512;
    for (int id = gt; id < 65536; id += NTH) {
        const int n = id & 1023, ib = (id >> 10) & 15, gi = id >> 14;
        const float* pw = p->in[20] + (size_t)gi * 16384 + (size_t)(ib * 8) * 128;
        const float* sc = p->in[21] + gi * 128;
        const float* wo = p->in[10] + (size_t)(512 + gi * 128) * 1024 + n;
        float acc[8];
#pragma unroll
        for (int e = 0; e < 8; ++e) acc[e] = 0.f;
        for (int j = 0; j < 128; ++j) { const float wv = wo[(size_t)j * 1024] * sc[j];
#pragma unroll
            for (int e = 0; e < 8; ++e) acc[e] += pw[e * 128 + j] * wv; }
        u32x4 o; o.x = pk2(acc[0], acc[1]); o.y = pk2(acc[2], acc[3]); o.z = pk2(acc[4], acc[5]); o.w = pk2(acc[6], acc[7]);
        *(u32x4*)((bf16*)(p->ws + WS_WOUT) + (size_t)n * 1024 + 512 + gi * 128 + ib * 8) = o;
    }
    for (int id = gt; id < 4096; id += NTH) {
        const float lr = p->in[11][id], li = p->in[12][id], dt = __expf(p->in[13][id >> 6]);
        const float mag = expf(lr * dt), ar = mag * cosf(li * dt), ai = mag * sinf(li * dt);
        const float den = lr * lr + li * li;
        const float fr = ((ar - 1.f) * lr + ai * li) / den, fi = (ai * lr - (ar - 1.f) * li) / den;
        float* A = (float*)(p->ws + WS_S5A); A[2 * id] = ar; A[2 * id + 1] = ai;
        float* BB = (float*)(p->ws + WS_S5BB) + (size_t)id * 32;
        const float* br = p->in[14] + (size_t)id * 16; const float* bi = p->in[15] + (size_t)id * 16;
#pragma unroll
        for (int c = 0; c < 16; ++c) { const float x = br[c], y = bi[c]; BB[c] = fr * x - fi * y; BB[16 + c] = fr * y + fi * x; }
        const int pos = id >> 4, fq = id & 15;
        const float inv = powf(10000.f, -(float)fq / 16.f), ang = (float)pos * inv;
        float* R = (float*)(p->ws + WS_ROPE); R[2 * id] = cosf(ang); R[2 * id + 1] = sinf(ang);
    }
}

struct RowP { const float* xlat; const float* xctx; float* olat; float* octx; const bf16* Y; const float* gA; const float* gate;
              const float* gB; const float* shsc; bf16* H; int r0; };
__device__ __forceinline__ void row_phase(const RowP& a, int lane, int wave) {
    const int gw = blockIdx.x * 8 + wave, NGW = gridDim.x * 8;
    for (int r = a.r0 + gw; r < T; r += NGW) {
        const bool isctx = r < NCTX; const int vo = isctx ? 6144 : 0;
        const float* xs = isctx ? a.xctx + (size_t)r * DM : a.xlat + (size_t)(r - NCTX) * DM;
        f32x4 v[4];
#pragma unroll
        for (int j = 0; j < 4; ++j) v[j] = ((const f32x4*)xs)[lane + 64 * j];
        if (a.Y) {
            f32x4 y[4]; float ss = 0.f;
#pragma unroll
            for (int j = 0; j < 4; ++j) { const u32x2 w = ((const u32x2*)(a.Y + (size_t)r * DM))[lane + 64 * j]; y[j] = (f32x4){bflo(w.x), bfhi(w.x), bflo(w.y), bfhi(w.y)};
                ss += (y[j].x * y[j].x + y[j].y * y[j].y) + (y[j].z * y[j].z + y[j].w * y[j].w); }
            const float rstd = rsqrtf(wave_sum(ss) * (1.f / DM) + EPS);
            float* xo = isctx ? a.octx + (size_t)r * DM : a.olat + (size_t)(r - NCTX) * DM;
#pragma unroll
            for (int j = 0; j < 4; ++j) { const f32x4 g = ((const f32x4*)a.gA)[lane + 64 * j], gt = ((const f32x4*)(a.gate + vo))[lane + 64 * j];
                v[j] = v[j] + gt * (y[j] * rstd * g); ((f32x4*)xo)[lane + 64 * j] = v[j]; }
        }
        if (a.H) {
            float ss = 0.f;
#pragma unroll
            for (int j = 0; j < 4; ++j) ss += (v[j].x * v[j].x + v[j].y * v[j].y) + (v[j].z * v[j].z + v[j].w * v[j].w);
            const float rstd = rsqrtf(wave_sum(ss) * (1.f / DM) + EPS);
#pragma unroll
            for (int j = 0; j < 4; ++j) { const f32x4 g = ((const f32x4*)a.gB)[lane + 64 * j], sh = ((const f32x4*)(a.shsc + vo))[lane + 64 * j], sc = ((const f32x4*)(a.shsc + vo + 1024))[lane + 64 * j];
                const f32x4 h = (v[j] * rstd * g) * (sc + 1.f) + sh;
                u32x2 o; o.x = pk2(h.x, h.y); o.y = pk2(h.z, h.w); ((u32x2*)(a.H + (size_t)r * DM))[lane + 64 * j] = o; }
        }
    }
}

__device__ __forceinline__ int s5_row(int dir, int j, int sl) { const int s = j * 64 + sl; return dir == 0 ? s : (j < 4 ? 255 - s : 16895 - s); }
__device__ __forceinline__ void s5_stage_u(const bf16* U, int row, int g, float* ut, int lane) {
    const u32x4* src = (const u32x4*)(U + (size_t)row * DM + g * 16);
    const u32x4 a = src[0], b = src[1];
    f32x4* d = (f32x4*)(ut + lane * 16);
    d[0] = (f32x4){bflo(a.x), bfhi(a.x), bflo(a.y), bfhi(a.y)}; d[1] = (f32x4){bflo(a.z), bfhi(a.z), bflo(a.w), bfhi(a.w)};
    d[2] = (f32x4){bflo(b.x), bfhi(b.x), bflo(b.y), bfhi(b.y)}; d[3] = (f32x4){bflo(b.z), bfhi(b.z), bflo(b.w), bfhi(b.w)};
}
#define S5_LOAD_BB(dir, g) do { const f32x4* bp_ = (const f32x4*)((const float*)(p->ws + WS_S5BB) + (size_t)(((dir) * 32 + (g)) * 64 + lane) * 32); \
    _Pragma("unroll") for (int q_ = 0; q_ < 4; ++q_) { const f32x4 t_ = bp_[q_]; bbr[4 * q_] = t_.x; bbr[4 * q_ + 1] = t_.y; bbr[4 * q_ + 2] = t_.z; bbr[4 * q_ + 3] = t_.w; } \
    _Pragma("unroll") for (int q_ = 0; q_ < 4; ++q_) { const f32x4 t_ = bp_[4 + q_]; bbi[4 * q_] = t_.x; bbi[4 * q_ + 1] = t_.y; bbi[4 * q_ + 2] = t_.z; bbi[4 * q_ + 3] = t_.w; } } while (0)
#define S5_STEP(utrow) do { const f32x4* up_ = (const f32x4*)(utrow); float bur_ = 0.f, bui_ = 0.f; \
    _Pragma("unroll") for (int q_ = 0; q_ < 4; ++q_) { const f32x4 u_ = up_[q_]; \
        bur_ += bbr[4 * q_] * u_.x + bbr[4 * q_ + 1] * u_.y + bbr[4 * q_ + 2] * u_.z + bbr[4 * q_ + 3] * u_.w; \
        bui_ += bbi[4 * q_] * u_.x + bbi[4 * q_ + 1] * u_.y + bbi[4 * q_ + 2] * u_.z + bbi[4 * q_ + 3] * u_.w; } \
    const float nr_ = ar * hr - ai * hi + bur_, ni_ = ar * hi + ai * hr + bui_; hr = nr_; hi = ni_; } while (0)

__device__ __forceinline__ void pool_s5a_phase(KP p, unsigned char* lds, int tid, int lane, int wave) {
    const bf16* U = (const bf16*)(p->ws + WS_U); bf16* Z = (bf16*)(p->ws + WS_Z);
    const int gt = blockIdx.x * 512 + tid, NTH = gridDim.x * 512;
    for (int id = gt; id < T * 64; id += NTH) {
        const int r = id >> 6, cgp = id & 63, gi = cgp >> 4, w = 2 << gi, lo = w >> 1, hi = w - 1 - lo;
        const int s0 = r < NCTX ? 0 : NCTX, s1 = r < NCTX ? NCTX : T;
        const int st = (r - lo) < s0 ? s0 : (r - lo), en = (r + hi + 1) > s1 ? s1 : (r + hi + 1);
        float acc[8];
#pragma unroll
        for (int e = 0; e < 8; ++e) acc[e] = 0.f;
        for (int q = st; q < en; ++q) { const u32x4 x = *(const u32x4*)(U + (size_t)q * DM + 512 + cgp * 8);
            acc[0] += bflo(x.x); acc[1] += bfhi(x.x); acc[2] += bflo(x.y); acc[3] += bfhi(x.y); acc[4] += bflo(x.z); acc[5] += bfhi(x.z); acc[6] += bflo(x.w); acc[7] += bfhi(x.w); }
        const u32x4 x = *(const u32x4*)(U + (size_t)r * DM + 512 + cgp * 8);
        const float ic = 1.f / (float)(en - st);
        u32x4 o; o.x = pk2(acc[0] * ic - bflo(x.x), acc[1] * ic - bfhi(x.x)); o.y = pk2(acc[2] * ic - bflo(x.y), acc[3] * ic - bfhi(x.y));
        o.z = pk2(acc[4] * ic - bflo(x.z), acc[5] * ic - bfhi(x.z)); o.w = pk2(acc[6] * ic - bflo(x.w), acc[7] * ic - bfhi(x.w));
        *(u32x4*)(Z + (size_t)r * DM + 512 + cgp * 8) = o;
    }
    float* ut = (float*)(lds + wave * 8192);
    const int gw = blockIdx.x * 8 + wave, NGW = gridDim.x * 8;
    f32x2* E = (f32x2*)(p->ws + WS_S5E);
    for (int unit = gw; unit < 2 * NCH * 32; unit += NGW) {
        const int dir = unit / (NCH * 32), rem = unit % (NCH * 32), j = rem >> 5, g = rem & 31;
        s5_stage_u(U, s5_row(dir, j, lane), g, ut, lane);
        __builtin_amdgcn_wave_barrier();
        float bbr[16], bbi[16]; S5_LOAD_BB(dir, g);
        const f32x2 av = ((const f32x2*)(p->ws + WS_S5A))[(dir * 32 + g) * 64 + lane]; const float ar = av.x, ai = av.y;
        float hr = 0.f, hi = 0.f;
        for (int sl = 0; sl < 64; ++sl) S5_STEP(ut + sl * 16);
        E[(size_t)((dir * NCH + j) * 32 + g) * 64 + lane] = (f32x2){hr, hi};
        __builtin_amdgcn_wave_barrier();
    }
}
__device__ __forceinline__ void s5b_phase(KP p, int tid) {
    const int gt = blockIdx.x * 512 + tid, NTH = gridDim.x * 512;
    const f32x2* E = (const f32x2*)(p->ws + WS_S5E); f32x2* Hin = (f32x2*)(p->ws + WS_S5H);
    for (int id = gt; id < 4096; id += NTH) {
        const int dir = id >> 11, gp = id & 2047;
        f32x2 a = ((const f32x2*)(p->ws + WS_S5A))[id];
#pragma unroll
        for (int q = 0; q < 6; ++q) a = (f32x2){a.x * a.x - a.y * a.y, 2.f * a.x * a.y};
        float hr = 0.f, hi = 0.f;
        for (int jb = 0; jb < NCH; jb += 13) {
            f32x2 e[13];
#pragma unroll
            for (int q = 0; q < 13; ++q) e[q] = E[(size_t)(dir * NCH + jb + q) * 2048 + gp];
#pragma unroll
            for (int q = 0; q < 13; ++q) { Hin[(size_t)(dir * NCH + jb + q) * 2048 + gp] = (f32x2){hr, hi};
                const float nr = a.x * hr - a.y * hi + e[q].x, ni = a.x * hi + a.y * hr + e[q].y; hr = nr; hi = ni; }
        }
    }
}
__device__ __forceinline__ void s5c_phase(KP p, unsigned char* lds, int lane, int wave) {
    const bf16* U = (const bf16*)(p->ws + WS_U); bf16* G = (bf16*)(p->ws + WS_G);
    float* ut = (float*)(lds + wave * 8192); float* yt = ut + 1024;
    const int gw = blockIdx.x * 8 + wave, NGW = gridDim.x * 8;
    const f32x2* Hin = (const f32x2*)(p->ws + WS_S5H);
    const int cidx = ((lane >> 5) & 1) * 8 + ((lane >> 4) & 1) * 4 + ((lane >> 3) & 1) * 2 + ((lane >> 2) & 1);
    const bool b32 = (lane & 32) != 0, b16 = (lane & 16) != 0, b8 = (lane & 8) != 0, b4 = (lane & 4) != 0;
    for (int unit = gw; unit < NCH * 32; unit += NGW) {
        const int rc = unit >> 5, g = unit & 31;
        s5_stage_u(U, rc * 64 + lane, g, ut, lane);
        { const float* dp = p->in[18] + g * 16;
#pragma unroll
          for (int c = 0; c < 16; ++c) yt[lane * 16 + c] = dp[c] * ut[lane * 16 + c]; }
        __builtin_amdgcn_wave_barrier();
#pragma unroll 1
        for (int dir = 0; dir < 2; ++dir) {
            const int j = dir == 0 ? rc : (rc < 4 ? 3 - rc : 263 - rc);
            float bbr[16], bbi[16]; S5_LOAD_BB(dir, g);
            float cr[16], ci[16];
            { const float* crp = p->in[16] + (size_t)((dir * 32 + g) * 16) * 64 + lane; const float* cip = p->in[17] + (size_t)((dir * 32 + g) * 16) * 64 + lane;
#pragma unroll
              for (int c = 0; c < 16; ++c) { cr[c] = crp[c * 64]; ci[c] = cip[c * 64]; } }
            const f32x2 av = ((const f32x2*)(p->ws + WS_S5A))[(dir * 32 + g) * 64 + lane]; const float ar = av.x, ai = av.y;
            const f32x2 h0 = Hin[(size_t)((dir * NCH + j) * 32 + g) * 64 + lane]; float hr = h0.x, hi = h0.y;
#pragma unroll 1
            for (int i = 0; i < 64; ++i) {
                const int t = dir == 0 ? i : 63 - i;
                S5_STEP(ut + t * 16);
                float v[16];
#pragma unroll
                for (int c = 0; c < 16; ++c) v[c] = cr[c] * hr - ci[c] * hi;
                float w8[8], w4[4], w2[2], w1;
#pragma unroll
                for (int q = 0; q < 8; ++q) { const float snd = b32 ? v[q] : v[q + 8], kp = b32 ? v[q + 8] : v[q]; w8[q] = kp + __shfl_xor(snd, 32); }
#pragma unroll
                for (int q = 0; q < 4; ++q) { const float snd = b16 ? w8[q] : w8[q + 4], kp = b16 ? w8[q + 4] : w8[q]; w4[q] = kp + __shfl_xor(snd, 16); }
#pragma unroll
                for (int q = 0; q < 2; ++q) { const float snd = b8 ? w4[q] : w4[q + 2], kp = b8 ? w4[q + 2] : w4[q]; w2[q] = kp + __shfl_xor(snd, 8); }
                { const float snd = b4 ? w2[0] : w2[1], kp = b4 ? w2[1] : w2[0]; w1 = kp + __shfl_xor(snd, 4); }
                w1 += __shfl_xor(w1, 1); w1 += __shfl_xor(w1, 2);
                if ((lane & 3) == 0) yt[t * 16 + cidx] += w1;
            }
            __builtin_amdgcn_wave_barrier();
        }
        { float o[16];
#pragma unroll
          for (int c = 0; c < 16; ++c) o[c] = gelu_tanh(yt[lane * 16 + c]);
          u32x4 a, b; a.x = pk2(o[0], o[1]); a.y = pk2(o[2], o[3]); a.z = pk2(o[4], o[5]); a.w = pk2(o[6], o[7]); b.x = pk2(o[8], o[9]); b.y = pk2(o[10], o[11]); b.z = pk2(o[12], o[13]); b.w = pk2(o[14], o[15]);
          u32x4* dst = (u32x4*)(G + (size_t)(rc * 64 + lane) * 512 + g * 16); dst[0] = a; dst[1] = b; }
        __builtin_amdgcn_wave_barrier();
    }
}

__device__ __forceinline__ void qkv_post_phase(KP p, int lane, int wave) {
    const bf16* raw = (const bf16*)(p->ws + WS_QKV); bf16* Q = (bf16*)(p->ws + WS_Q); bf16* K = (bf16*)(p->ws + WS_K); bf16* V = (bf16*)(p->ws + WS_V);
    const float* R = (const float*)(p->ws + WS_ROPE);
    const int gw = blockIdx.x * 8 + wave, NGW = gridDim.x * 8;
    const int j = lane & 15, hq = lane >> 4;
    const f32x4 qn = ((const f32x4*)p->in[24])[j], kn = ((const f32x4*)p->in[25])[j];
    for (int r = gw; r < T; r += NGW) {
        const bool lat = r >= NCTX; const int tl = r - NCTX;
        const int pos = (j < 8) ? (tl >> 6) : (tl & 63);
        f32x4 cs0 = (f32x4){1.f, 0.f, 1.f, 0.f}, cs1 = cs0;
        if (lat) { const f32x4* rp = (const f32x4*)(R + (size_t)pos * 32 + 8 * (j & 3)); cs0 = rp[0]; cs1 = rp[1]; }
        const bool up = (j & 4) != 0;
        for (int pass = lat ? 0 : 4; pass < 5; ++pass) {
            const int col = pass < 4 ? (pass * 4 + hq) * 64 + 4 * j : 1024 + hq * 64 + 4 * j;
            const u32x2 w = *(const u32x2*)(raw + (size_t)r * NQKV + col);
            f32x4 x = (f32x4){bflo(w.x), bfhi(w.x), bflo(w.y), bfhi(w.y)};
            float ss = (x.x * x.x + x.y * x.y) + (x.z * x.z + x.w * x.w);
            ss += __shfl_xor(ss, 1); ss += __shfl_xor(ss, 2); ss += __shfl_xor(ss, 4); ss += __shfl_xor(ss, 8);
            const float rstd = rsqrtf(ss * (1.f / 64.f) + EPS);
            x = x * rstd * (pass < 4 ? qn : kn);
            if (lat) {
                f32x4 o; o.x = __shfl_xor(x.x, 4); o.y = __shfl_xor(x.y, 4); o.z = __shfl_xor(x.z, 4); o.w = __shfl_xor(x.w, 4);
                const float sg = up ? 1.f : -1.f;
                x.x = x.x * cs0.x + sg * o.x * cs0.y; x.y = x.y * cs0.z + sg * o.y * cs0.w; x.z = x.z * cs1.x + sg * o.z * cs1.y; x.w = x.w * cs1.z + sg * o.w * cs1.w;
            }
            if (pass < 4) { x = x * attn_body::C2; u32x2 o; o.x = pk2(x.x, x.y); o.y = pk2(x.z, x.w); *(u32x2*)(Q + (size_t)r * DM + (pass * 4 + hq) * 64 + 4 * j) = o; }
            else { u32x2 o; o.x = pk2(x.x, x.y); o.y = pk2(x.z, x.w); *(u32x2*)(K + (size_t)r * 256 + hq * 64 + 4 * j) = o; }
        }
        *(u32x2*)(V + (size_t)r * 256 + 4 * lane) = *(const u32x2*)(raw + (size_t)r * NQKV + 1280 + 4 * lane);
    }
}

template <class Epi> __device__ __forceinline__ void run_gemm(LAS3 unsigned char* lds3, const bf16* A, const bf16* Bt, int M, int N, int K, const Epi& E) {
    pg8::Gemm g{A, Bt, M, N, K}; pg8::StaticOrder S; S.init(M, N, (int)gridDim.x, (int)blockIdx.x);
    pg8::gemm_phase<Epi, pg8::StaticOrder, true, true>(lds3, g, S, E);
}
constexpr int NSTEP = 20;
__global__ void __launch_bounds__(512, 2) mega_fwd(Params p_unused) {
    extern __shared__ __attribute__((aligned(16))) unsigned char lds[];
    cg::grid_group grid = cg::this_grid();
    const size_t LO = (size_t)NCTX;
#pragma unroll 1
    for (int step = 0; step < NSTEP; ++step) {
        KP p = (KP)__builtin_amdgcn_kernarg_segment_ptr();
        asm volatile("" : "+s"(p));
        int tid_ = threadIdx.x; asm volatile("" : "+v"(tid_));
        const int tid = tid_, lane = tid & 63, wave = __builtin_amdgcn_readfirstlane(tid >> 6);
        unsigned char* ws = p->ws;
        const float* modv = (const float*)(ws + WS_MOD);
        const float* ng = p->in[6];
        bf16* H = (bf16*)(ws + WS_H); bf16* Y = (bf16*)(ws + WS_Y); bf16* HID = (bf16*)(ws + WS_BIG);
        float* XC = (float*)(ws + WS_XC);
        if (step == 0) prologue(p, lds, tid, lane, wave);
        else if (step == 3) pool_s5a_phase(p, lds, tid, lane, wave);
        else if (step == 4) s5b_phase(p, tid);
        else if (step == 5) s5c_phase(p, lds, lane, wave);
        else if (step == 13) qkv_post_phase(p, lane, wave);
        else if (step == 14) {
            const attn_body::AttnTensors AT{(const attn_body::bf16*)(ws + WS_Q) + LO * DM, (const attn_body::bf16*)(ws + WS_K), (const attn_body::bf16*)(ws + WS_V), (attn_body::bf16*)(ws + WS_Q) + LO * DM};
            const attn_body::StaticOrder S((int)gridDim.x, (int)blockIdx.x);
            attn_body::attn_phase<attn_body::StaticOrder>((char*)lds, AT, S);
        } else if (step == 1 || step == 8 || step == 11 || step == 16 || step == 19) {
            RowP ra; ra.xlat = p->out; ra.xctx = XC; ra.olat = p->out; ra.octx = XC; ra.Y = Y; ra.H = H; ra.r0 = 0;
            if (step == 1) { ra.xlat = p->in[0]; ra.xctx = p->in[2]; ra.Y = nullptr; ra.gA = ng; ra.gate = modv; ra.gB = ng + 0 * 1024; ra.shsc = modv + 0; }
            else if (step == 8) { ra.xlat = p->in[0]; ra.xctx = p->in[2]; ra.gA = ng + 1 * 1024; ra.gate = modv + 2048; ra.gB = ng + 2 * 1024; ra.shsc = modv + 3072; }
            else if (step == 11) { ra.gA = ng + 3 * 1024; ra.gate = modv + 5120; ra.gB = ng + 4 * 1024; ra.shsc = modv + 2 * 6144 + 0; }
            else if (step == 16) { ra.r0 = NCTX; ra.gA = ng + 5 * 1024; ra.gate = modv + 2 * 6144 + 2048; ra.gB = ng + 6 * 1024; ra.shsc = modv + 2 * 6144 + 3072; }
            else { ra.r0 = NCTX; ra.gA = ng + 7 * 1024; ra.gate = modv + 2 * 6144 + 5120; ra.gB = ng; ra.shsc = modv; ra.H = nullptr; }
            row_phase(ra, lane, wave);
        } else {
            int gk = 0; const bf16* gA = H; const bf16* gB = nullptr; int gM = T, gN = 1024, gK = 1024; bf16* gO = Y; int gld = 1024;
            switch (step) {
            case 2: gB = (const bf16*)(ws + WS_WIN); gO = (bf16*)(ws + WS_U); break;
            case 6: gk = 3; gA = (const bf16*)(ws + WS_G); gB = (const bf16*)(ws + WS_WGLU); gK = 512; gO = (bf16*)(ws + WS_Z); break;
            case 7: gA = (const bf16*)(ws + WS_Z); gB = (const bf16*)(ws + WS_WOUT); break;
            case 9: gk = 2; gB = (const bf16*)(ws + WS_W1_0); gN = 4096; gO = HID; gld = 4096; break;
            case 10: gA = HID; gB = (const bf16*)(ws + WS_W2_0); gK = 4096; break;
            case 12: gB = (const bf16*)(ws + WS_WQKV); gN = NQKV; gO = (bf16*)(ws + WS_QKV); gld = NQKV; break;
            case 15: gA = (const bf16*)(ws + WS_Q) + LO * DM; gB = (const bf16*)(ws + WS_WAO); gM = NLAT; gO = Y + LO * DM; break;
            case 17: gk = 2; gA = H + LO * DM; gB = (const bf16*)(ws + WS_W1_1); gM = NLAT; gN = 4096; gO = HID + LO * FF; gld = 4096; break;
            default: gA = HID + LO * FF; gB = (const bf16*)(ws + WS_W2_1); gM = NLAT; gK = 4096; gO = Y + LO * DM; break;
            }
            if (gk == 0) { pg8::EpiBf16<0> E{gO, gld}; run_gemm((LAS3 unsigned char*)lds, gA, gB, gM, gN, gK, E); }
            else if (gk == 2) { pg8::EpiBf16<2> E{gO, gld}; run_gemm((LAS3 unsigned char*)lds, gA, gB, gM, gN, gK, E); }
            else { pg8::EpiGlu E{gO, gld}; run_gemm((LAS3 unsigned char*)lds, gA, gB, gM, gN, gK, E); }
        }
        if (step != NSTEP - 1) grid.sync();
    }
}

extern "C" void kernel_launch(void* const* d_in, const int* in_sizes, int n_in, void* d_out, int out_size, void* d_ws, size_t ws_size, hipStream_t stream) {
    static int grid = 0;
    if (grid == 0) {
        if (n_in != 26 || out_size != NLAT * DM || ws_size < WS_END) { fprintf(stderr, "kernel_launch: unexpected shapes (n_in %d out %d ws %zu)\n", n_in, out_size, ws_size); grid = -1; return; }
        int dev = 0, cus = 0, per_cu = 0;
        (void)hipGetDevice(&dev); (void)hipDeviceGetAttribute(&cus, hipDeviceAttributeMultiprocessorCount, dev);
        if (hipFuncSetAttribute((const void*)mega_fwd, hipFuncAttributeMaxDynamicSharedMemorySize, LDS_TOTAL) != hipSuccess) { fprintf(stderr, "kernel_launch: hipFuncSetAttribute failed\n"); grid = -1; return; }
        if (hipOccupancyMaxActiveBlocksPerMultiprocessor(&per_cu, (const void*)mega_fwd, 512, LDS_TOTAL) != hipSuccess || per_cu < 1) { fprintf(stderr, "kernel_launch: occupancy query says %d\n", per_cu); per_cu = 1; (void)hipGetLastError(); }
        grid = cus * per_cu; if (grid > 256) grid = 256;
    }
    if (grid < 0) return;
    Params p{};
    for (int i = 0; i < 26; ++i) p.in[i] = (const float*)d_in[i];
    p.out = (float*)d_out; p.ws = (unsigned char*)d_ws;
    void* args[] = {&p};
    hipError_t e = hipLaunchCooperativeKernel((const void*)mega_fwd, dim3(grid), dim3(512), args, LDS_TOTAL, stream);
    if (e != hipSuccess) fprintf(stderr, "cooperative launch failed: %s (grid %d)\n", hipGetErrorString(e), grid);
}
```

```cpp
#include <hip/hip_runtime.h>
#include <hip/hip_cooperative_groups.h>
#include <cstdio>
#include <cstdint>
namespace cg = cooperative_groups;
namespace pg8 {
#define PG8_LAS __attribute__((address_space(3)))
typedef unsigned short bf16_t;
typedef short bf16x8 __attribute__((ext_vector_type(8)));
typedef float f32x4 __attribute__((ext_vector_type(4)));
typedef unsigned u32x4 __attribute__((ext_vector_type(4)));
constexpr int BM = 256, BK = 64, HALF = 128, HTB = HALF * BK * 2  , STAGE_BYTES = 8 * HTB, NXCD = 8, WGM = 8;

__host__ __device__ __forceinline__ int lds_byte(int r, int c) { const int st = (r >> 4) * 2 + (c >> 5), rr = r & 15, cc = c & 31, ob = rr * 64 + cc * 2; return st * 1024 + (ob ^ (((ob >> 9) & 1) << 5)); }
__host__ __device__ __forceinline__ void stage_rc(int b, int& R, int& C) { const int st = b / 1024, sb = b % 1024, swz = sb ^ (((sb >> 9) & 1) << 5); R = (st >> 1) * 16 + swz / 64; C = (st & 1) * 32 + (swz % 64) / 2; }
__host__ __device__ __forceinline__ int perm32(int rho) { const int n = rho >> 4, i = rho & 15; return 8 * (i >> 2) + 4 * n + (i & 3); }

struct Unit { int pm, pn; };
struct Gemm { const bf16_t* A; const bf16_t* Bt; int M, N, K; };

struct StaticOrder {
    int nM, nN, nwg, G, c;
    __host__ __device__ void init(int M, int N, int G_, int c_) { nM = M / BM; nN = N / BM; nwg = nM * nN; G = G_; c = c_; }
    __host__ __device__ bool next(int i, Unit& u) const {
        const long L = (long)i * G + c; if (L >= nwg) return false;
        int wgid = (int)L; { const int q = nwg / NXCD, r = nwg % NXCD, xcd = wgid % NXCD, off = wgid / NXCD; wgid = (xcd < r ? xcd * (q + 1) : r * (q + 1) + (xcd - r) * q) + off; }
        const int nig = WGM * nN, gid = wgid / nig, fm = gid * WGM, gsz = (nM - fm) < WGM ? (nM - fm) : WGM;
        u.pm = fm + ((wgid % nig) % gsz); u.pn = (wgid % nig) / gsz; return true;
    }
    __device__ __forceinline__ void a_ready(const Unit&) const {}
    __device__ __forceinline__ void done(const Unit&) const {}
};

__device__ __forceinline__ unsigned cvt_pk_bf16(float lo, float hi) { unsigned r; asm volatile("v_cvt_pk_bf16_f32 %0, %1, %2" : "=v"(r) : "v"(lo), "v"(hi)); return r; }
typedef float f32x2 __attribute__((ext_vector_type(2)));
template <int ACT> struct EpiBf16 {
    static constexpr bool PERM = true, AFTER_DRAIN = false;
    bf16_t* O; int ldc;
    __device__ __forceinline__ void operator()(const f32x4 (&acc)[2][2][4][2], const Unit& u, int wr, int wc, int fr, int fq) const {
        const int row0 = u.pm * BM + wr * 64 + fr; const int col0 = u.pn * BM + wc * 32 + 8 * fq;
#pragma unroll
        for (int ai = 0; ai < 2; ++ai)
#pragma unroll
            for (int m = 0; m < 4; ++m) { bf16_t* rowp = O + (size_t)(row0 + ai * HALF + m * 16) * ldc + col0;
#pragma unroll
                for (int bj = 0; bj < 2; ++bj) { f32x4 v0 = acc[ai][bj][m][0], v1 = acc[ai][bj][m][1];
                    if (ACT == 2) {
#pragma unroll
                        for (int e = 0; e < 4; ++e) { float a = v0[e] > 0.f ? v0[e] : 0.f; v0[e] = a * a; float b = v1[e] > 0.f ? v1[e] : 0.f; v1[e] = b * b; } }
                    u32x4 w; w.x = cvt_pk_bf16(v0[0], v0[1]); w.y = cvt_pk_bf16(v0[2], v0[3]); w.z = cvt_pk_bf16(v1[0], v1[1]); w.w = cvt_pk_bf16(v1[2], v1[3]);
                    *(u32x4*)(rowp + bj * HALF) = w; } }
    }
};
struct EpiGlu {
    static constexpr bool PERM = true, AFTER_DRAIN = false;
    bf16_t* O; int ldc;
    __device__ __forceinline__ void operator()(const f32x4 (&acc)[2][2][4][2], const Unit& u, int wr, int wc, int fr, int fq) const {
        const int row0 = u.pm * BM + wr * 64 + fr; const int col0 = u.pn * HALF + wc * 32 + 8 * fq;
#pragma unroll
        for (int ai = 0; ai < 2; ++ai)
#pragma unroll
            for (int m = 0; m < 4; ++m) { bf16_t* rowp = O + (size_t)(row0 + ai * HALF + m * 16) * ldc + col0;
                f32x4 v0 = acc[ai][0][m][0], v1 = acc[ai][0][m][1]; const f32x4 g0 = acc[ai][1][m][0], g1 = acc[ai][1][m][1];
#pragma unroll
                for (int e = 0; e < 4; ++e) { v0[e] = v0[e] / (1.f + __expf(-g0[e])); v1[e] = v1[e] / (1.f + __expf(-g1[e])); }
                u32x4 w; w.x = cvt_pk_bf16(v0[0], v0[1]); w.y = cvt_pk_bf16(v0[2], v0[3]); w.z = cvt_pk_bf16(v1[0], v1[1]); w.w = cvt_pk_bf16(v1[2], v1[3]);
                *(u32x4*)rowp = w; }
    }
};
template <class Epi, class Sched, bool ALIGN_EPI = false, bool SP2 = false>
__device__ __forceinline__ void gemm_phase(PG8_LAS unsigned char* lds, const Gemm g, const Sched& S, const Epi& E) {
    int tid_ = threadIdx.x; asm volatile("" : "+v"(tid_)); const int tid = tid_, wid = __builtin_amdgcn_readfirstlane(tid >> 6), lane = tid & 63, wr = wid >> 2, wc = wid & 3, fr = lane & 15, fq = lane >> 4;
    const int K = g.K, nt = K / BK;
    unsigned voffA[2], voffB[2];
#pragma unroll
    for (int i = 0; i < 2; ++i) { int R, C; stage_rc(tid * 16 + i * 8192, R, C); const int Rb = Epi::PERM ? ((R & ~31) + perm32(R & 31)) : R;
        voffA[i] = (unsigned)(R * K + C) * 2u; voffB[i] = (unsigned)(Rb * K + C) * 2u; }
    const size_t kstep = (size_t)(BK * 2);
    const size_t hstep = (size_t)HALF * K * 2;
    const size_t tstep = 2 * hstep;
    const unsigned ldsw = (unsigned)wid * 1024u;
    const int aoff = lds_byte(wr * 64 + fr, fq * 8), boff = lds_byte(wc * 32 + fr, fq * 8);
#define PG8_SA(b, h) (((b) * 2 + (h)) * HTB)
#define PG8_SB(b, h) ((4 + (b) * 2 + (h)) * HTB)
#define PG8_STAGE(bufoff, gbase, voff) do { _Pragma("unroll") for (int _i = 0; _i < 2; ++_i) \
        __builtin_amdgcn_global_load_lds((const unsigned*)((const char*)(gbase) + (voff)[_i]), (PG8_LAS unsigned*)(lds + (bufoff) + ldsw + _i * 8192), 16, 0, 0); } while (0)
#define PG8_LDA(dst, b, h) do { _Pragma("unroll") for (int m = 0; m < 4; ++m) _Pragma("unroll") for (int k = 0; k < 2; ++k) dst[m][k] = *(const PG8_LAS bf16x8*)(lds + PG8_SA(b, h) + aoff + m * 2048 + k * 1024); } while (0)
#define PG8_LDB(dst, b, h) do { _Pragma("unroll") for (int n = 0; n < 2; ++n) _Pragma("unroll") for (int k = 0; k < 2; ++k) dst[n][k] = *(const PG8_LAS bf16x8*)(lds + PG8_SB(b, h) + boff + n * 2048 + k * 1024); } while (0)
#define PG8_MMA(ai, bj, At, Bt) do { __builtin_amdgcn_s_setprio(1); _Pragma("unroll") for (int m = 0; m < 4; ++m) _Pragma("unroll") for (int n = 0; n < 2; ++n) _Pragma("unroll") for (int k = 0; k < 2; ++k) \
        acc[ai][bj][m][n] = __builtin_amdgcn_mfma_f32_16x16x32_bf16(Bt[n][k], At[m][k], acc[ai][bj][m][n], 0, 0, 0); __builtin_amdgcn_s_setprio(0); } while (0)
#define PG8_WAIT_V(n) asm volatile("s_waitcnt vmcnt(" #n ")" ::: "memory")
#define PG8_WAIT_L(n) asm volatile("s_waitcnt lgkmcnt(" #n ")" ::: "memory")
#define PG8_BAR __builtin_amdgcn_s_barrier()
#define PG8_SCHED __builtin_amdgcn_sched_barrier(0)
    Unit cur, nxt; int ui = 0;
    if (!S.next(0, cur)) return;
    f32x4 acc[2][2][4][2];
#pragma unroll
    for (int a = 0; a < 2; ++a)
#pragma unroll
        for (int b = 0; b < 2; ++b)
#pragma unroll
            for (int m = 0; m < 4; ++m)
#pragma unroll
                for (int n = 0; n < 2; ++n) acc[a][b][m][n] = (f32x4){0.f, 0.f, 0.f, 0.f};
    bf16x8 At[4][2], B0[2][2], B1[2][2];
    const char* cA = (const char*)g.A + (size_t)cur.pm * tstep; const char* cB = (const char*)g.Bt + (size_t)cur.pn * tstep;
    S.a_ready(cur);
    if constexpr (SP2) {
        PG8_STAGE(PG8_SB(0, 0), cB, voffB); PG8_STAGE(PG8_SB(0, 1), cB + hstep, voffB); PG8_STAGE(PG8_SA(0, 0), cA, voffA); PG8_STAGE(PG8_SA(0, 1), cA + hstep, voffA);
        if (wr == 1) PG8_BAR;
        PG8_WAIT_V(2); PG8_BAR;
        PG8_STAGE(PG8_SB(1, 0), cB + kstep, voffB); PG8_STAGE(PG8_SA(1, 0), cA + kstep, voffA); PG8_STAGE(PG8_SB(1, 1), cB + hstep + kstep, voffB);
        PG8_WAIT_V(6); PG8_BAR;
    } else {
        PG8_STAGE(PG8_SB(0, 0), cB, voffB); PG8_STAGE(PG8_SA(0, 0), cA, voffA); PG8_STAGE(PG8_SB(0, 1), cB + hstep, voffB); PG8_STAGE(PG8_SA(0, 1), cA + hstep, voffA);
        if (wr == 1) PG8_BAR;
        PG8_WAIT_V(4); PG8_BAR;
        PG8_STAGE(PG8_SB(1, 0), cB + kstep, voffB); PG8_STAGE(PG8_SA(1, 0), cA + kstep, voffA); PG8_STAGE(PG8_SB(1, 1), cB + hstep + kstep, voffB);
        PG8_WAIT_V(6); PG8_BAR;
    }
    for (;;) {
        const bool has_next = S.next(ui + 1, nxt);
        const char* nA = has_next ? (const char*)g.A + (size_t)nxt.pm * tstep : cA; const char* nB = has_next ? (const char*)g.Bt + (size_t)nxt.pn * tstep : cB;
        for (int t = 0; t < nt; t += 2) {
            const bool last = (t == nt - 2);
            const char* a1 = cA + (size_t)(t + 1) * kstep;
            const char* a2 = last ? nA : cA + (size_t)(t + 2) * kstep; const char* b2 = last ? nB : cB + (size_t)(t + 2) * kstep;
            const char* a3 = a2 + kstep; const char* b3 = b2 + kstep;
            if (last && has_next) S.a_ready(nxt);
            if constexpr (SP2) {
            PG8_LDB(B0, 0, 0); PG8_LDB(B1, 0, 1); PG8_SCHED; PG8_LDA(At, 0, 0); PG8_STAGE(PG8_SA(1, 1), a1 + hstep, voffA);
            PG8_WAIT_V(8); PG8_WAIT_L(0); PG8_BAR; PG8_MMA(0, 0, At, B0); PG8_MMA(0, 1, At, B1); PG8_BAR; PG8_SCHED;
            PG8_LDA(At, 0, 1); PG8_STAGE(PG8_SB(0, 0), b2, voffB); PG8_STAGE(PG8_SB(0, 1), b2 + hstep, voffB); PG8_STAGE(PG8_SA(0, 0), a2, voffA);
            PG8_WAIT_V(8); PG8_WAIT_L(0); PG8_BAR; PG8_MMA(1, 0, At, B0); PG8_MMA(1, 1, At, B1); PG8_BAR; PG8_SCHED;
            PG8_LDB(B0, 1, 0); PG8_LDB(B1, 1, 1); PG8_SCHED; PG8_LDA(At, 1, 0); PG8_STAGE(PG8_SA(0, 1), a2 + hstep, voffA);
            PG8_WAIT_V(8); PG8_WAIT_L(0); PG8_BAR; PG8_MMA(0, 0, At, B0); PG8_MMA(0, 1, At, B1); PG8_BAR; PG8_SCHED;
            PG8_LDA(At, 1, 1); PG8_STAGE(PG8_SB(1, 0), b3, voffB); PG8_STAGE(PG8_SB(1, 1), b3 + hstep, voffB); PG8_STAGE(PG8_SA(1, 0), a3, voffA);
            PG8_WAIT_V(8); PG8_WAIT_L(0); PG8_BAR; PG8_MMA(1, 0, At, B0); PG8_MMA(1, 1, At, B1); PG8_BAR; PG8_SCHED;
            } else {
            PG8_LDB(B0, 0, 0); PG8_SCHED; PG8_LDA(At, 0, 0); PG8_STAGE(PG8_SA(1, 1), a1 + hstep, voffA);
            PG8_WAIT_L(8); PG8_BAR; PG8_WAIT_L(0); PG8_MMA(0, 0, At, B0); PG8_BAR; PG8_SCHED;
            PG8_LDB(B1, 0, 1); PG8_STAGE(PG8_SB(0, 0), b2, voffB);
            PG8_BAR; PG8_WAIT_L(0); PG8_MMA(0, 1, At, B1); PG8_BAR;
            PG8_LDA(At, 0, 1); PG8_STAGE(PG8_SA(0, 0), a2, voffA);
            PG8_BAR; PG8_WAIT_L(0); PG8_MMA(1, 0, At, B0); PG8_BAR; PG8_SCHED;
            PG8_STAGE(PG8_SB(0, 1), b2 + hstep, voffB);
            PG8_WAIT_V(6); PG8_BAR; PG8_MMA(1, 1, At, B1); PG8_BAR;
            PG8_LDB(B0, 1, 0); PG8_SCHED; PG8_LDA(At, 1, 0); PG8_STAGE(PG8_SA(0, 1), a2 + hstep, voffA);
            PG8_WAIT_L(8); PG8_BAR; PG8_WAIT_L(0); PG8_MMA(0, 0, At, B0); PG8_BAR; PG8_SCHED;
            PG8_LDB(B1, 1, 1); PG8_STAGE(PG8_SB(1, 0), b3, voffB);
            PG8_BAR; PG8_WAIT_L(0); PG8_MMA(0, 1, At, B1); PG8_BAR;
            PG8_LDA(At, 1, 1); PG8_STAGE(PG8_SA(1, 0), a3, voffA);
            PG8_BAR; PG8_WAIT_L(0); PG8_MMA(1, 0, At, B0); PG8_BAR; PG8_SCHED;
            PG8_STAGE(PG8_SB(1, 1), b3 + hstep, voffB);
            PG8_WAIT_V(6); PG8_BAR; PG8_MMA(1, 1, At, B1); PG8_BAR;
            }
        }
        if constexpr (ALIGN_EPI) { if (wr == 0) PG8_BAR; }
        if constexpr (!Epi::AFTER_DRAIN) { E(acc, cur, wr, wc, fr, fq); S.done(cur); }
        if (!has_next) break;
#pragma unroll
        for (int a = 0; a < 2; ++a)
#pragma unroll
            for (int b = 0; b < 2; ++b)
#pragma unroll
                for (int m = 0; m < 4; ++m)
#pragma unroll
                    for (int n = 0; n < 2; ++n) acc[a][b][m][n] = (f32x4){0.f, 0.f, 0.f, 0.f};
        cur = nxt; cA = nA; cB = nB; ++ui;
        if constexpr (ALIGN_EPI) { if (wr == 1) PG8_BAR; }
    }
    PG8_WAIT_V(0);
    if constexpr (!ALIGN_EPI) { if (wr == 0) PG8_BAR; }
    PG8_BAR;
    if constexpr (Epi::AFTER_DRAIN) { E.fused(acc, cur, wr, wc, fr, fq, lds, wid, lane); S.done(cur); }
#undef PG8_SA
#undef PG8_SB
#undef PG8_STAGE
#undef PG8_LDA
#undef PG8_LDB
#undef PG8_MMA
#undef PG8_WAIT_V
#undef PG8_WAIT_L
#undef PG8_BAR
#undef PG8_SCHED
}
}
#include <hip/hip_bf16.h>
#include <cmath>
namespace attn_body {
using bf16=__hip_bfloat16;
using bf16x8=__attribute__((ext_vector_type(8)))short;
using s16x4=__attribute__((ext_vector_type(4)))short;
using f32x16=__attribute__((ext_vector_type(16)))float;
using u32x4=__attribute__((ext_vector_type(4)))unsigned;
constexpr int BATCH=1,NHEAD=16,SEQ=16384,D=64,DM=NHEAD*D,KVP=256,NKT=260;
constexpr int NW=8,QBLK=32,QB=QBLK*NW,KVBLK=64,NQB=SEQ/QB;
constexpr int ATTN_PITCH=DM, ATTN_UNIT_ROWS=QB;
__device__ __forceinline__ int crow(int r,int hi){return (r&3)+8*(r>>2)+4*hi;}
#define SBAR() __builtin_amdgcn_sched_barrier(0)
__device__ __forceinline__ void cmask(f32x16&p0,f32x16&p1,int jb,int qrel,int hi){
  const float NEG=-INFINITY; int kb=64*jb+4*hi;
  #pragma unroll
  for(int r=0;r<16;++r){int kv=kb+(r&3)+8*(r>>2); if(kv>qrel)p0[r]=NEG; if(kv+32>qrel)p1[r]=NEG;}
}

constexpr int NSLOT=3, SLOTB=8192;
constexpr int LDS_K=0, LDS_V=NSLOT*SLOTB, LDS_WS=2*NSLOT*SLOTB, LDS_OST=LDS_WS+NW*64*4, LDS_BYTES=LDS_OST+NW*4096;
constexpr float C2=0.125f*1.4426950408889634f;
__device__ __forceinline__ void glds16(const void*gsrc,unsigned lds_dst){unsigned keep;
  asm volatile("s_mov_b32 %0, m0\n\ts_mov_b32 m0, %2\n\ts_nop 0\n\tglobal_load_lds_dwordx4 %1, off\n\ts_mov_b32 m0, %0":"=&s"(keep):"v"(gsrc),"s"(lds_dst):"memory");}
__device__ __forceinline__ float max3f(float a,float b,float c){float r;asm("v_max3_f32 %0, %1, %2, %3":"=v"(r):"v"(a),"v"(b),"v"(c));return r;}
__device__ __forceinline__ float max2f(float a,float b){float r;asm("v_max_f32_e32 %0, %1, %2":"=v"(r):"v"(a),"v"(b));return r;}
__device__ __forceinline__ float fadd_s(float a,float b){float r;asm("v_add_f32_e32 %0, %1, %2":"=v"(r):"v"(a),"v"(b));return r;}
__device__ __forceinline__ float fsub_s(float a,float b){float r;asm("v_sub_f32_e32 %0, %1, %2":"=v"(r):"v"(a),"v"(b));return r;}
typedef float f32x2_t __attribute__((ext_vector_type(2))); typedef __bf16 bf16x2_t __attribute__((ext_vector_type(2)));
__device__ __forceinline__ unsigned cvtpk_s(float lo,float hi){f32x2_t v={lo,hi};bf16x2_t b=__builtin_convertvector(v,bf16x2_t);return __builtin_bit_cast(unsigned,b);}
#define WAIT_BAR(N) asm volatile("s_waitcnt vmcnt(" #N ") lgkmcnt(0)\n\ts_barrier":::"memory")

__device__ __forceinline__ void qkt(f32x16&p0,f32x16&p1,const char*Kslot,const bf16x8*qr,const f32x16&negm,int r32,int hi){
  const char*kb=Kslot+hi*1024+r32*16;
  #pragma unroll
  for(int d0=0;d0<4;++d0){
    const bf16x8 b0=*reinterpret_cast<const bf16x8*>(kb+d0*2048);
    const bf16x8 b1=*reinterpret_cast<const bf16x8*>(kb+d0*2048+512);
    if(d0==0){p0=__builtin_amdgcn_mfma_f32_32x32x16_bf16(b0,qr[0],negm,0,0,0);p1=__builtin_amdgcn_mfma_f32_32x32x16_bf16(b1,qr[0],negm,0,0,0);}
    else{p0=__builtin_amdgcn_mfma_f32_32x32x16_bf16(b0,qr[d0],p0,0,0,0);p1=__builtin_amdgcn_mfma_f32_32x32x16_bf16(b1,qr[d0],p1,0,0,0);}}
}
typedef __attribute__((address_space(3))) const char* lds_cptr;
typedef short v4i16_t __attribute__((ext_vector_type(4)));
__device__ __forceinline__ void kload8(bf16x8*kf,lds_cptr kp){
  kf[0]=*(const __attribute__((address_space(3))) bf16x8*)(kp);      kf[1]=*(const __attribute__((address_space(3))) bf16x8*)(kp+512);
  kf[2]=*(const __attribute__((address_space(3))) bf16x8*)(kp+2048); kf[3]=*(const __attribute__((address_space(3))) bf16x8*)(kp+2560);
  kf[4]=*(const __attribute__((address_space(3))) bf16x8*)(kp+4096); kf[5]=*(const __attribute__((address_space(3))) bf16x8*)(kp+4608);
  kf[6]=*(const __attribute__((address_space(3))) bf16x8*)(kp+6144); kf[7]=*(const __attribute__((address_space(3))) bf16x8*)(kp+6656);
}
__device__ __forceinline__ void kload2(bf16x8*kf,lds_cptr kp,int j){ kf[2*j]=*(const __attribute__((address_space(3))) bf16x8*)(kp+j*2048); kf[2*j+1]=*(const __attribute__((address_space(3))) bf16x8*)(kp+j*2048+512); }
__device__ __forceinline__ s16x4 vtr(lds_cptr p){ return __builtin_bit_cast(s16x4,__builtin_amdgcn_ds_read_tr16_b64_v4i16((__attribute__((address_space(3))) v4i16_t*)p)); }
__device__ __forceinline__ float rowmax(const f32x16&p0,const f32x16&p1){
  float a=max3f(p0[0],p0[1],p1[0]),b=max3f(p0[2],p0[3],p1[1]);a=max3f(a,p1[2],p1[3]);
  #pragma unroll
  for(int r=4;r<16;r+=4){a=max3f(a,p0[r],p0[r+1]);b=max3f(b,p0[r+2],p0[r+3]);a=max3f(a,p1[r],p1[r+1]);b=max3f(b,p1[r+2],p1[r+3]);}
  const float m=max2f(a,b);
  auto rr=__builtin_amdgcn_permlane32_swap(__float_as_uint(m),__float_as_uint(m),false,false);
  return max2f(__uint_as_float(rr[0]),__uint_as_float(rr[1]));
}
__device__ __forceinline__ void pv(f32x16*o,int vb,bf16x8 pa0,bf16x8 pa1,bf16x8 pa2,bf16x8 pa3){
  #pragma unroll
  for(int d0=0;d0<2;++d0){s16x4 lo[4],hi[4];
    #pragma unroll
    for(int ks=0;ks<4;++ks){
      asm volatile("ds_read_b64_tr_b16 %0,%1 offset:%c2":"=&v"(lo[ks]):"v"(vb),"i"(d0*4096+ks*1024):"memory");
      asm volatile("ds_read_b64_tr_b16 %0,%1 offset:%c2":"=&v"(hi[ks]):"v"(vb),"i"(d0*4096+ks*1024+512):"memory");}
    asm volatile("s_waitcnt lgkmcnt(0)":::"memory");SBAR();
    #define PK(k) (bf16x8){lo[k][0],lo[k][1],lo[k][2],lo[k][3],hi[k][0],hi[k][1],hi[k][2],hi[k][3]}
    o[d0]=__builtin_amdgcn_mfma_f32_32x32x16_bf16(pa0,PK(0),o[d0],0,0,0);
    o[d0]=__builtin_amdgcn_mfma_f32_32x32x16_bf16(pa1,PK(1),o[d0],0,0,0);
    o[d0]=__builtin_amdgcn_mfma_f32_32x32x16_bf16(pa2,PK(2),o[d0],0,0,0);
    o[d0]=__builtin_amdgcn_mfma_f32_32x32x16_bf16(pa3,PK(3),o[d0],0,0,0);
    #undef PK
  }
}

#ifndef ATTN_STORE16
#define ATTN_STORE16(p,v) (*(u32x4*)(p)=(v))
#endif
template<int THRL> __device__ __forceinline__ void attn_unit(int b,int h,int qb,const bf16*Q,const bf16*__restrict__ K,const bf16*__restrict__ V,bf16*O,char*shm){
  int tid_=threadIdx.x; asm volatile("":"+v"(tid_)); const int tid=tid_,lane=tid&63,r32=lane&31,hi=lane>>5; const int wid=__builtin_amdgcn_readfirstlane(tid>>6);
  const long rowbase=(long)b*SEQ; const int q0=qb*QB;
  const bf16*Qw=Q+(rowbase+q0+wid*QBLK)*DM+h*D;
  const bf16*Kh=K+(h>>2)*D,*Vh=V+(h>>2)*D;
  const unsigned lds0=(unsigned)(uintptr_t)shm;
  float*wsf=(float*)(shm+LDS_WS)+wid*64;
  const bf16*ksrc=Kh+(long)lane*KVP+wid*8;
  const bf16*vsrc=Vh+(long)(16*(wid&3)+(lane>>2))*KVP+(wid>>2)*32+(lane&3)*8;
  const unsigned kdst=lds0+LDS_K+wid*1024, vdst=lds0+LDS_V+wid*1024;
  #define DMA_K(t,slot) glds16(ksrc+(long)(t)*KVBLK*KVP,(unsigned)__builtin_amdgcn_readfirstlane(kdst+(slot)))
  #define DMA_V(t,slot) glds16(vsrc+(long)(t)*KVBLK*KVP,(unsigned)__builtin_amdgcn_readfirstlane(vdst+(slot)))
  const int vb0=(int)(lds0+LDS_V)+((lane>>4)&1)*32+(lane&3)*8+(4*hi+((lane&15)>>2))*64;
  const char*Kbase=shm+LDS_K; bf16x8 kf[8];
  const lds_cptr shm3=(lds_cptr)shm; const lds_cptr kp0=shm3+LDS_K+hi*1024+r32*16; const lds_cptr vp0=shm3+LDS_V+((lane>>4)&1)*32+(lane&3)*8+(4*hi+((lane&15)>>2))*64;
  const int NT=NKT;
  DMA_K(0,0);DMA_V(0,0);DMA_K(1,SLOTB);
  bf16x8 qr[4];
  #pragma unroll
  for(int d0=0;d0<4;++d0)qr[d0]=*reinterpret_cast<const bf16x8*>(&Qw[(long)r32*DM+d0*16+hi*8]);
  float mhat=0.f,l_reg=0.f;f32x16 o[2];o[0]=f32x16{};o[1]=f32x16{};f32x16 negm=f32x16{};asm volatile("":"+v"(negm));
  const int qrel=wid*QBLK+r32;
  #define CMASK(P0,P1,t) do{}while(0)
  bool resc=false;
  #define START(P0,P1) do{ const float rm=rowmax(P0,P1); resc=false; \
    { const float dl=rm; mhat=fadd_s(mhat,dl); \
      _Pragma("unroll") for(int r=0;r<16;++r){P0[r]=fsub_s(P0[r],dl);P1[r]=fsub_s(P1[r],dl);} \
      _Pragma("unroll") for(int r=0;r<16;++r)negm[r]=-mhat; asm volatile("":"+v"(negm)); } \
    _Pragma("unroll") for(int r=0;r<16;++r)P0[r]=__builtin_amdgcn_exp2f(P0[r]); }while(0)
  #define RESC() do{ if(resc){ asm volatile("s_waitcnt lgkmcnt(0)":::"memory"); \
      _Pragma("unroll") for(int d_=0;d_<2;++d_) _Pragma("unroll") for(int r=0;r<16;++r)o[d_][r]*=wsf[crow(r,hi)]; } }while(0)
  f32x16 pA0,pA1,pB0,pB1;
  int sl_prev=0,sl_cur=0,sl_next=SLOTB;
  #define ROT() do{sl_prev=sl_cur;sl_cur=sl_next;sl_next=(sl_next==(NSLOT-1)*SLOTB)?0:sl_next+SLOTB;}while(0)
  DMA_K(2,2*SLOTB);
  WAIT_BAR(3);
  qkt(pA0,pA1,Kbase,qr,negm,r32,hi);asm volatile("s_nop 15\n\ts_nop 7":"+v"(pA0),"+v"(pA1));CMASK(pA0,pA1,0);
  START(pA0,pA1);
  _Pragma("unroll") for(int r=0;r<16;++r)pA1[r]=__builtin_amdgcn_exp2f(pA1[r]);
  WAIT_BAR(0);
  DMA_K(3,0);DMA_V(1,SLOTB);
  ROT();
  kload8(kf,kp0+sl_cur);
  WAIT_BAR(2);
  s16x4 vlo[8],vhi[8]; u32x4 pw0,pw1,pw2,pw3;
  #define PKW(P,B) cvtpk_s(P[B],P[B+1])
  #define PAF(k) __builtin_bit_cast(bf16x8,pw##k)
  #define VFR(i) (bf16x8){vlo[i][0],vlo[i][1],vlo[i][2],vlo[i][3],vhi[i][0],vhi[i][1],vhi[i][2],vhi[i][3]}
  #define PIN(x) asm volatile("":"+v"(x))
  #define MX3(a,b,c) __builtin_fmaxf(__builtin_fmaxf((a),(b)),(c))
  #define GAPA(MF,A0,A1,A2,A3,W0,W1,PW) do{ MF; sacc+=A0; sacc+=A1; sacc+=A2; sacc+=A3; PIN(sacc); W0; W1; PIN(PW); SBAR(); }while(0)
  #define EX(v) __builtin_amdgcn_exp2f(v)
  #define GAPB(MF,X,B) do{ MF; X[B]=EX(X[B]); X[B+1]=EX(X[B+1]); X[B+2]=EX(X[B+2]); X[B+3]=EX(X[B+3]); PIN(X); SBAR(); }while(0)
  #define VRD(i) do{ vlo[i]=vtr(vp_+(((i)>>2)*4096+((i)&3)*1024)); vhi[i]=vtr(vp_+(((i)>>2)*4096+((i)&3)*1024+512)); }while(0)
  #define KRD(G,j) do{ if(G){ kload2(kf,kp0+sl_next,j); SBAR(); } }while(0)
  #define STEP(C0,C1,P0,P1,t,GK,GV,GL) do{ SBAR(); \
    const lds_cptr vp_=vp0+sl_prev; \
    VRD(0); SBAR(); float sacc=(P0[0]+P0[1]); \
    GAPA(C0=__builtin_amdgcn_mfma_f32_32x32x16_bf16(kf[0],qr[0],negm,0,0,0), P0[2],P0[3],P0[4],P0[5],     pw0[0]=PKW(P0,0), pw0[1]=PKW(P0,2), pw0); \
    VRD(4); SBAR(); GAPA(C1=__builtin_amdgcn_mfma_f32_32x32x16_bf16(kf[1],qr[0],negm,0,0,0), P0[6],P0[7],P0[8],P0[9],     pw0[2]=PKW(P0,4), pw0[3]=PKW(P0,6), pw0); \
    VRD(1); SBAR(); GAPA(C0=__builtin_amdgcn_mfma_f32_32x32x16_bf16(kf[2],qr[1],C0,0,0,0),   P0[10],P0[11],P0[12],P0[13], pw1[0]=PKW(P0,8), pw1[1]=PKW(P0,10), pw1); \
    VRD(5); SBAR(); GAPA(C1=__builtin_amdgcn_mfma_f32_32x32x16_bf16(kf[3],qr[1],C1,0,0,0),   P0[14],P0[15],P1[0],P1[1],   pw1[2]=PKW(P0,12),pw1[3]=PKW(P0,14), pw1); \
    VRD(2); SBAR(); GAPA(C0=__builtin_amdgcn_mfma_f32_32x32x16_bf16(kf[4],qr[2],C0,0,0,0),   P1[2],P1[3],P1[4],P1[5],     pw2[0]=PKW(P1,0), pw2[1]=PKW(P1,2), pw2); \
    VRD(6); SBAR(); GAPA(C1=__builtin_amdgcn_mfma_f32_32x32x16_bf16(kf[5],qr[2],C1,0,0,0),   P1[6],P1[7],P1[8],P1[9],     pw2[2]=PKW(P1,4), pw2[3]=PKW(P1,6), pw2); \
    VRD(3); SBAR(); GAPA(C0=__builtin_amdgcn_mfma_f32_32x32x16_bf16(kf[6],qr[3],C0,0,0,0),   P1[10],P1[11],P1[12],P1[13], pw3[0]=PKW(P1,8), pw3[1]=PKW(P1,10), pw3); \
    VRD(7); SBAR(); GAPA(C1=__builtin_amdgcn_mfma_f32_32x32x16_bf16(kf[7],qr[3],C1,0,0,0),   P1[14],P1[15],0.f,0.f,       pw3[2]=PKW(P1,12),pw3[3]=PKW(P1,14), pw3); \
    l_reg+=sacc; \
    if(GK){DMA_K((t)+3,sl_cur);} if(GV){DMA_V((t)+1,sl_next);} \
    CMASK(C0,C1,t); \
    { float a=MX3(C0[0],C0[1],C1[0]),b=MX3(C0[2],C0[3],C1[1]); a=MX3(a,C1[2],C1[3]); \
      _Pragma("unroll") for(int r=4;r<16;r+=4){a=MX3(a,C0[r],C0[r+1]);b=MX3(b,C0[r+2],C0[r+3]);a=MX3(a,C1[r],C1[r+1]);b=MX3(b,C1[r+2],C1[r+3]);} \
      float rm=__builtin_fmaxf(a,b); { auto rr=__builtin_amdgcn_permlane32_swap(__float_as_uint(rm),__float_as_uint(rm),false,false); rm=__builtin_fmaxf(__uint_as_float(rr[0]),__uint_as_float(rr[1])); } \
      resc=false; \
      if(__builtin_expect(__any(rm>(float)THRL),0)){ const float dl=__builtin_fmaxf(rm,0.f); mhat+=dl; \
        _Pragma("unroll") for(int r=0;r<16;++r){C0[r]-=dl;C1[r]-=dl;} \
        _Pragma("unroll") for(int r=0;r<16;++r)negm[r]=-mhat; asm volatile("":"+v"(negm)); \
        const float f=__builtin_amdgcn_exp2f(-dl); l_reg*=f; if(hi==0)wsf[r32]=f; resc=true; } } \
    SBAR(); \
    GAPB(o[0]=__builtin_amdgcn_mfma_f32_32x32x16_bf16(PAF(0),VFR(0),o[0],0,0,0), C0,0); \
    GAPB(o[1]=__builtin_amdgcn_mfma_f32_32x32x16_bf16(PAF(0),VFR(4),o[1],0,0,0), C0,4); \
    KRD(GL,0); GAPB(o[0]=__builtin_amdgcn_mfma_f32_32x32x16_bf16(PAF(1),VFR(1),o[0],0,0,0), C0,8); \
    KRD(GL,1); GAPB(o[1]=__builtin_amdgcn_mfma_f32_32x32x16_bf16(PAF(1),VFR(5),o[1],0,0,0), C0,12); \
    KRD(GL,2); GAPB(o[0]=__builtin_amdgcn_mfma_f32_32x32x16_bf16(PAF(2),VFR(2),o[0],0,0,0), C1,0); \
    KRD(GL,3); GAPB(o[1]=__builtin_amdgcn_mfma_f32_32x32x16_bf16(PAF(2),VFR(6),o[1],0,0,0), C1,4); \
    GAPB(o[0]=__builtin_amdgcn_mfma_f32_32x32x16_bf16(PAF(3),VFR(3),o[0],0,0,0), C1,8); \
    GAPB(o[1]=__builtin_amdgcn_mfma_f32_32x32x16_bf16(PAF(3),VFR(7),o[1],0,0,0), C1,12); \
    }while(0)
  int t=1;
  #undef CMASK
  #define CMASK(P0,P1,t) do{}while(0)
  for(;t+5<NT;t+=2){
    STEP(pB0,pB1,pA0,pA1,t,true,true,true);     WAIT_BAR(2); RESC(); ROT();
    STEP(pA0,pA1,pB0,pB1,t+1,true,true,true);   WAIT_BAR(2); RESC(); ROT();
  }
  #undef CMASK
  #define CMASK(P0,P1,t) do{}while(0)
  #define ENDW(tt) do{ if((tt)+3<NT){WAIT_BAR(2);} else if((tt)+2<NT){WAIT_BAR(1);} else {WAIT_BAR(0);} }while(0)
  for(;t+1<NT;t+=2){
    STEP(pB0,pB1,pA0,pA1,t,(t+3<NT),(t+1<NT),(t+1<NT));       ENDW(t);   RESC(); ROT();
    STEP(pA0,pA1,pB0,pB1,t+1,(t+4<NT),(t+2<NT),(t+2<NT));     ENDW(t+1); RESC(); ROT();
  }
  STEP(pB0,pB1,pA0,pA1,NT-1,false,false,false); RESC();
  { float sacc=pB0[0]+pB0[1]; _Pragma("unroll") for(int r=2;r<16;++r)sacc+=pB0[r]; _Pragma("unroll") for(int r=0;r<16;++r)sacc+=pB1[r]; l_reg+=sacc;
    pw0=(u32x4){PKW(pB0,0),PKW(pB0,2),PKW(pB0,4),PKW(pB0,6)};pw1=(u32x4){PKW(pB0,8),PKW(pB0,10),PKW(pB0,12),PKW(pB0,14)};pw2=(u32x4){PKW(pB1,0),PKW(pB1,2),PKW(pB1,4),PKW(pB1,6)};pw3=(u32x4){PKW(pB1,8),PKW(pB1,10),PKW(pB1,12),PKW(pB1,14)};
    SBAR(); pv(o,vb0+sl_cur,PAF(0),PAF(1),PAF(2),PAF(3)); }
  #undef PKW
  #undef PAF
  #undef VFR
  #undef PIN
  #undef MX3
  #undef GAPA
  #undef GAPB
  #undef EX
  #undef VRD
  #undef KRD
  #undef STEP
  #undef ENDW
  {auto rr=__builtin_amdgcn_permlane32_swap(__float_as_uint(l_reg),__float_as_uint(l_reg),false,false);l_reg=__uint_as_float(rr[0])+__uint_as_float(rr[1]);}
  if(hi==0)wsf[32+r32]=l_reg;asm volatile("s_waitcnt lgkmcnt(0)":::"memory");
  float rli[16];
  #pragma unroll
  for(int r=0;r<16;++r)rli[r]=__builtin_amdgcn_rcpf(wsf[32+crow(r,hi)]);
  bf16*Ow=O+(rowbase+q0+wid*QBLK)*DM+h*D;
  { bf16*stg=(bf16*)(shm+LDS_OST)+wid*2048;
    #pragma unroll
    for(int r=0;r<16;++r){const int orow=crow(r,hi);
      #pragma unroll
      for(int d0=0;d0<2;++d0)stg[orow*64+d0*32+r32]=__float2bfloat16(o[d0][r]*rli[r]);}
    asm volatile("s_waitcnt lgkmcnt(0)":::"memory");
    #pragma unroll
    for(int i=0;i<4;++i){const int row=i*8+(lane>>3),ch=lane&7; const u32x4 v=*(const u32x4*)(stg+row*64+ch*8); ATTN_STORE16(Ow+(long)row*DM+ch*8,v);} }
  asm volatile("s_waitcnt lgkmcnt(0)\n\ts_barrier":::"memory");
  #undef DMA_K
  #undef DMA_V
  #undef CMASK
  #undef START
  #undef RESC
  #undef ROT
}
constexpr int ATTN_LDS_BYTES=LDS_BYTES;
struct AttnTensors { const bf16* Q; const bf16* K; const bf16* V; bf16* O; };
struct AttnUnit { int bh; int qb; };
struct StaticOrder {
  int vcu;
  __device__ __forceinline__ explicit StaticOrder(int grid,int block):vcu((grid%8==0)?(block%8)*(grid/8)+block/8:block){}
  __device__ __forceinline__ bool next(int i,AttnUnit&u)const{ if(i>=4)return false; const int x=vcu>>5, c=vcu&31; const int ul=(x&1)*128+c*4+i; u.bh=(x>>1)*4+(ul>>6); u.qb=ul&63; return true; }
  __device__ __forceinline__ void a_ready(const AttnUnit&)const{}
  __device__ __forceinline__ void done(const AttnUnit&)const{}
};
template<class Sched,int THRL=8> __device__ __forceinline__ void attn_phase(char*lds,const AttnTensors&T,const Sched&S){
  AttnUnit u;
  for(int i=0;S.next(i,u);++i){ S.a_ready(u); attn_unit<THRL>(u.bh/NHEAD,u.bh%NHEAD,u.qb,T.Q,T.K,T.V,T.O,lds); S.done(u); }
}
#undef SBAR
#undef WAIT_BAR
}
typedef unsigned short bf16;
typedef float f32x4 __attribute__((ext_vector_type(4)));
typedef float f32x2 __attribute__((ext_vector_type(2)));
typedef unsigned u32x4 __attribute__((ext_vector_type(4)));
typedef unsigned u32x2 __attribute__((ext_vector_type(2)));
#define LAS3 __attribute__((address_space(3)))

constexpr int T = 16640, NCTX = 256, NLAT = 16384, DM = 1024, FF = 4096, NQKV = 1536;
constexpr float EPS = 1e-6f;
constexpr size_t MiB = 1u << 20;
constexpr size_t WS_MOD = 0, WS_S5A = 128 * 1024, WS_S5BB = 256 * 1024, WS_ROPE = 768 * 1024;
constexpr size_t WS_WIN = 2 * MiB, WS_WGLU = 4 * MiB, WS_WOUT = 5 * MiB, WS_W1_0 = 7 * MiB, WS_W2_0 = 15 * MiB, WS_WQKV = 23 * MiB, WS_WAO = 26 * MiB, WS_W1_1 = 28 * MiB, WS_W2_1 = 36 * MiB;
constexpr size_t WS_XC = 44 * MiB, WS_H = 45 * MiB, WS_Y = 78 * MiB, WS_BIG = 111 * MiB;
constexpr size_t WS_U = WS_BIG, WS_G = 144 * MiB, WS_Z = 161 * MiB, WS_S5E = 194 * MiB, WS_S5H = 203 * MiB;
constexpr size_t WS_O = WS_BIG;
constexpr size_t WS_QKV = WS_BIG, WS_Q = 160 * MiB, WS_K = 193 * MiB, WS_V = 202 * MiB;
constexpr size_t WS_AP = 1 * MiB;
constexpr size_t WS_KS = 194 * MiB, WS_CA = 198 * MiB, WS_BA = 202 * MiB;
constexpr size_t OUT_E = 0, OUT_HIN = 40 * MiB;
constexpr int NC16 = 1040;
constexpr size_t WS_END = 241 * MiB;
constexpr int LDS_TOTAL = 143360;
constexpr int NCH = 260;

struct Params { const float* in[26]; float* out; unsigned char* ws; };
typedef const __attribute__((address_space(4))) Params* KP;

__device__ __forceinline__ float wave_sum(float v) {
#pragma unroll
    for (int o = 1; o < 64; o <<= 1) v += __shfl_xor(v, o);
    return v;
}
__device__ __forceinline__ float siluf(float x) { return x / (1.f + __expf(-x)); }
__device__ __forceinline__ unsigned f2bf(float f) { unsigned u = __float_as_uint(f); return (u + 0x7fffu + ((u >> 16) & 1u)) >> 16; }
__device__ __forceinline__ unsigned pk2(float lo, float hi) { return f2bf(lo) | (f2bf(hi) << 16); }
__device__ __forceinline__ float bflo(unsigned w) { return __uint_as_float(w << 16); }
__device__ __forceinline__ float bfhi(unsigned w) { return __uint_as_float(w & 0xffff0000u); }
__device__ __forceinline__ float gelu_tanh(float x) { const float a = 0.7978845608028654f * (x + 0.044715f * x * x * x); const float th = 1.f - 2.f / (1.f + __expf(2.f * a)); return 0.5f * x * (1.f + th); }

__device__ __forceinline__ void tr_item(const float* W, int ldw, bf16* WT, int ldt, float* scr, int lane) {
#pragma unroll 8
    for (int i = 0; i < 32; ++i) { const int kk = 2 * i + (lane >> 5); scr[kk * 33 + (lane & 31)] = W[(size_t)kk * ldw + (lane & 31)]; }
    __builtin_amdgcn_wave_barrier();
    const int c = lane & 7;
#pragma unroll
    for (int j = 0; j < 4; ++j) { const int n = (lane >> 3) + 8 * j; const float* s = scr + (8 * c) * 33 + n;
        u32x4 o; o.x = pk2(s[0 * 33], s[1 * 33]); o.y = pk2(s[2 * 33], s[3 * 33]); o.z = pk2(s[4 * 33], s[5 * 33]); o.w = pk2(s[6 * 33], s[7 * 33]);
        *(u32x4*)(WT + (size_t)n * ldt + 8 * c) = o; }
    __builtin_amdgcn_wave_barrier();
}

__device__ __forceinline__ void prologue(KP p, unsigned char* lds, int tid, int lane, int wave) {
    float* misc = (float*)(lds + 131072);
    float* red = misc + 2048;
    { const float* c = p->in[1]; const float* cc = p->in[3];
      for (int i = tid; i < 1024; i += 512) { misc[i] = siluf(c[i]); misc[1024 + i] = siluf(cc[i]); } }
    __syncthreads();
    float* modv = (float*)(p->ws + WS_MOD);
    for (int it = blockIdx.x; it < 192; it += gridDim.x) {
        const int l = it / 96, cb = it % 96, cl = tid & 63, kq = tid >> 6;
        const float* w = p->in[4] + (size_t)l * 1024 * 6144 + cb * 64 + cl;
        float a0 = 0.f, a1 = 0.f;
#pragma unroll 8
        for (int k = kq * 128; k < kq * 128 + 128; ++k) { const float wv = w[(size_t)k * 6144]; a0 += misc[k] * wv; a1 += misc[1024 + k] * wv; }
        red[kq * 64 + cl] = a0; red[512 + kq * 64 + cl] = a1;
        __syncthreads();
        if (tid < 128) { const int v = tid >> 6; float s = 0.f;
#pragma unroll
            for (int q = 0; q < 8; ++q) s += red[v * 512 + q * 64 + cl];
            modv[(size_t)(l * 2 + v) * 6144 + cb * 64 + cl] = s + p->in[5][l * 6144 + cb * 64 + cl]; }
        __syncthreads();
    }
    float* scr = (float*)(lds + wave * 16384);
    const int gw = blockIdx.x * 8 + wave, NGW = gridDim.x * 8;
    constexpr int I_IN = 512, I_GLU = 256, I_OUT = 256, I_W1 = 2048, I_W2 = 2048, I_QKV = 768, I_AO = 512;
    constexpr int NITEMS = I_IN + I_GLU + I_OUT + 2 * (I_W1 + I_W2) + I_QKV + I_AO;
    for (int it = gw; it < NITEMS; it += NGW) {
        int r = it; const float* W; int N, ldt; bf16* WT; bool glu = false;
        if (r < I_IN) { W = p->in[9]; N = 1024; ldt = 1024; WT = (bf16*)(p->ws + WS_WIN); }
        else if ((r -= I_IN) < I_GLU) { W = p->in[19]; N = 1024; ldt = 512; WT = (bf16*)(p->ws + WS_WGLU); glu = true; }
        else if ((r -= I_GLU) < I_OUT) { W = p->in[10]; N = 1024; ldt = 1024; WT = (bf16*)(p->ws + WS_WOUT); }
        else if ((r -= I_OUT) < I_W1) { W = p->in[7]; N = 4096; ldt = 1024; WT = (bf16*)(p->ws + WS_W1_0); }
        else if ((r -= I_W1) < I_W2) { W = p->in[8]; N = 1024; ldt = 4096; WT = (bf16*)(p->ws + WS_W2_0); }
        else if ((r -= I_W2) < I_QKV) { W = p->in[22]; N = 1536; ldt = 1024; WT = (bf16*)(p->ws + WS_WQKV); }
        else if ((r -= I_QKV) < I_AO) { W = p->in[23]; N = 1024; ldt = 1024; WT = (bf16*)(p->ws + WS_WAO); }
        else if ((r -= I_AO) < I_W1) { W = p->in[7] + (size_t)1024 * 4096; N = 4096; ldt = 1024; WT = (bf16*)(p->ws + WS_W1_1); }
        else { r -= I_W1; W = p->in[8] + (size_t)4096 * 1024; N = 1024; ldt = 4096; WT = (bf16*)(p->ws + WS_W2_1); }
        const int nblk = N / 32, kb = r / nblk, nb = r % nblk, k0 = 64 * kb, n0 = 32 * nb;
        int drow = n0;
        if (glu) { const int bj = n0 >> 9, rem = n0 & 511; drow = 256 * (rem >> 7) + 128 * bj + (rem & 127); }
        tr_item(W + (size_t)k0 * N + n0, N, WT + (size_t)drow * ldt + k0, ldt, scr, lane);
    }
    const int gt = blockIdx.x * 512 + tid, NTH = gridDim.x * 512;
    for (int id = gt; id < 65536; id += NTH) {
        const int n = id & 1023, ib = (id >> 10) & 15, gi = id >> 14;
        const float* pw = p->in[20] + (size_t)gi * 16384 + (size_t)(ib * 8) * 128;
        const float* sc = p->in[21] + gi * 128;
        const float* wo = p->in[10] + (size_t)(512 + gi * 128) * 1024 + n;
        float acc[8];
#pragma unroll
        for (int e = 0; e < 8; ++e) acc[e] = 0.f;
        for (int j = 0; j < 128; ++j) { const float wv = wo[(size_t)j * 1024] * sc[j];
#pragma unroll
            for (int e = 0; e < 8; ++e) acc[e] += pw[e * 128 + j] * wv; }
        u32x4 o; o.x = pk2(acc[0], acc[1]); o.y = pk2(acc[2], acc[3]); o.z = pk2(acc[4], acc[5]); o.w = pk2(acc[6], acc[7]);
        *(u32x4*)((bf16*)(p->ws + WS_WOUT) + (size_t)n * 1024 + 512 + gi * 128 + ib * 8) = o;
    }
    for (int id = gt; id < 4096; id += NTH) {
        const float lr = p->in[11][id], li = p->in[12][id], dt = __expf(p->in[13][id >> 6]);
        const float mag = expf(lr * dt), ar = mag * cosf(li * dt), ai = mag * sinf(li * dt);
        const float den = lr * lr + li * li;
        const float fr = ((ar - 1.f) * lr + ai * li) / den, fi = (ai * lr - (ar - 1.f) * li) / den;
        float* A = (float*)(p->ws + WS_S5A); A[2 * id] = ar; A[2 * id + 1] = ai;
        float* BB = (float*)(p->ws + WS_S5BB) + (size_t)id * 32;
        const float* br = p->in[14] + (size_t)id * 16; const float* bi = p->in[15] + (size_t)id * 16;
#pragma unroll
        for (int c = 0; c < 16; ++c) { const float x = br[c], y = bi[c]; BB[c] = fr * x - fi * y; BB[16 + c] = fr * y + fi * x; }
        const int pos = id >> 4, fq = id & 15;
        const float inv = powf(10000.f, -(float)fq / 16.f), ang = (float)pos * inv;
        float* R = (float*)(p->ws + WS_ROPE); R[2 * id] = cosf(ang); R[2 * id + 1] = sinf(ang);
    }
    for (int id = gt; id < 64 * 17 * 64; id += NTH) {
        const int pp = id & 63, d = (id >> 6) % 17, dg = id / (64 * 17);
        const float lr = p->in[11][dg * 64 + pp], li = p->in[12][dg * 64 + pp], e = (float)d * expf(p->in[13][dg]);
        const float mag = expf(lr * e), ang = li * e;
        ((f32x2*)(p->ws + WS_AP))[id] = (f32x2){mag * cosf(ang), mag * sinf(ang)};
    }
}

struct RowP { const float* xlat; const float* xctx; float* olat; float* octx; const bf16* Y; const float* gA; const float* gate;
              const float* gB; const float* shsc; bf16* H; int r0; };
__device__ __forceinline__ void row_phase(const RowP& a, int lane, int wave) {
    const int gw = blockIdx.x * 8 + wave, NGW = gridDim.x * 8;
    for (int r = a.r0 + gw; r < T; r += NGW) {
        const bool isctx = r < NCTX; const int vo = isctx ? 6144 : 0;
        const float* xs = isctx ? a.xctx + (size_t)r * DM : a.xlat + (size_t)(r - NCTX) * DM;
        f32x4 v[4];
#pragma unroll
        for (int j = 0; j < 4; ++j) v[j] = ((const f32x4*)xs)[lane + 64 * j];
        if (a.Y) {
            f32x4 y[4]; float ss = 0.f;
#pragma unroll
            for (int j = 0; j < 4; ++j) { const u32x2 w = ((const u32x2*)(a.Y + (size_t)r * DM))[lane + 64 * j]; y[j] = (f32x4){bflo(w.x), bfhi(w.x), bflo(w.y), bfhi(w.y)};
                ss += (y[j].x * y[j].x + y[j].y * y[j].y) + (y[j].z * y[j].z + y[j].w * y[j].w); }
            const float rstd = rsqrtf(wave_sum(ss) * (1.f / DM) + EPS);
            float* xo = isctx ? a.octx + (size_t)r * DM : a.olat + (size_t)(r - NCTX) * DM;
#pragma unroll
            for (int j = 0; j < 4; ++j) { const f32x4 g = ((const f32x4*)a.gA)[lane + 64 * j], gt = ((const f32x4*)(a.gate + vo))[lane + 64 * j];
                v[j] = v[j] + gt * (y[j] * rstd * g); ((f32x4*)xo)[lane + 64 * j] = v[j]; }
        }
        if (a.H) {
            float ss = 0.f;
#pragma unroll
            for (int j = 0; j < 4; ++j) ss += (v[j].x * v[j].x + v[j].y * v[j].y) + (v[j].z * v[j].z + v[j].w * v[j].w);
            const float rstd = rsqrtf(wave_sum(ss) * (1.f / DM) + EPS);
#pragma unroll
            for (int j = 0; j < 4; ++j) { const f32x4 g = ((const f32x4*)a.gB)[lane + 64 * j], sh = ((const f32x4*)(a.shsc + vo))[lane + 64 * j], sc = ((const f32x4*)(a.shsc + vo + 1024))[lane + 64 * j];
                const f32x4 h = (v[j] * rstd * g) * (sc + 1.f) + sh;
                u32x2 o; o.x = pk2(h.x, h.y); o.y = pk2(h.z, h.w); ((u32x2*)(a.H + (size_t)r * DM))[lane + 64 * j] = o; }
        }
    }
}

__device__ __forceinline__ int s5_row(int dir, int j, int sl) { const int s = j * 64 + sl; return dir == 0 ? s : (j < 4 ? 255 - s : 16895 - s); }
__device__ __forceinline__ void s5_stage_u(const bf16* U, int row, int g, float* ut, int lane) {
    const u32x4* src = (const u32x4*)(U + (size_t)row * DM + g * 16);
    const u32x4 a = src[0], b = src[1];
    f32x4* d = (f32x4*)(ut + lane * 16);
    d[0] = (f32x4){bflo(a.x), bfhi(a.x), bflo(a.y), bfhi(a.y)}; d[1] = (f32x4){bflo(a.z), bfhi(a.z), bflo(a.w), bfhi(a.w)};
    d[2] = (f32x4){bflo(b.x), bfhi(b.x), bflo(b.y), bfhi(b.y)}; d[3] = (f32x4){bflo(b.z), bfhi(b.z), bflo(b.w), bfhi(b.w)};
}
#define S5_LOAD_BB(dir, g) do { const f32x4* bp_ = (const f32x4*)((const float*)(p->ws + WS_S5BB) + (size_t)(((dir) * 32 + (g)) * 64 + lane) * 32); \
    _Pragma("unroll") for (int q_ = 0; q_ < 4; ++q_) { const f32x4 t_ = bp_[q_]; bbr[4 * q_] = t_.x; bbr[4 * q_ + 1] = t_.y; bbr[4 * q_ + 2] = t_.z; bbr[4 * q_ + 3] = t_.w; } \
    _Pragma("unroll") for (int q_ = 0; q_ < 4; ++q_) { const f32x4 t_ = bp_[4 + q_]; bbi[4 * q_] = t_.x; bbi[4 * q_ + 1] = t_.y; bbi[4 * q_ + 2] = t_.z; bbi[4 * q_ + 3] = t_.w; } } while (0)
#define S5_STEP(utrow) do { const f32x4* up_ = (const f32x4*)(utrow); float bur_ = 0.f, bui_ = 0.f; \
    _Pragma("unroll") for (int q_ = 0; q_ < 4; ++q_) { const f32x4 u_ = up_[q_]; \
        bur_ += bbr[4 * q_] * u_.x + bbr[4 * q_ + 1] * u_.y + bbr[4 * q_ + 2] * u_.z + bbr[4 * q_ + 3] * u_.w; \
        bui_ += bbi[4 * q_] * u_.x + bbi[4 * q_ + 1] * u_.y + bbi[4 * q_ + 2] * u_.z + bbi[4 * q_ + 3] * u_.w; } \
    const float nr_ = ar * hr - ai * hi + bur_, ni_ = ar * hi + ai * hr + bui_; hr = nr_; hi = ni_; } while (0)

__device__ __forceinline__ void pool_s5a_phase(KP p, unsigned char* lds, int tid, int lane, int wave) {
    const bf16* U = (const bf16*)(p->ws + WS_U); bf16* Z = (bf16*)(p->ws + WS_Z);
    const int gt = blockIdx.x * 512 + tid, NTH = gridDim.x * 512;
    for (int id = gt; id < T * 64; id += NTH) {
        const int r = id >> 6, cgp = id & 63, gi = cgp >> 4, w = 2 << gi, lo = w >> 1, hi = w - 1 - lo;
        const int s0 = r < NCTX ? 0 : NCTX, s1 = r < NCTX ? NCTX : T;
        const int st = (r - lo) < s0 ? s0 : (r - lo), en = (r + hi + 1) > s1 ? s1 : (r + hi + 1);
        float acc[8];
#pragma unroll
        for (int e = 0; e < 8; ++e) acc[e] = 0.f;
        for (int q = st; q < en; ++q) { const u32x4 x = *(const u32x4*)(U + (size_t)q * DM + 512 + cgp * 8);
            acc[0] += bflo(x.x); acc[1] += bfhi(x.x); acc[2] += bflo(x.y); acc[3] += bfhi(x.y); acc[4] += bflo(x.z); acc[5] += bfhi(x.z); acc[6] += bflo(x.w); acc[7] += bfhi(x.w); }
        const u32x4 x = *(const u32x4*)(U + (size_t)r * DM + 512 + cgp * 8);
        const float ic = 1.f / (float)(en - st);
        u32x4 o; o.x = pk2(acc[0] * ic - bflo(x.x), acc[1] * ic - bfhi(x.x)); o.y = pk2(acc[2] * ic - bflo(x.y), acc[3] * ic - bfhi(x.y));
        o.z = pk2(acc[4] * ic - bflo(x.z), acc[5] * ic - bfhi(x.z)); o.w = pk2(acc[6] * ic - bflo(x.w), acc[7] * ic - bfhi(x.w));
        *(u32x4*)(Z + (size_t)r * DM + 512 + cgp * 8) = o;
    }
}
typedef short bf16x8v __attribute__((ext_vector_type(8)));
typedef float f32x16v __attribute__((ext_vector_type(16)));
__device__ __forceinline__ int crow16(int r, int hi) { return (r & 3) + 8 * (r >> 2) + 4 * hi; }
__device__ __forceinline__ void s5_build(KP p, int tid) {
    const float* BBt = (const float*)(p->ws + WS_S5BB); const f32x2* AP = (const f32x2*)(p->ws + WS_AP);
    const int gt = blockIdx.x * 512 + tid, NTH = gridDim.x * 512;
    bf16* KS = (bf16*)(p->ws + WS_KS); bf16* CA = (bf16*)(p->ws + WS_CA); bf16* BA = (bf16*)(p->ws + WS_BA);
    for (int id = gt; id < 32 * 16 * 256; id += NTH) {
        const int cp = id & 15, c = (id >> 4) & 15, d = (id >> 8) & 15, g = id >> 12;
        float L[2];
#pragma unroll
        for (int dir = 0; dir < 2; ++dir) { const int dg = dir * 32 + g; float acc = 0.f;
            const float* crp = p->in[16] + (size_t)(dg * 16 + c) * 64; const float* cip = p->in[17] + (size_t)(dg * 16 + c) * 64;
            for (int q = 0; q < 64; ++q) { const f32x2 P = AP[(dg * 17 + d) * 64 + q]; const float Cr = crp[q], Ci = cip[q];
                const float Br = BBt[(size_t)(dg * 64 + q) * 32 + cp], Bi = BBt[(size_t)(dg * 64 + q) * 32 + 16 + cp];
                const float wr = Cr * P.x - Ci * P.y, wi = Cr * P.y + Ci * P.x; acc += wr * Br - wi * Bi; }
            L[dir] = acc; }
        bf16* Kg = KS + (size_t)g * 65536;
        if (d == 0) { const float v = L[0] + L[1] + (c == cp ? p->in[18][g * 16 + c] : 0.f); const bf16 b = (bf16)f2bf(v);
            for (int i = 0; i < 16; ++i) Kg[(size_t)(i * 16 + c) * 256 + i * 16 + cp] = b; }
        else { const bf16 bf = (bf16)f2bf(L[0]), br = (bf16)f2bf(L[1]);
            for (int i = 0; i + d < 16; ++i) { Kg[(size_t)((i + d) * 16 + c) * 256 + i * 16 + cp] = bf; Kg[(size_t)(i * 16 + c) * 256 + (i + d) * 16 + cp] = br; } }
    }
    for (int id = gt; id < 64 * 256 * 64; id += NTH) {
        const int q = id & 63, n = (id >> 6) & 255, dg = id >> 14, t = n >> 4, c = n & 15, e = (dg < 32) ? t + 1 : 16 - t;
        const f32x2 P = AP[(dg * 17 + e) * 64 + q]; const float Cr = p->in[16][(size_t)(dg * 16 + c) * 64 + q], Ci = p->in[17][(size_t)(dg * 16 + c) * 64 + q];
        CA[(size_t)(dg * 256 + n) * 128 + q] = (bf16)f2bf(Cr * P.x - Ci * P.y); CA[(size_t)(dg * 256 + n) * 128 + 64 + q] = (bf16)f2bf(-(Cr * P.y + Ci * P.x));
    }
    for (int id = gt; id < 64 * 64 * 256; id += NTH) {
        const int kk = id & 255, q = (id >> 8) & 63, dg = id >> 14, sdx = kk >> 4, cp = kk & 15, e = (dg < 32) ? 15 - sdx : sdx;
        const f32x2 P = AP[(dg * 17 + e) * 64 + q]; const float Br = BBt[(size_t)(dg * 64 + q) * 32 + cp], Bi = BBt[(size_t)(dg * 64 + q) * 32 + 16 + cp];
        BA[(size_t)(dg * 128 + q) * 256 + kk] = (bf16)f2bf(P.x * Br - P.y * Bi); BA[(size_t)(dg * 128 + 64 + q) * 256 + kk] = (bf16)f2bf(P.x * Bi + P.y * Br);
    }
}
__device__ __forceinline__ void s5_end_phase(KP p, int lane, int wave) {
    const bf16* U = (const bf16*)(p->ws + WS_U); const bf16* BA = (const bf16*)(p->ws + WS_BA); float* E = (float*)(p->ws + WS_Y);
    const int gw = blockIdx.x * 8 + wave, NGW = gridDim.x * 8, m = lane & 31, half = lane >> 5;
    for (int unit = gw; unit < 33 * 32; unit += NGW) {
        const int ct = unit >> 5, g = unit & 31; const int chunk = (32 * ct + m) < NC16 ? (32 * ct + m) : NC16 - 1;
        const bf16* up = U + (size_t)(16 * chunk) * DM + 16 * g + 8 * half;
        f32x16v acc[8];
#pragma unroll
        for (int nt = 0; nt < 8; ++nt) acc[nt] = (f32x16v){};
#pragma unroll 2
        for (int ks = 0; ks < 16; ++ks) { const bf16x8v a = *(const bf16x8v*)(up + (size_t)ks * DM);
#pragma unroll
            for (int nt = 0; nt < 8; ++nt) { const bf16x8v b = *(const bf16x8v*)(BA + (size_t)(((nt >> 2) * 32 + g) * 128 + 32 * (nt & 3) + m) * 256 + 16 * ks + 8 * half);
                acc[nt] = __builtin_amdgcn_mfma_f32_32x32x16_bf16(a, b, acc[nt], 0, 0, 0); } }
#pragma unroll
        for (int nt = 0; nt < 8; ++nt)
#pragma unroll
            for (int r = 0; r < 16; ++r) { const int ch = 32 * ct + crow16(r, half); if (ch < NC16) E[(size_t)(((nt >> 2) * NC16 + ch) * 32 + g) * 128 + 32 * (nt & 3) + m] = acc[nt][r]; }
    }
}
__device__ __forceinline__ void s5_carry_phase(KP p, unsigned char* lds, int lane, int wave) {
    const float* E = (const float*)(p->ws + WS_Y); bf16* Hin = (bf16*)(p->ws + WS_H);
    float* seg = (float*)lds;
    for (int dg = blockIdx.x; dg < 64; dg += gridDim.x) {
        const int dir = dg >> 5, g = dg & 31;
        const f32x2 A16 = ((const f32x2*)(p->ws + WS_AP))[(dg * 17 + 16) * 64 + lane];
        float hr = 0.f, hi = 0.f;
        for (int jb = 0; jb < 130; jb += 13) { float er[13], ei[13];
#pragma unroll
            for (int q = 0; q < 13; ++q) { const int j = 130 * wave + jb + q, rc = dir == 0 ? j : (j < 16 ? 15 - j : 1055 - j); const float* ep = E + (size_t)((dir * NC16 + rc) * 32 + g) * 128; er[q] = ep[lane]; ei[q] = ep[64 + lane]; }
#pragma unroll
            for (int q = 0; q < 13; ++q) { const float nr = A16.x * hr - A16.y * hi + er[q], ni = A16.x * hi + A16.y * hr + ei[q]; hr = nr; hi = ni; } }
        seg[wave * 128 + lane] = hr; seg[wave * 128 + 64 + lane] = hi;
        float pr = 1.f, pi = 0.f;
        for (int q = 0; q < 130; ++q) { const float nr = pr * A16.x - pi * A16.y, ni = pr * A16.y + pi * A16.x; pr = nr; pi = ni; }
        __syncthreads();
        hr = 0.f; hi = 0.f;
        for (int w = 0; w < wave; ++w) { const float sr = seg[w * 128 + lane], si = seg[w * 128 + 64 + lane]; const float nr = pr * hr - pi * hi + sr, ni = pr * hi + pi * hr + si; hr = nr; hi = ni; }
        for (int jb = 0; jb < 130; jb += 13) { float er[13], ei[13];
#pragma unroll
            for (int q = 0; q < 13; ++q) { const int j = 130 * wave + jb + q, rc = dir == 0 ? j : (j < 16 ? 15 - j : 1055 - j); const float* ep = E + (size_t)((dir * NC16 + rc) * 32 + g) * 128; er[q] = ep[lane]; ei[q] = ep[64 + lane]; }
#pragma unroll
            for (int q = 0; q < 13; ++q) { const int j = 130 * wave + jb + q, rc = dir == 0 ? j : (j < 16 ? 15 - j : 1055 - j); bf16* hp = Hin + (size_t)(dg * NC16 + rc) * 128;
                hp[lane] = (bf16)f2bf(hr); hp[64 + lane] = (bf16)f2bf(hi);
                const float nr = A16.x * hr - A16.y * hi + er[q], ni = A16.x * hi + A16.y * hr + ei[q]; hr = nr; hi = ni; } }
        __syncthreads();
    }
}
__device__ __forceinline__ void s5_out_phase(KP p, int lane, int wave) {
    const bf16* U = (const bf16*)(p->ws + WS_U); const bf16* KS = (const bf16*)(p->ws + WS_KS); const bf16* CA = (const bf16*)(p->ws + WS_CA);
    const bf16* Hin = (const bf16*)(p->ws + WS_H); bf16* G = (bf16*)(p->ws + WS_G);
    const int gw = blockIdx.x * 8 + wave, NGW = gridDim.x * 8, m = lane & 31, half = lane >> 5;
    for (int unit = gw; unit < 33 * 32; unit += NGW) {
        const int ct = unit >> 5, g = unit & 31; const int chunk = (32 * ct + m) < NC16 ? (32 * ct + m) : NC16 - 1;
        const bf16* up = U + (size_t)(16 * chunk) * DM + 16 * g + 8 * half;
        f32x16v acc[8];
#pragma unroll
        for (int nt = 0; nt < 8; ++nt) acc[nt] = (f32x16v){};
#pragma unroll 2
        for (int ks = 0; ks < 16; ++ks) { const bf16x8v a = *(const bf16x8v*)(up + (size_t)ks * DM);
#pragma unroll
            for (int nt = 0; nt < 8; ++nt) { const bf16x8v b = *(const bf16x8v*)(KS + (size_t)(g * 256 + 32 * nt + m) * 256 + 16 * ks + 8 * half);
                acc[nt] = __builtin_amdgcn_mfma_f32_32x32x16_bf16(a, b, acc[nt], 0, 0, 0); } }
#pragma unroll 1
        for (int dir = 0; dir < 2; ++dir) { const int dg = dir * 32 + g; const bf16* hp = Hin + (size_t)(dg * NC16 + chunk) * 128 + 8 * half;
#pragma unroll 2
            for (int ks = 0; ks < 8; ++ks) { const bf16x8v a = *(const bf16x8v*)(hp + 16 * ks);
#pragma unroll
                for (int nt = 0; nt < 8; ++nt) { const bf16x8v b = *(const bf16x8v*)(CA + (size_t)(dg * 256 + 32 * nt + m) * 128 + 16 * ks + 8 * half);
                    acc[nt] = __builtin_amdgcn_mfma_f32_32x32x16_bf16(a, b, acc[nt], 0, 0, 0); } } }
#pragma unroll
        for (int nt = 0; nt < 8; ++nt) { const int t = 2 * nt + (m >> 4), c = m & 15;
#pragma unroll
            for (int r = 0; r < 16; ++r) { const int ch = 32 * ct + crow16(r, half); if (ch < NC16) G[(size_t)(16 * ch + t) * 512 + 16 * g + c] = (bf16)f2bf(gelu_tanh(acc[nt][r])); } }
    }
}

__device__ __forceinline__ void qkv_post_phase(KP p, int lane, int wave) {
    const bf16* raw = (const bf16*)(p->ws + WS_QKV); bf16* Q = (bf16*)(p->ws + WS_Q); bf16* K = (bf16*)(p->ws + WS_K); bf16* V = (bf16*)(p->ws + WS_V);
    const float* R = (const float*)(p->ws + WS_ROPE);
    const int gw = blockIdx.x * 8 + wave, NGW = gridDim.x * 8;
    const int j = lane & 15, hq = lane >> 4;
    const f32x4 qn = ((const f32x4*)p->in[24])[j], kn = ((const f32x4*)p->in[25])[j];
    for (int r = gw; r < T; r += NGW) {
        const bool lat = r >= NCTX; const int tl = r - NCTX;
        const int pos = (j < 8) ? (tl >> 6) : (tl & 63);
        f32x4 cs0 = (f32x4){1.f, 0.f, 1.f, 0.f}, cs1 = cs0;
        if (lat) { const f32x4* rp = (const f32x4*)(R + (size_t)pos * 32 + 8 * (j & 3)); cs0 = rp[0]; cs1 = rp[1]; }
        const bool up = (j & 4) != 0;
        for (int pass = lat ? 0 : 4; pass < 5; ++pass) {
            const int col = pass < 4 ? (pass * 4 + hq) * 64 + 4 * j : 1024 + hq * 64 + 4 * j;
            const u32x2 w = *(const u32x2*)(raw + (size_t)r * NQKV + col);
            f32x4 x = (f32x4){bflo(w.x), bfhi(w.x), bflo(w.y), bfhi(w.y)};
            float ss = (x.x * x.x + x.y * x.y) + (x.z * x.z + x.w * x.w);
            ss += __shfl_xor(ss, 1); ss += __shfl_xor(ss, 2); ss += __shfl_xor(ss, 4); ss += __shfl_xor(ss, 8);
            const float rstd = rsqrtf(ss * (1.f / 64.f) + EPS);
            x = x * rstd * (pass < 4 ? qn : kn);
            if (lat) {
                f32x4 o; o.x = __shfl_xor(x.x, 4); o.y = __shfl_xor(x.y, 4); o.z = __shfl_xor(x.z, 4); o.w = __shfl_xor(x.w, 4);
                const float sg = up ? 1.f : -1.f;
                x.x = x.x * cs0.x + sg * o.x * cs0.y; x.y = x.y * cs0.z + sg * o.y * cs0.w; x.z = x.z * cs1.x + sg * o.z * cs1.y; x.w = x.w * cs1.z + sg * o.w * cs1.w;
            }
            if (pass < 4) { x = x * attn_body::C2; u32x2 o; o.x = pk2(x.x, x.y); o.y = pk2(x.z, x.w); *(u32x2*)(Q + (size_t)r * DM + (pass * 4 + hq) * 64 + 4 * j) = o; }
            else { u32x2 o; o.x = pk2(x.x, x.y); o.y = pk2(x.z, x.w); *(u32x2*)(K + (size_t)r * 256 + hq * 64 + 4 * j) = o; }
        }
        *(u32x2*)(V + (size_t)r * 256 + 4 * lane) = *(const u32x2*)(raw + (size_t)r * NQKV + 1280 + 4 * lane);
    }
}

template <class Epi> __device__ __forceinline__ void run_gemm(LAS3 unsigned char* lds3, const bf16* A, const bf16* Bt, int M, int N, int K, const Epi& E) {
    pg8::Gemm g{A, Bt, M, N, K}; pg8::StaticOrder S; S.init(M, N, (int)gridDim.x, (int)blockIdx.x);
    pg8::gemm_phase<Epi, pg8::StaticOrder, true, true>(lds3, g, S, E);
}
constexpr int NSTEP = 20;
__global__ void __launch_bounds__(512, 2) mega_fwd(Params p_unused) {
    extern __shared__ __attribute__((aligned(16))) unsigned char lds[];
    cg::grid_group grid = cg::this_grid();
    const size_t LO = (size_t)NCTX;
    bool again = false; (void)again;
#pragma unroll 1
    for (int step = 0; step < NSTEP; ++step) {
        KP p = (KP)__builtin_amdgcn_kernarg_segment_ptr();
        asm volatile("" : "+s"(p));
        int tid_ = threadIdx.x; asm volatile("" : "+v"(tid_));
        const int tid = tid_, lane = tid & 63, wave = __builtin_amdgcn_readfirstlane(tid >> 6);
        unsigned char* ws = p->ws;
        const float* modv = (const float*)(ws + WS_MOD);
        const float* ng = p->in[6];
        bf16* H = (bf16*)(ws + WS_H); bf16* Y = (bf16*)(ws + WS_Y); bf16* HID = (bf16*)(ws + WS_BIG);
        float* XC = (float*)(ws + WS_XC);
        if (step == 0) prologue(p, lds, tid, lane, wave);
        else if (step == 3) { pool_s5a_phase(p, lds, tid, lane, wave); s5_end_phase(p, lane, wave); }
        else if (step == 4) s5_carry_phase(p, lds, lane, wave);
        else if (step == 5) s5_out_phase(p, lane, wave);
        else if (step == 13) qkv_post_phase(p, lane, wave);
        else if (step == 14) {
            const attn_body::AttnTensors AT{(const attn_body::bf16*)(ws + WS_Q) + LO * DM, (const attn_body::bf16*)(ws + WS_K), (const attn_body::bf16*)(ws + WS_V), (attn_body::bf16*)(ws + WS_O) + LO * DM};
            const attn_body::StaticOrder S((int)gridDim.x, (int)blockIdx.x);
            attn_body::attn_phase<attn_body::StaticOrder>((char*)lds, AT, S);
        } else if (step == 1) {
            const RowP ra{p->in[0], p->in[2], nullptr, nullptr, nullptr, ng, modv, ng + 0 * 1024, modv + 0, H, 0};
            row_phase(ra, lane, wave); s5_build(p, tid);
        } else if (step == 8) {
            const RowP ra{p->in[0], p->in[2], p->out, XC, Y, ng + 1 * 1024, modv + 2048, ng + 2 * 1024, modv + 3072, H, 0};
            row_phase(ra, lane, wave);
        } else if (step == 11) {
            const RowP ra{p->out, XC, p->out, XC, Y, ng + 3 * 1024, modv + 5120, ng + 4 * 1024, modv + 2 * 6144 + 0, H, 0};
            row_phase(ra, lane, wave);
        } else if (step == 16) {
            const RowP ra{p->out, XC, p->out, XC, Y, ng + 5 * 1024, modv + 2 * 6144 + 2048, ng + 6 * 1024, modv + 2 * 6144 + 3072, H, NCTX};
            row_phase(ra, lane, wave);
        } else if (step == 19) {
            const RowP ra{p->out, XC, p->out, XC, Y, ng + 7 * 1024, modv + 2 * 6144 + 5120, ng, modv, nullptr, NCTX};
            row_phase(ra, lane, wave);
        } else {
            int gk = 0; const bf16* gA = H; const bf16* gB = nullptr; int gM = T, gN = 1024, gK = 1024; bf16* gO = Y; int gld = 1024;
            switch (step) {
            case 2: gB = (const bf16*)(ws + WS_WIN); gO = (bf16*)(ws + WS_U); break;
            case 6: gk = 3; gA = (const bf16*)(ws + WS_G); gB = (const bf16*)(ws + WS_WGLU); gK = 512; gO = (bf16*)(ws + WS_Z); break;
            case 7: gA = (const bf16*)(ws + WS_Z); gB = (const bf16*)(ws + WS_WOUT); break;
            case 9: gk = 2; gB = (const bf16*)(ws + WS_W1_0); gN = 4096; gO = HID; gld = 4096; break;
            case 10: gA = HID; gB = (const bf16*)(ws + WS_W2_0); gK = 4096; break;
            case 12: gB = (const bf16*)(ws + WS_WQKV); gN = NQKV; gO = (bf16*)(ws + WS_QKV); gld = NQKV; break;
            case 15: gA = (const bf16*)(ws + WS_O) + LO * DM; gB = (const bf16*)(ws + WS_WAO); gM = NLAT; gO = Y + LO * DM; break;
            case 17: gk = 2; gA = H + LO * DM; gB = (const bf16*)(ws + WS_W1_1); gM = NLAT; gN = 4096; gO = HID + LO * FF; gld = 4096; break;
            default: gA = HID + LO * FF; gB = (const bf16*)(ws + WS_W2_1); gM = NLAT; gK = 4096; gO = Y + LO * DM; break;
            }
            if (gk == 0) { pg8::EpiBf16<0> E{gO, gld}; run_gemm((LAS3 unsigned char*)lds, gA, gB, gM, gN, gK, E); }
            else if (gk == 2) { pg8::EpiBf16<2> E{gO, gld}; run_gemm((LAS3 unsigned char*)lds, gA, gB, gM, gN, gK, E); }
            else { pg8::EpiGlu E{gO, gld}; run_gemm((LAS3 unsigned char*)lds, gA, gB, gM, gN, gK, E); }
        }
        if (step != NSTEP - 1) grid.sync();
#ifdef PROBE_MASK
        if (((PROBE_MASK >> step) & 1) && !again) { again = true; --step; } else again = false;
#endif
    }
}

extern "C" void kernel_launch(void* const* d_in, const int* in_sizes, int n_in, void* d_out, int out_size, void* d_ws, size_t ws_size, hipStream_t stream) {
    static int grid = 0;
    if (grid == 0) {
        if (n_in != 26 || out_size != NLAT * DM || ws_size < WS_END) { fprintf(stderr, "kernel_launch: unexpected shapes (n_in %d out %d ws %zu)\n", n_in, out_size, ws_size); grid = -1; return; }
        int dev = 0, cus = 0, per_cu = 0;
        (void)hipGetDevice(&dev); (void)hipDeviceGetAttribute(&cus, hipDeviceAttributeMultiprocessorCount, dev);
        if (hipFuncSetAttribute((const void*)mega_fwd, hipFuncAttributeMaxDynamicSharedMemorySize, LDS_TOTAL) != hipSuccess) { fprintf(stderr, "kernel_launch: hipFuncSetAttribute failed\n"); grid = -1; return; }
        if (hipOccupancyMaxActiveBlocksPerMultiprocessor(&per_cu, (const void*)mega_fwd, 512, LDS_TOTAL) != hipSuccess || per_cu < 1) { fprintf(stderr, "kernel_launch: occupancy query says %d\n", per_cu); per_cu = 1; (void)hipGetLastError(); }
        grid = cus * per_cu; if (grid > 256) grid = 256;
    }
    if (grid < 0) return;
    Params p{};
    for (int i = 0; i < 26; ++i) p.in[i] = (const float*)d_in[i];
    p.out = (float*)d_out; p.ws = (unsigned char*)d_ws;
    void* args[] = {&p};
    hipError_t e = hipLaunchCooperativeKernel((const void*)mega_fwd, dim3(grid), dim3(512), args, LDS_TOTAL, stream);
    if (e != hipSuccess) fprintf(stderr, "cooperative launch failed: %s (grid %d)\n", hipGetErrorString(e), grid);
}
```

```cpp
#include <hip/hip_runtime.h>
#include <hip/hip_cooperative_groups.h>
#include <cstdio>
#include <cstdint>
namespace cg = cooperative_groups;
namespace pg8 {
#define PG8_LAS __attribute__((address_space(3)))
typedef unsigned short bf16_t;
typedef short bf16x8 __attribute__((ext_vector_type(8)));
typedef float f32x4 __attribute__((ext_vector_type(4)));
typedef unsigned u32x4 __attribute__((ext_vector_type(4)));
constexpr int BM = 256, BK = 64, HALF = 128, HTB = HALF * BK * 2  , STAGE_BYTES = 8 * HTB, NXCD = 8, WGM = 8;

__host__ __device__ __forceinline__ int lds_byte(int r, int c) { const int st = (r >> 4) * 2 + (c >> 5), rr = r & 15, cc = c & 31, ob = rr * 64 + cc * 2; return st * 1024 + (ob ^ (((ob >> 9) & 1) << 5)); }
__host__ __device__ __forceinline__ void stage_rc(int b, int& R, int& C) { const int st = b / 1024, sb = b % 1024, swz = sb ^ (((sb >> 9) & 1) << 5); R = (st >> 1) * 16 + swz / 64; C = (st & 1) * 32 + (swz % 64) / 2; }
__host__ __device__ __forceinline__ int perm32(int rho) { const int n = rho >> 4, i = rho & 15; return 8 * (i >> 2) + 4 * n + (i & 3); }

struct Unit { int pm, pn; };
struct Gemm { const bf16_t* A; const bf16_t* Bt; int M, N, K; };

struct StaticOrder {
    int nM, nN, nwg, G, c;
    __host__ __device__ void init(int M, int N, int G_, int c_) { nM = M / BM; nN = N / BM; nwg = nM * nN; G = G_; c = c_; }
    __host__ __device__ bool next(int i, Unit& u) const {
        const long L = (long)i * G + c; if (L >= nwg) return false;
        int wgid = (int)L; { const int q = nwg / NXCD, r = nwg % NXCD, xcd = wgid % NXCD, off = wgid / NXCD; wgid = (xcd < r ? xcd * (q + 1) : r * (q + 1) + (xcd - r) * q) + off; }
        const int nig = WGM * nN, gid = wgid / nig, fm = gid * WGM, gsz = (nM - fm) < WGM ? (nM - fm) : WGM;
        u.pm = fm + ((wgid % nig) % gsz); u.pn = (wgid % nig) / gsz; return true;
    }
    __device__ __forceinline__ void a_ready(const Unit&) const {}
    __device__ __forceinline__ void done(const Unit&) const {}
};

__device__ __forceinline__ unsigned cvt_pk_bf16(float lo, float hi) { unsigned r; asm volatile("v_cvt_pk_bf16_f32 %0, %1, %2" : "=v"(r) : "v"(lo), "v"(hi)); return r; }
typedef float f32x2 __attribute__((ext_vector_type(2)));
template <int ACT> struct EpiBf16 {
    static constexpr bool PERM = true, AFTER_DRAIN = false;
    bf16_t* O; int ldc;
    __device__ __forceinline__ void operator()(const f32x4 (&acc)[2][2][4][2], const Unit& u, int wr, int wc, int fr, int fq) const {
        const int row0 = u.pm * BM + wr * 64 + fr; const int col0 = u.pn * BM + wc * 32 + 8 * fq;
#pragma unroll
        for (int ai = 0; ai < 2; ++ai)
#pragma unroll
            for (int m = 0; m < 4; ++m) { bf16_t* rowp = O + (size_t)(row0 + ai * HALF + m * 16) * ldc + col0;
#pragma unroll
                for (int bj = 0; bj < 2; ++bj) { f32x4 v0 = acc[ai][bj][m][0], v1 = acc[ai][bj][m][1];
                    if (ACT == 2) {
#pragma unroll
                        for (int e = 0; e < 4; ++e) { float a = v0[e] > 0.f ? v0[e] : 0.f; v0[e] = a * a; float b = v1[e] > 0.f ? v1[e] : 0.f; v1[e] = b * b; } }
                    u32x4 w; w.x = cvt_pk_bf16(v0[0], v0[1]); w.y = cvt_pk_bf16(v0[2], v0[3]); w.z = cvt_pk_bf16(v1[0], v1[1]); w.w = cvt_pk_bf16(v1[2], v1[3]);
                    *(u32x4*)(rowp + bj * HALF) = w; } }
    }
};
struct EpiGlu {
    static constexpr bool PERM = true, AFTER_DRAIN = false;
    bf16_t* O; int ldc;
    __device__ __forceinline__ void operator()(const f32x4 (&acc)[2][2][4][2], const Unit& u, int wr, int wc, int fr, int fq) const {
        const int row0 = u.pm * BM + wr * 64 + fr; const int col0 = u.pn * HALF + wc * 32 + 8 * fq;
#pragma unroll
        for (int ai = 0; ai < 2; ++ai)
#pragma unroll
            for (int m = 0; m < 4; ++m) { bf16_t* rowp = O + (size_t)(row0 + ai * HALF + m * 16) * ldc + col0;
                f32x4 v0 = acc[ai][0][m][0], v1 = acc[ai][0][m][1]; const f32x4 g0 = acc[ai][1][m][0], g1 = acc[ai][1][m][1];
#pragma unroll
                for (int e = 0; e < 4; ++e) { v0[e] = v0[e] / (1.f + __expf(-g0[e])); v1[e] = v1[e] / (1.f + __expf(-g1[e])); }
                u32x4 w; w.x = cvt_pk_bf16(v0[0], v0[1]); w.y = cvt_pk_bf16(v0[2], v0[3]); w.z = cvt_pk_bf16(v1[0], v1[1]); w.w = cvt_pk_bf16(v1[2], v1[3]);
                *(u32x4*)rowp = w; }
    }
};
template <class Epi, class Sched, bool ALIGN_EPI = false, bool SP2 = false>
__device__ __forceinline__ void gemm_phase(PG8_LAS unsigned char* lds, const Gemm g, const Sched& S, const Epi& E) {
    int tid_ = threadIdx.x; asm volatile("" : "+v"(tid_)); const int tid = tid_, wid = __builtin_amdgcn_readfirstlane(tid >> 6), lane = tid & 63, wr = wid >> 2, wc = wid & 3, fr = lane & 15, fq = lane >> 4;
    const int K = g.K, nt = K / BK;
    unsigned voffA[2], voffB[2];
#pragma unroll
    for (int i = 0; i < 2; ++i) { int R, C; stage_rc(tid * 16 + i * 8192, R, C); const int Rb = Epi::PERM ? ((R & ~31) + perm32(R & 31)) : R;
        voffA[i] = (unsigned)(R * K + C) * 2u; voffB[i] = (unsigned)(Rb * K + C) * 2u; }
    const size_t kstep = (size_t)(BK * 2);
    const size_t hstep = (size_t)HALF * K * 2;
    const size_t tstep = 2 * hstep;
    const unsigned ldsw = (unsigned)wid * 1024u;
    const int aoff = lds_byte(wr * 64 + fr, fq * 8), boff = lds_byte(wc * 32 + fr, fq * 8);
#define PG8_SA(b, h) (((b) * 2 + (h)) * HTB)
#define PG8_SB(b, h) ((4 + (b) * 2 + (h)) * HTB)
#define PG8_STAGE(bufoff, gbase, voff) do { _Pragma("unroll") for (int _i = 0; _i < 2; ++_i) \
        __builtin_amdgcn_global_load_lds((const unsigned*)((const char*)(gbase) + (voff)[_i]), (PG8_LAS unsigned*)(lds + (bufoff) + ldsw + _i * 8192), 16, 0, 0); } while (0)
#define PG8_LDA(dst, b, h) do { _Pragma("unroll") for (int m = 0; m < 4; ++m) _Pragma("unroll") for (int k = 0; k < 2; ++k) dst[m][k] = *(const PG8_LAS bf16x8*)(lds + PG8_SA(b, h) + aoff + m * 2048 + k * 1024); } while (0)
#define PG8_LDB(dst, b, h) do { _Pragma("unroll") for (int n = 0; n < 2; ++n) _Pragma("unroll") for (int k = 0; k < 2; ++k) dst[n][k] = *(const PG8_LAS bf16x8*)(lds + PG8_SB(b, h) + boff + n * 2048 + k * 1024); } while (0)
#define PG8_MMA(ai, bj, At, Bt) do { __builtin_amdgcn_s_setprio(1); _Pragma("unroll") for (int m = 0; m < 4; ++m) _Pragma("unroll") for (int n = 0; n < 2; ++n) _Pragma("unroll") for (int k = 0; k < 2; ++k) \
        acc[ai][bj][m][n] = __builtin_amdgcn_mfma_f32_16x16x32_bf16(Bt[n][k], At[m][k], acc[ai][bj][m][n], 0, 0, 0); __builtin_amdgcn_s_setprio(0); } while (0)
#define PG8_WAIT_V(n) asm volatile("s_waitcnt vmcnt(" #n ")" ::: "memory")
#define PG8_WAIT_L(n) asm volatile("s_waitcnt lgkmcnt(" #n ")" ::: "memory")
#define PG8_BAR __builtin_amdgcn_s_barrier()
#define PG8_SCHED __builtin_amdgcn_sched_barrier(0)
    Unit cur, nxt; int ui = 0;
    if (!S.next(0, cur)) return;
    f32x4 acc[2][2][4][2];
#pragma unroll
    for (int a = 0; a < 2; ++a)
#pragma unroll
        for (int b = 0; b < 2; ++b)
#pragma unroll
            for (int m = 0; m < 4; ++m)
#pragma unroll
                for (int n = 0; n < 2; ++n) acc[a][b][m][n] = (f32x4){0.f, 0.f, 0.f, 0.f};
    bf16x8 At[4][2], B0[2][2], B1[2][2];
    const char* cA = (const char*)g.A + (size_t)cur.pm * tstep; const char* cB = (const char*)g.Bt + (size_t)cur.pn * tstep;
    S.a_ready(cur);
    if constexpr (SP2) {
        PG8_STAGE(PG8_SB(0, 0), cB, voffB); PG8_STAGE(PG8_SB(0, 1), cB + hstep, voffB); PG8_STAGE(PG8_SA(0, 0), cA, voffA); PG8_STAGE(PG8_SA(0, 1), cA + hstep, voffA);
        if (wr == 1) PG8_BAR;
        PG8_WAIT_V(2); PG8_BAR;
        PG8_STAGE(PG8_SB(1, 0), cB + kstep, voffB); PG8_STAGE(PG8_SA(1, 0), cA + kstep, voffA); PG8_STAGE(PG8_SB(1, 1), cB + hstep + kstep, voffB);
        PG8_WAIT_V(6); PG8_BAR;
    } else {
        PG8_STAGE(PG8_SB(0, 0), cB, voffB); PG8_STAGE(PG8_SA(0, 0), cA, voffA); PG8_STAGE(PG8_SB(0, 1), cB + hstep, voffB); PG8_STAGE(PG8_SA(0, 1), cA + hstep, voffA);
        if (wr == 1) PG8_BAR;
        PG8_WAIT_V(4); PG8_BAR;
        PG8_STAGE(PG8_SB(1, 0), cB + kstep, voffB); PG8_STAGE(PG8_SA(1, 0), cA + kstep, voffA); PG8_STAGE(PG8_SB(1, 1), cB + hstep + kstep, voffB);
        PG8_WAIT_V(6); PG8_BAR;
    }
    for (;;) {
        const bool has_next = S.next(ui + 1, nxt);
        const char* nA = has_next ? (const char*)g.A + (size_t)nxt.pm * tstep : cA; const char* nB = has_next ? (const char*)g.Bt + (size_t)nxt.pn * tstep : cB;
        for (int t = 0; t < nt; t += 2) {
            const bool last = (t == nt - 2);
            const char* a1 = cA + (size_t)(t + 1) * kstep;
            const char* a2 = last ? nA : cA + (size_t)(t + 2) * kstep; const char* b2 = last ? nB : cB + (size_t)(t + 2) * kstep;
            const char* a3 = a2 + kstep; const char* b3 = b2 + kstep;
            if (last && has_next) S.a_ready(nxt);
            if constexpr (SP2) {
            PG8_LDB(B0, 0, 0); PG8_LDB(B1, 0, 1); PG8_SCHED; PG8_LDA(At, 0, 0); PG8_STAGE(PG8_SA(1, 1), a1 + hstep, voffA);
            PG8_WAIT_V(8); PG8_WAIT_L(0); PG8_BAR; PG8_MMA(0, 0, At, B0); PG8_MMA(0, 1, At, B1); PG8_BAR; PG8_SCHED;
            PG8_LDA(At, 0, 1); PG8_STAGE(PG8_SB(0, 0), b2, voffB); PG8_STAGE(PG8_SB(0, 1), b2 + hstep, voffB); PG8_STAGE(PG8_SA(0, 0), a2, voffA);
            PG8_WAIT_V(8); PG8_WAIT_L(0); PG8_BAR; PG8_MMA(1, 0, At, B0); PG8_MMA(1, 1, At, B1); PG8_BAR; PG8_SCHED;
            PG8_LDB(B0, 1, 0); PG8_LDB(B1, 1, 1); PG8_SCHED; PG8_LDA(At, 1, 0); PG8_STAGE(PG8_SA(0, 1), a2 + hstep, voffA);
            PG8_WAIT_V(8); PG8_WAIT_L(0); PG8_BAR; PG8_MMA(0, 0, At, B0); PG8_MMA(0, 1, At, B1); PG8_BAR; PG8_SCHED;
            PG8_LDA(At, 1, 1); PG8_STAGE(PG8_SB(1, 0), b3, voffB); PG8_STAGE(PG8_SB(1, 1), b3 + hstep, voffB); PG8_STAGE(PG8_SA(1, 0), a3, voffA);
            PG8_WAIT_V(8); PG8_WAIT_L(0); PG8_BAR; PG8_MMA(1, 0, At, B0); PG8_MMA(1, 1, At, B1); PG8_BAR; PG8_SCHED;
            } else {
            PG8_LDB(B0, 0, 0); PG8_SCHED; PG8_LDA(At, 0, 0); PG8_STAGE(PG8_SA(1, 1), a1 + hstep, voffA);
            PG8_WAIT_L(8); PG8_BAR; PG8_WAIT_L(0); PG8_MMA(0, 0, At, B0); PG8_BAR; PG8_SCHED;
            PG8_LDB(B1, 0, 1); PG8_STAGE(PG8_SB(0, 0), b2, voffB);
            PG8_BAR; PG8_WAIT_L(0); PG8_MMA(0, 1, At, B1); PG8_BAR;
            PG8_LDA(At, 0, 1); PG8_STAGE(PG8_SA(0, 0), a2, voffA);
            PG8_BAR; PG8_WAIT_L(0); PG8_MMA(1, 0, At, B0); PG8_BAR; PG8_SCHED;
            PG8_STAGE(PG8_SB(0, 1), b2 + hstep, voffB);
            PG8_WAIT_V(6); PG8_BAR; PG8_MMA(1, 1, At, B1); PG8_BAR;
            PG8_LDB(B0, 1, 0); PG8_SCHED; PG8_LDA(At, 1, 0); PG8_STAGE(PG8_SA(0, 1), a2 + hstep, voffA);
            PG8_WAIT_L(8); PG8_BAR; PG8_WAIT_L(0); PG8_MMA(0, 0, At, B0); PG8_BAR; PG8_SCHED;
            PG8_LDB(B1, 1, 1); PG8_STAGE(PG8_SB(1, 0), b3, voffB);
            PG8_BAR; PG8_WAIT_L(0); PG8_MMA(0, 1, At, B1); PG8_BAR;
            PG8_LDA(At, 1, 1); PG8_STAGE(PG8_SA(1, 0), a3, voffA);
            PG8_BAR; PG8_WAIT_L(0); PG8_MMA(1, 0, At, B0); PG8_BAR; PG8_SCHED;
            PG8_STAGE(PG8_SB(1, 1), b3 + hstep, voffB);
            PG8_WAIT_V(6); PG8_BAR; PG8_MMA(1, 1, At, B1); PG8_BAR;
            }
        }
        if constexpr (ALIGN_EPI) { if (wr == 0) PG8_BAR; }
        if constexpr (!Epi::AFTER_DRAIN) { E(acc, cur, wr, wc, fr, fq); S.done(cur); }
        if (!has_next) break;
#pragma unroll
        for (int a = 0; a < 2; ++a)
#pragma unroll
            for (int b = 0; b < 2; ++b)
#pragma unroll
                for (int m = 0; m < 4; ++m)
#pragma unroll
                    for (int n = 0; n < 2; ++n) acc[a][b][m][n] = (f32x4){0.f, 0.f, 0.f, 0.f};
        cur = nxt; cA = nA; cB = nB; ++ui;
        if constexpr (ALIGN_EPI) { if (wr == 1) PG8_BAR; }
    }
    PG8_WAIT_V(0);
    if constexpr (!ALIGN_EPI) { if (wr == 0) PG8_BAR; }
    PG8_BAR;
    if constexpr (Epi::AFTER_DRAIN) { E.fused(acc, cur, wr, wc, fr, fq, lds, wid, lane); S.done(cur); }
#undef PG8_SA
#undef PG8_SB
#undef PG8_STAGE
#undef PG8_LDA
#undef PG8_LDB
#undef PG8_MMA
#undef PG8_WAIT_V
#undef PG8_WAIT_L
#undef PG8_BAR
#undef PG8_SCHED
}
}
#include <hip/hip_bf16.h>
#include <cmath>
namespace attn_body {
using bf16=__hip_bfloat16;
using bf16x8=__attribute__((ext_vector_type(8)))short;
using s16x4=__attribute__((ext_vector_type(4)))short;
using f32x16=__attribute__((ext_vector_type(16)))float;
using u32x4=__attribute__((ext_vector_type(4)))unsigned;
constexpr int BATCH=1,NHEAD=16,SEQ=16384,D=64,DM=NHEAD*D,KVP=256,NKT=260;
constexpr int NW=8,QBLK=32,QB=QBLK*NW,KVBLK=64,NQB=SEQ/QB;
constexpr int ATTN_PITCH=DM, ATTN_UNIT_ROWS=QB;
__device__ __forceinline__ int crow(int r,int hi){return (r&3)+8*(r>>2)+4*hi;}
#define SBAR() __builtin_amdgcn_sched_barrier(0)
__device__ __forceinline__ void cmask(f32x16&p0,f32x16&p1,int jb,int qrel,int hi){
  const float NEG=-INFINITY; int kb=64*jb+4*hi;
  #pragma unroll
  for(int r=0;r<16;++r){int kv=kb+(r&3)+8*(r>>2); if(kv>qrel)p0[r]=NEG; if(kv+32>qrel)p1[r]=NEG;}
}

constexpr int NSLOT=3, SLOTB=8192;
constexpr int LDS_K=0, LDS_V=NSLOT*SLOTB, LDS_WS=2*NSLOT*SLOTB, LDS_OST=LDS_WS+NW*64*4, LDS_BYTES=LDS_OST+NW*4096;
constexpr float C2=0.125f*1.4426950408889634f;
__device__ __forceinline__ void glds16(const void*gsrc,unsigned lds_dst){unsigned keep;
  asm volatile("s_mov_b32 %0, m0\n\ts_mov_b32 m0, %2\n\ts_nop 0\n\tglobal_load_lds_dwordx4 %1, off\n\ts_mov_b32 m0, %0":"=&s"(keep):"v"(gsrc),"s"(lds_dst):"memory");}
__device__ __forceinline__ float max3f(float a,float b,float c){float r;asm("v_max3_f32 %0, %1, %2, %3":"=v"(r):"v"(a),"v"(b),"v"(c));return r;}
__device__ __forceinline__ float max2f(float a,float b){float r;asm("v_max_f32_e32 %0, %1, %2":"=v"(r):"v"(a),"v"(b));return r;}
__device__ __forceinline__ float fadd_s(float a,float b){float r;asm("v_add_f32_e32 %0, %1, %2":"=v"(r):"v"(a),"v"(b));return r;}
__device__ __forceinline__ float fsub_s(float a,float b){float r;asm("v_sub_f32_e32 %0, %1, %2":"=v"(r):"v"(a),"v"(b));return r;}
typedef float f32x2_t __attribute__((ext_vector_type(2))); typedef __bf16 bf16x2_t __attribute__((ext_vector_type(2)));
__device__ __forceinline__ unsigned cvtpk_s(float lo,float hi){f32x2_t v={lo,hi};bf16x2_t b=__builtin_convertvector(v,bf16x2_t);return __builtin_bit_cast(unsigned,b);}
#define WAIT_BAR(N) asm volatile("s_waitcnt vmcnt(" #N ") lgkmcnt(0)\n\ts_barrier":::"memory")

__device__ __forceinline__ void qkt(f32x16&p0,f32x16&p1,const char*Kslot,const bf16x8*qr,const f32x16&negm,int r32,int hi){
  const char*kb=Kslot+hi*1024+r32*16;
  #pragma unroll
  for(int d0=0;d0<4;++d0){
    const bf16x8 b0=*reinterpret_cast<const bf16x8*>(kb+d0*2048);
    const bf16x8 b1=*reinterpret_cast<const bf16x8*>(kb+d0*2048+512);
    if(d0==0){p0=__builtin_amdgcn_mfma_f32_32x32x16_bf16(b0,qr[0],negm,0,0,0);p1=__builtin_amdgcn_mfma_f32_32x32x16_bf16(b1,qr[0],negm,0,0,0);}
    else{p0=__builtin_amdgcn_mfma_f32_32x32x16_bf16(b0,qr[d0],p0,0,0,0);p1=__builtin_amdgcn_mfma_f32_32x32x16_bf16(b1,qr[d0],p1,0,0,0);}}
}
typedef __attribute__((address_space(3))) const char* lds_cptr;
typedef short v4i16_t __attribute__((ext_vector_type(4)));
__device__ __forceinline__ void kload8(bf16x8*kf,lds_cptr kp){
  kf[0]=*(const __attribute__((address_space(3))) bf16x8*)(kp);      kf[1]=*(const __attribute__((address_space(3))) bf16x8*)(kp+512);
  kf[2]=*(const __attribute__((address_space(3))) bf16x8*)(kp+2048); kf[3]=*(const __attribute__((address_space(3))) bf16x8*)(kp+2560);
  kf[4]=*(const __attribute__((address_space(3))) bf16x8*)(kp+4096); kf[5]=*(const __attribute__((address_space(3))) bf16x8*)(kp+4608);
  kf[6]=*(const __attribute__((address_space(3))) bf16x8*)(kp+6144); kf[7]=*(const __attribute__((address_space(3))) bf16x8*)(kp+6656);
}
__device__ __forceinline__ void kload2(bf16x8*kf,lds_cptr kp,int j){ kf[2*j]=*(const __attribute__((address_space(3))) bf16x8*)(kp+j*2048); kf[2*j+1]=*(const __attribute__((address_space(3))) bf16x8*)(kp+j*2048+512); }
__device__ __forceinline__ s16x4 vtr(lds_cptr p){ return __builtin_bit_cast(s16x4,__builtin_amdgcn_ds_read_tr16_b64_v4i16((__attribute__((address_space(3))) v4i16_t*)p)); }
__device__ __forceinline__ float rowmax(const f32x16&p0,const f32x16&p1){
  float a=max3f(p0[0],p0[1],p1[0]),b=max3f(p0[2],p0[3],p1[1]);a=max3f(a,p1[2],p1[3]);
  #pragma unroll
  for(int r=4;r<16;r+=4){a=max3f(a,p0[r],p0[r+1]);b=max3f(b,p0[r+2],p0[r+3]);a=max3f(a,p1[r],p1[r+1]);b=max3f(b,p1[r+2],p1[r+3]);}
  const float m=max2f(a,b);
  auto rr=__builtin_amdgcn_permlane32_swap(__float_as_uint(m),__float_as_uint(m),false,false);
  return max2f(__uint_as_float(rr[0]),__uint_as_float(rr[1]));
}
__device__ __forceinline__ void pv(f32x16*o,int vb,bf16x8 pa0,bf16x8 pa1,bf16x8 pa2,bf16x8 pa3){
  #pragma unroll
  for(int d0=0;d0<2;++d0){s16x4 lo[4],hi[4];
    #pragma unroll
    for(int ks=0;ks<4;++ks){
      asm volatile("ds_read_b64_tr_b16 %0,%1 offset:%c2":"=&v"(lo[ks]):"v"(vb),"i"(d0*4096+ks*1024):"memory");
      asm volatile("ds_read_b64_tr_b16 %0,%1 offset:%c2":"=&v"(hi[ks]):"v"(vb),"i"(d0*4096+ks*1024+512):"memory");}
    asm volatile("s_waitcnt lgkmcnt(0)":::"memory");SBAR();
    #define PK(k) (bf16x8){lo[k][0],lo[k][1],lo[k][2],lo[k][3],hi[k][0],hi[k][1],hi[k][2],hi[k][3]}
    o[d0]=__builtin_amdgcn_mfma_f32_32x32x16_bf16(pa0,PK(0),o[d0],0,0,0);
    o[d0]=__builtin_amdgcn_mfma_f32_32x32x16_bf16(pa1,PK(1),o[d0],0,0,0);
    o[d0]=__builtin_amdgcn_mfma_f32_32x32x16_bf16(pa2,PK(2),o[d0],0,0,0);
    o[d0]=__builtin_amdgcn_mfma_f32_32x32x16_bf16(pa3,PK(3),o[d0],0,0,0);
    #undef PK
  }
}

#ifndef ATTN_STORE16
#define ATTN_STORE16(p,v) (*(u32x4*)(p)=(v))
#endif
template<int THRL> __device__ __forceinline__ void attn_unit(int b,int h,int qb,const bf16*Q,const bf16*__restrict__ K,const bf16*__restrict__ V,bf16*O,char*shm){
  int tid_=threadIdx.x; asm volatile("":"+v"(tid_)); const int tid=tid_,lane=tid&63,r32=lane&31,hi=lane>>5; const int wid=__builtin_amdgcn_readfirstlane(tid>>6);
  const long rowbase=(long)b*SEQ; const int q0=qb*QB;
  const bf16*Qw=Q+(rowbase+q0+wid*QBLK)*DM+h*D;
  const bf16*Kh=K+(h>>2)*D,*Vh=V+(h>>2)*D;
  const unsigned lds0=(unsigned)(uintptr_t)shm;
  float*wsf=(float*)(shm+LDS_WS)+wid*64;
  const bf16*ksrc=Kh+(long)lane*KVP+wid*8;
  const bf16*vsrc=Vh+(long)(16*(wid&3)+(lane>>2))*KVP+(wid>>2)*32+(lane&3)*8;
  const unsigned kdst=lds0+LDS_K+wid*1024, vdst=lds0+LDS_V+wid*1024;
  #define DMA_K(t,slot) glds16(ksrc+(long)(t)*KVBLK*KVP,(unsigned)__builtin_amdgcn_readfirstlane(kdst+(slot)))
  #define DMA_V(t,slot) glds16(vsrc+(long)(t)*KVBLK*KVP,(unsigned)__builtin_amdgcn_readfirstlane(vdst+(slot)))
  const int vb0=(int)(lds0+LDS_V)+((lane>>4)&1)*32+(lane&3)*8+(4*hi+((lane&15)>>2))*64;
  const char*Kbase=shm+LDS_K; bf16x8 kf[8];
  const lds_cptr shm3=(lds_cptr)shm; const lds_cptr kp0=shm3+LDS_K+hi*1024+r32*16; const lds_cptr vp0=shm3+LDS_V+((lane>>4)&1)*32+(lane&3)*8+(4*hi+((lane&15)>>2))*64;
  const int NT=NKT;
  DMA_K(0,0);DMA_V(0,0);DMA_K(1,SLOTB);
  bf16x8 qr[4];
  #pragma unroll
  for(int d0=0;d0<4;++d0)qr[d0]=*reinterpret_cast<const bf16x8*>(&Qw[(long)r32*DM+d0*16+hi*8]);
  float mhat=0.f,l_reg=0.f;f32x16 o[2];o[0]=f32x16{};o[1]=f32x16{};f32x16 negm=f32x16{};asm volatile("":"+v"(negm));
  const int qrel=wid*QBLK+r32;
  #define CMASK(P0,P1,t) do{}while(0)
  bool resc=false;
  #define START(P0,P1) do{ const float rm=rowmax(P0,P1); resc=false; \
    { const float dl=rm; mhat=fadd_s(mhat,dl); \
      _Pragma("unroll") for(int r=0;r<16;++r){P0[r]=fsub_s(P0[r],dl);P1[r]=fsub_s(P1[r],dl);} \
      _Pragma("unroll") for(int r=0;r<16;++r)negm[r]=-mhat; asm volatile("":"+v"(negm)); } \
    _Pragma("unroll") for(int r=0;r<16;++r)P0[r]=__builtin_amdgcn_exp2f(P0[r]); }while(0)
  #define RESC() do{ if(resc){ asm volatile("s_waitcnt lgkmcnt(0)":::"memory"); \
      _Pragma("unroll") for(int d_=0;d_<2;++d_) _Pragma("unroll") for(int r=0;r<16;++r)o[d_][r]*=wsf[crow(r,hi)]; } }while(0)
  f32x16 pA0,pA1,pB0,pB1;
  int sl_prev=0,sl_cur=0,sl_next=SLOTB;
  #define ROT() do{sl_prev=sl_cur;sl_cur=sl_next;sl_next=(sl_next==(NSLOT-1)*SLOTB)?0:sl_next+SLOTB;}while(0)
  DMA_K(2,2*SLOTB);
  WAIT_BAR(3);
  qkt(pA0,pA1,Kbase,qr,negm,r32,hi);asm volatile("s_nop 15\n\ts_nop 7":"+v"(pA0),"+v"(pA1));CMASK(pA0,pA1,0);
  START(pA0,pA1);
  _Pragma("unroll") for(int r=0;r<16;++r)pA1[r]=__builtin_amdgcn_exp2f(pA1[r]);
  WAIT_BAR(0);
  DMA_K(3,0);DMA_V(1,SLOTB);
  ROT();
  kload8(kf,kp0+sl_cur);
  WAIT_BAR(2);
  s16x4 vlo[8],vhi[8]; u32x4 pw0,pw1,pw2,pw3;
  #define PKW(P,B) cvtpk_s(P[B],P[B+1])
  #define PAF(k) __builtin_bit_cast(bf16x8,pw##k)
  #define VFR(i) (bf16x8){vlo[i][0],vlo[i][1],vlo[i][2],vlo[i][3],vhi[i][0],vhi[i][1],vhi[i][2],vhi[i][3]}
  #define PIN(x) asm volatile("":"+v"(x))
  #define MX3(a,b,c) __builtin_fmaxf(__builtin_fmaxf((a),(b)),(c))
  #define GAPA(MF,A0,A1,A2,A3,W0,W1,PW) do{ MF; sacc+=A0; sacc+=A1; sacc+=A2; sacc+=A3; PIN(sacc); W0; W1; PIN(PW); SBAR(); }while(0)
  #define EX(v) __builtin_amdgcn_exp2f(v)
  #define GAPB(MF,X,B) do{ MF; X[B]=EX(X[B]); X[B+1]=EX(X[B+1]); X[B+2]=EX(X[B+2]); X[B+3]=EX(X[B+3]); PIN(X); SBAR(); }while(0)
  #define VRD(i) do{ vlo[i]=vtr(vp_+(((i)>>2)*4096+((i)&3)*1024)); vhi[i]=vtr(vp_+(((i)>>2)*4096+((i)&3)*1024+512)); }while(0)
  #define KRD(G,j) do{ if(G){ kload2(kf,kp0+sl_next,j); SBAR(); } }while(0)
  #define STEP(C0,C1,P0,P1,t,GK,GV,GL) do{ SBAR(); \
    const lds_cptr vp_=vp0+sl_prev; \
    VRD(0); SBAR(); float sacc=(P0[0]+P0[1]); \
    GAPA(C0=__builtin_amdgcn_mfma_f32_32x32x16_bf16(kf[0],qr[0],negm,0,0,0), P0[2],P0[3],P0[4],P0[5],     pw0[0]=PKW(P0,0), pw0[1]=PKW(P0,2), pw0); \
    VRD(4); SBAR(); GAPA(C1=__builtin_amdgcn_mfma_f32_32x32x16_bf16(kf[1],qr[0],negm,0,0,0), P0[6],P0[7],P0[8],P0[9],     pw0[2]=PKW(P0,4), pw0[3]=PKW(P0,6), pw0); \
    VRD(1); SBAR(); GAPA(C0=__builtin_amdgcn_mfma_f32_32x32x16_bf16(kf[2],qr[1],C0,0,0,0),   P0[10],P0[11],P0[12],P0[13], pw1[0]=PKW(P0,8), pw1[1]=PKW(P0,10), pw1); \
    VRD(5); SBAR(); GAPA(C1=__builtin_amdgcn_mfma_f32_32x32x16_bf16(kf[3],qr[1],C1,0,0,0),   P0[14],P0[15],P1[0],P1[1],   pw1[2]=PKW(P0,12),pw1[3]=PKW(P0,14), pw1); \
    VRD(2); SBAR(); GAPA(C0=__builtin_amdgcn_mfma_f32_32x32x16_bf16(kf[4],qr[2],C0,0,0,0),   P1[2],P1[3],P1[4],P1[5],     pw2[0]=PKW(P1,0), pw2[1]=PKW(P1,2), pw2); \
    VRD(6); SBAR(); GAPA(C1=__builtin_amdgcn_mfma_f32_32x32x16_bf16(kf[5],qr[2],C1,0,0,0),   P1[6],P1[7],P1[8],P1[9],     pw2[2]=PKW(P1,4), pw2[3]=PKW(P1,6), pw2); \
    VRD(3); SBAR(); GAPA(C0=__builtin_amdgcn_mfma_f32_32x32x16_bf16(kf[6],qr[3],C0,0,0,0),   P1[10],P1[11],P1[12],P1[13], pw3[0]=PKW(P1,8), pw3[1]=PKW(P1,10), pw3); \
    VRD(7); SBAR(); GAPA(C1=__builtin_amdgcn_mfma_f32_32x32x16_bf16(kf[7],qr[3],C1,0,0,0),   P1[14],P1[15],0.f,0.f,       pw3[2]=PKW(P1,12),pw3[3]=PKW(P1,14), pw3); \
    l_reg+=sacc; \
    if(GK){DMA_K((t)+3,sl_cur);} if(GV){DMA_V((t)+1,sl_next);} \
    CMASK(C0,C1,t); \
    { float a=MX3(C0[0],C0[1],C1[0]),b=MX3(C0[2],C0[3],C1[1]); a=MX3(a,C1[2],C1[3]); \
      _Pragma("unroll") for(int r=4;r<16;r+=4){a=MX3(a,C0[r],C0[r+1]);b=MX3(b,C0[r+2],C0[r+3]);a=MX3(a,C1[r],C1[r+1]);b=MX3(b,C1[r+2],C1[r+3]);} \
      float rm=__builtin_fmaxf(a,b); { auto rr=__builtin_amdgcn_permlane32_swap(__float_as_uint(rm),__float_as_uint(rm),false,false); rm=__builtin_fmaxf(__uint_as_float(rr[0]),__uint_as_float(rr[1])); } \
      resc=false; \
      if(__builtin_expect(__any(rm>(float)THRL),0)){ const float dl=__builtin_fmaxf(rm,0.f); mhat+=dl; \
        _Pragma("unroll") for(int r=0;r<16;++r){C0[r]-=dl;C1[r]-=dl;} \
        _Pragma("unroll") for(int r=0;r<16;++r)negm[r]=-mhat; asm volatile("":"+v"(negm)); \
        const float f=__builtin_amdgcn_exp2f(-dl); l_reg*=f; if(hi==0)wsf[r32]=f; resc=true; } } \
    SBAR(); \
    GAPB(o[0]=__builtin_amdgcn_mfma_f32_32x32x16_bf16(PAF(0),VFR(0),o[0],0,0,0), C0,0); \
    GAPB(o[1]=__builtin_amdgcn_mfma_f32_32x32x16_bf16(PAF(0),VFR(4),o[1],0,0,0), C0,4); \
    KRD(GL,0); GAPB(o[0]=__builtin_amdgcn_mfma_f32_32x32x16_bf16(PAF(1),VFR(1),o[0],0,0,0), C0,8); \
    KRD(GL,1); GAPB(o[1]=__builtin_amdgcn_mfma_f32_32x32x16_bf16(PAF(1),VFR(5),o[1],0,0,0), C0,12); \
    KRD(GL,2); GAPB(o[0]=__builtin_amdgcn_mfma_f32_32x32x16_bf16(PAF(2),VFR(2),o[0],0,0,0), C1,0); \
    KRD(GL,3); GAPB(o[1]=__builtin_amdgcn_mfma_f32_32x32x16_bf16(PAF(2),VFR(6),o[1],0,0,0), C1,4); \
    GAPB(o[0]=__builtin_amdgcn_mfma_f32_32x32x16_bf16(PAF(3),VFR(3),o[0],0,0,0), C1,8); \
    GAPB(o[1]=__builtin_amdgcn_mfma_f32_32x32x16_bf16(PAF(3),VFR(7),o[1],0,0,0), C1,12); \
    }while(0)
  int t=1;
  #undef CMASK
  #define CMASK(P0,P1,t) do{}while(0)
  for(;t+5<NT;t+=2){
    STEP(pB0,pB1,pA0,pA1,t,true,true,true);     WAIT_BAR(2); RESC(); ROT();
    STEP(pA0,pA1,pB0,pB1,t+1,true,true,true);   WAIT_BAR(2); RESC(); ROT();
  }
  #undef CMASK
  #define CMASK(P0,P1,t) do{}while(0)
  #define ENDW(tt) do{ if((tt)+3<NT){WAIT_BAR(2);} else if((tt)+2<NT){WAIT_BAR(1);} else {WAIT_BAR(0);} }while(0)
  for(;t+1<NT;t+=2){
    STEP(pB0,pB1,pA0,pA1,t,(t+3<NT),(t+1<NT),(t+1<NT));       ENDW(t);   RESC(); ROT();
    STEP(pA0,pA1,pB0,pB1,t+1,(t+4<NT),(t+2<NT),(t+2<NT));     ENDW(t+1); RESC(); ROT();
  }
  STEP(pB0,pB1,pA0,pA1,NT-1,false,false,false); RESC();
  { float sacc=pB0[0]+pB0[1]; _Pragma("unroll") for(int r=2;r<16;++r)sacc+=pB0[r]; _Pragma("unroll") for(int r=0;r<16;++r)sacc+=pB1[r]; l_reg+=sacc;
    pw0=(u32x4){PKW(pB0,0),PKW(pB0,2),PKW(pB0,4),PKW(pB0,6)};pw1=(u32x4){PKW(pB0,8),PKW(pB0,10),PKW(pB0,12),PKW(pB0,14)};pw2=(u32x4){PKW(pB1,0),PKW(pB1,2),PKW(pB1,4),PKW(pB1,6)};pw3=(u32x4){PKW(pB1,8),PKW(pB1,10),PKW(pB1,12),PKW(pB1,14)};
    SBAR(); pv(o,vb0+sl_cur,PAF(0),PAF(1),PAF(2),PAF(3)); }
  #undef PKW
  #undef PAF
  #undef VFR
  #undef PIN
  #undef MX3
  #undef GAPA
  #undef GAPB
  #undef EX
  #undef VRD
  #undef KRD
  #undef STEP
  #undef ENDW
  {auto rr=__builtin_amdgcn_permlane32_swap(__float_as_uint(l_reg),__float_as_uint(l_reg),false,false);l_reg=__uint_as_float(rr[0])+__uint_as_float(rr[1]);}
  if(hi==0)wsf[32+r32]=l_reg;asm volatile("s_waitcnt lgkmcnt(0)":::"memory");
  float rli[16];
  #pragma unroll
  for(int r=0;r<16;++r)rli[r]=__builtin_amdgcn_rcpf(wsf[32+crow(r,hi)]);
  bf16*Ow=O+(rowbase+q0+wid*QBLK)*DM+h*D;
  { bf16*stg=(bf16*)(shm+LDS_OST)+wid*2048;
    #pragma unroll
    for(int r=0;r<16;++r){const int orow=crow(r,hi);
      #pragma unroll
      for(int d0=0;d0<2;++d0)stg[orow*64+d0*32+r32]=__float2bfloat16(o[d0][r]*rli[r]);}
    asm volatile("s_waitcnt lgkmcnt(0)":::"memory");
    #pragma unroll
    for(int i=0;i<4;++i){const int row=i*8+(lane>>3),ch=lane&7; const u32x4 v=*(const u32x4*)(stg+row*64+ch*8); ATTN_STORE16(Ow+(long)row*DM+ch*8,v);} }
  asm volatile("s_waitcnt lgkmcnt(0)\n\ts_barrier":::"memory");
  #undef DMA_K
  #undef DMA_V
  #undef CMASK
  #undef START
  #undef RESC
  #undef ROT
}
constexpr int ATTN_LDS_BYTES=LDS_BYTES;
struct AttnTensors { const bf16* Q; const bf16* K; const bf16* V; bf16* O; };
struct AttnUnit { int bh; int qb; };
struct StaticOrder {
  int vcu;
  __device__ __forceinline__ explicit StaticOrder(int grid,int block):vcu((grid%8==0)?(block%8)*(grid/8)+block/8:block){}
  __device__ __forceinline__ bool next(int i,AttnUnit&u)const{ if(i>=4)return false; const int x=vcu>>5, c=vcu&31; const int ul=(x&1)*128+c*4+i; u.bh=(x>>1)*4+(ul>>6); u.qb=ul&63; return true; }
  __device__ __forceinline__ void a_ready(const AttnUnit&)const{}
  __device__ __forceinline__ void done(const AttnUnit&)const{}
};
template<class Sched,int THRL=8> __device__ __forceinline__ void attn_phase(char*lds,const AttnTensors&T,const Sched&S){
  AttnUnit u;
  for(int i=0;S.next(i,u);++i){ S.a_ready(u); attn_unit<THRL>(u.bh/NHEAD,u.bh%NHEAD,u.qb,T.Q,T.K,T.V,T.O,lds); S.done(u); }
}
#undef SBAR
#undef WAIT_BAR
}
typedef unsigned short bf16;
typedef float f32x4 __attribute__((ext_vector_type(4)));
typedef float f32x2 __attribute__((ext_vector_type(2)));
typedef unsigned u32x4 __attribute__((ext_vector_type(4)));
typedef unsigned u32x2 __attribute__((ext_vector_type(2)));
#define LAS3 __attribute__((address_space(3)))

constexpr int T = 16640, NCTX = 256, NLAT = 16384, DM = 1024, FF = 4096, NQKV = 1536;
constexpr float EPS = 1e-6f;
constexpr size_t MiB = 1u << 20;
constexpr size_t WS_MOD = 0, WS_S5A = 128 * 1024, WS_S5BB = 256 * 1024, WS_ROPE = 768 * 1024;
constexpr size_t WS_WIN = 2 * MiB, WS_WGLU = 4 * MiB, WS_WOUT = 5 * MiB, WS_W1_0 = 7 * MiB, WS_W2_0 = 15 * MiB, WS_WQKV = 23 * MiB, WS_WAO = 26 * MiB, WS_W1_1 = 28 * MiB, WS_W2_1 = 36 * MiB;
constexpr size_t WS_XC = 44 * MiB, WS_H = 45 * MiB, WS_Y = 78 * MiB, WS_BIG = 111 * MiB;
constexpr size_t WS_U = WS_BIG, WS_G = 144 * MiB, WS_Z = 161 * MiB, WS_S5E = 194 * MiB, WS_S5H = 203 * MiB;
constexpr size_t WS_O = WS_BIG;
constexpr size_t WS_QKV = WS_BIG, WS_Q = 160 * MiB, WS_K = 193 * MiB, WS_V = 202 * MiB;
constexpr size_t WS_AP = 1 * MiB;
constexpr size_t WS_KS = 194 * MiB, WS_CA = 198 * MiB, WS_BA = 202 * MiB;
constexpr size_t OUT_E = 0, OUT_HIN = 40 * MiB;
constexpr int NC16 = 1040;
constexpr size_t WS_END = 241 * MiB;
constexpr int LDS_TOTAL = 143360;
constexpr int NCH = 260;

struct Params { const float* in[26]; float* out; unsigned char* ws; };
typedef const __attribute__((address_space(4))) Params* KP;

__device__ __forceinline__ float wave_sum(float v) {
#pragma unroll
    for (int o = 1; o < 64; o <<= 1) v += __shfl_xor(v, o);
    return v;
}
__device__ __forceinline__ float siluf(float x) { return x / (1.f + __expf(-x)); }
__device__ __forceinline__ unsigned f2bf(float f) { unsigned u = __float_as_uint(f); return (u + 0x7fffu + ((u >> 16) & 1u)) >> 16; }
__device__ __forceinline__ unsigned pk2(float lo, float hi) { return f2bf(lo) | (f2bf(hi) << 16); }
__device__ __forceinline__ float bflo(unsigned w) { return __uint_as_float(w << 16); }
__device__ __forceinline__ float bfhi(unsigned w) { return __uint_as_float(w & 0xffff0000u); }
__device__ __forceinline__ float gelu_tanh(float x) { const float a = 0.7978845608028654f * (x + 0.044715f * x * x * x); const float th = 1.f - 2.f / (1.f + __expf(2.f * a)); return 0.5f * x * (1.f + th); }

__device__ __forceinline__ void tr_item(const float* W, int ldw, bf16* WT, int ldt, float* scr, int lane) {
#pragma unroll 8
    for (int i = 0; i < 32; ++i) { const int kk = 2 * i + (lane >> 5); scr[kk * 33 + (lane & 31)] = W[(size_t)kk * ldw + (lane & 31)]; }
    __builtin_amdgcn_wave_barrier();
    const int c = lane & 7;
#pragma unroll
    for (int j = 0; j < 4; ++j) { const int n = (lane >> 3) + 8 * j; const float* s = scr + (8 * c) * 33 + n;
        u32x4 o; o.x = pk2(s[0 * 33], s[1 * 33]); o.y = pk2(s[2 * 33], s[3 * 33]); o.z = pk2(s[4 * 33], s[5 * 33]); o.w = pk2(s[6 * 33], s[7 * 33]);
        *(u32x4*)(WT + (size_t)n * ldt + 8 * c) = o; }
    __builtin_amdgcn_wave_barrier();
}

__device__ __forceinline__ void prologue(KP p, unsigned char* lds, int tid, int lane, int wave) {
    float* misc = (float*)(lds + 131072);
    float* red = misc + 2048;
    { const float* c = p->in[1]; const float* cc = p->in[3];
      for (int i = tid; i < 1024; i += 512) { misc[i] = siluf(c[i]); misc[1024 + i] = siluf(cc[i]); } }
    __syncthreads();
    float* modv = (float*)(p->ws + WS_MOD);
    for (int it = blockIdx.x; it < 192; it += gridDim.x) {
        const int l = it / 96, cb = it % 96, cl = tid & 63, kq = tid >> 6;
        const float* w = p->in[4] + (size_t)l * 1024 * 6144 + cb * 64 + cl;
        float a0 = 0.f, a1 = 0.f;
#pragma unroll 8
        for (int k = kq * 128; k < kq * 128 + 128; ++k) { const float wv = w[(size_t)k * 6144]; a0 += misc[k] * wv; a1 += misc[1024 + k] * wv; }
        red[kq * 64 + cl] = a0; red[512 + kq * 64 + cl] = a1;
        __syncthreads();
        if (tid < 128) { const int v = tid >> 6; float s = 0.f;
#pragma unroll
            for (int q = 0; q < 8; ++q) s += red[v * 512 + q * 64 + cl];
            modv[(size_t)(l * 2 + v) * 6144 + cb * 64 + cl] = s + p->in[5][l * 6144 + cb * 64 + cl]; }
        __syncthreads();
    }
    float* scr = (float*)(lds + wave * 16384);
    const int gw = blockIdx.x * 8 + wave, NGW = gridDim.x * 8;
    constexpr int I_IN = 512, I_GLU = 256, I_OUT = 256, I_W1 = 2048, I_W2 = 2048, I_QKV = 768, I_AO = 512;
    constexpr int NITEMS = I_IN + I_GLU + I_OUT + 2 * (I_W1 + I_W2) + I_QKV + I_AO;
    for (int it = gw; it < NITEMS; it += NGW) {
        int r = it; const float* W; int N, ldt; bf16* WT; bool glu = false;
        if (r < I_IN) { W = p->in[9]; N = 1024; ldt = 1024; WT = (bf16*)(p->ws + WS_WIN); }
        else if ((r -= I_IN) < I_GLU) { W = p->in[19]; N = 1024; ldt = 512; WT = (bf16*)(p->ws + WS_WGLU); glu = true; }
        else if ((r -= I_GLU) < I_OUT) { W = p->in[10]; N = 1024; ldt = 1024; WT = (bf16*)(p->ws + WS_WOUT); }
        else if ((r -= I_OUT) < I_W1) { W = p->in[7]; N = 4096; ldt = 1024; WT = (bf16*)(p->ws + WS_W1_0); }
        else if ((r -= I_W1) < I_W2) { W = p->in[8]; N = 1024; ldt = 4096; WT = (bf16*)(p->ws + WS_W2_0); }
        else if ((r -= I_W2) < I_QKV) { W = p->in[22]; N = 1536; ldt = 1024; WT = (bf16*)(p->ws + WS_WQKV); }
        else if ((r -= I_QKV) < I_AO) { W = p->in[23]; N = 1024; ldt = 1024; WT = (bf16*)(p->ws + WS_WAO); }
        else if ((r -= I_AO) < I_W1) { W = p->in[7] + (size_t)1024 * 4096; N = 4096; ldt = 1024; WT = (bf16*)(p->ws + WS_W1_1); }
        else { r -= I_W1; W = p->in[8] + (size_t)4096 * 1024; N = 1024; ldt = 4096; WT = (bf16*)(p->ws + WS_W2_1); }
        const int nblk = N / 32, kb = r / nblk, nb = r % nblk, k0 = 64 * kb, n0 = 32 * nb;
        int drow = n0;
        if (glu) { const int bj = n0 >> 9, rem = n0 & 511; drow = 256 * (rem >> 7) + 128 * bj + (rem & 127); }
        tr_item(W + (size_t)k0 * N + n0, N, WT + (size_t)drow * ldt + k0, ldt, scr, lane);
    }
    const int gt = blockIdx.x * 512 + tid, NTH = gridDim.x * 512;
    for (int id = gt; id < 65536; id += NTH) {
        const int n = id & 1023, ib = (id >> 10) & 15, gi = id >> 14;
        const float* pw = p->in[20] + (size_t)gi * 16384 + (size_t)(ib * 8) * 128;
        const float* sc = p->in[21] + gi * 128;
        const float* wo = p->in[10] + (size_t)(512 + gi * 128) * 1024 + n;
        float acc[8];
#pragma unroll
        for (int e = 0; e < 8; ++e) acc[e] = 0.f;
        for (int j = 0; j < 128; ++j) { const float wv = wo[(size_t)j * 1024] * sc[j];
#pragma unroll
            for (int e = 0; e < 8; ++e) acc[e] += pw[e * 128 + j] * wv; }
        u32x4 o; o.x = pk2(acc[0], acc[1]); o.y = pk2(acc[2], acc[3]); o.z = pk2(acc[4], acc[5]); o.w = pk2(acc[6], acc[7]);
        *(u32x4*)((bf16*)(p->ws + WS_WOUT) + (size_t)n * 1024 + 512 + gi * 128 + ib * 8) = o;
    }
    for (int id = gt; id < 4096; id += NTH) {
        const float lr = p->in[11][id], li = p->in[12][id], dt = __expf(p->in[13][id >> 6]);
        const float mag = expf(lr * dt), ar = mag * cosf(li * dt), ai = mag * sinf(li * dt);
        const float den = lr * lr + li * li;
        const float fr = ((ar - 1.f) * lr + ai * li) / den, fi = (ai * lr - (ar - 1.f) * li) / den;
        float* A = (float*)(p->ws + WS_S5A); A[2 * id] = ar; A[2 * id + 1] = ai;
        float* BB = (float*)(p->ws + WS_S5BB) + (size_t)id * 32;
        const float* br = p->in[14] + (size_t)id * 16; const float* bi = p->in[15] + (size_t)id * 16;
#pragma unroll
        for (int c = 0; c < 16; ++c) { const float x = br[c], y = bi[c]; BB[c] = fr * x - fi * y; BB[16 + c] = fr * y + fi * x; }
        const int pos = id >> 4, fq = id & 15;
        const float inv = powf(10000.f, -(float)fq / 16.f), ang = (float)pos * inv;
        float* R = (float*)(p->ws + WS_ROPE); R[2 * id] = cosf(ang); R[2 * id + 1] = sinf(ang);
    }
    for (int id = gt; id < 64 * 17 * 64; id += NTH) {
        const int pp = id & 63, d = (id >> 6) % 17, dg = id / (64 * 17);
        const float lr = p->in[11][dg * 64 + pp], li = p->in[12][dg * 64 + pp], e = (float)d * expf(p->in[13][dg]);
        const float mag = expf(lr * e), ang = li * e;
        ((f32x2*)(p->ws + WS_AP))[id] = (f32x2){mag * cosf(ang), mag * sinf(ang)};
    }
}

struct RowP { const float* xlat; const float* xctx; float* olat; float* octx; const bf16* Y; const float* gA; const float* gate;
              const float* gB; const float* shsc; bf16* H; int r0; };
__device__ __forceinline__ void row_phase(const RowP& a, int lane, int wave) {
    const int gw = blockIdx.x * 8 + wave, NGW = gridDim.x * 8;
    for (int r = a.r0 + gw; r < T; r += NGW) {
        const bool isctx = r < NCTX; const int vo = isctx ? 6144 : 0;
        const float* xs = isctx ? a.xctx + (size_t)r * DM : a.xlat + (size_t)(r - NCTX) * DM;
        f32x4 v[4];
#pragma unroll
        for (int j = 0; j < 4; ++j) v[j] = ((const f32x4*)xs)[lane + 64 * j];
        if (a.Y) {
            f32x4 y[4]; float ss = 0.f;
#pragma unroll
            for (int j = 0; j < 4; ++j) { const u32x2 w = ((const u32x2*)(a.Y + (size_t)r * DM))[lane + 64 * j]; y[j] = (f32x4){bflo(w.x), bfhi(w.x), bflo(w.y), bfhi(w.y)};
                ss += (y[j].x * y[j].x + y[j].y * y[j].y) + (y[j].z * y[j].z + y[j].w * y[j].w); }
            const float rstd = rsqrtf(wave_sum(ss) * (1.f / DM) + EPS);
            float* xo = isctx ? a.octx + (size_t)r * DM : a.olat + (size_t)(r - NCTX) * DM;
#pragma unroll
            for (int j = 0; j < 4; ++j) { const f32x4 g = ((const f32x4*)a.gA)[lane + 64 * j], gt = ((const f32x4*)(a.gate + vo))[lane + 64 * j];
                v[j] = v[j] + gt * (y[j] * rstd * g); ((f32x4*)xo)[lane + 64 * j] = v[j]; }
        }
        if (a.H) {
            float ss = 0.f;
#pragma unroll
            for (int j = 0; j < 4; ++j) ss += (v[j].x * v[j].x + v[j].y * v[j].y) + (v[j].z * v[j].z + v[j].w * v[j].w);
            const float rstd = rsqrtf(wave_sum(ss) * (1.f / DM) + EPS);
#pragma unroll
            for (int j = 0; j < 4; ++j) { const f32x4 g = ((const f32x4*)a.gB)[lane + 64 * j], sh = ((const f32x4*)(a.shsc + vo))[lane + 64 * j], sc = ((const f32x4*)(a.shsc + vo + 1024))[lane + 64 * j];
                const f32x4 h = (v[j] * rstd * g) * (sc + 1.f) + sh;
                u32x2 o; o.x = pk2(h.x, h.y); o.y = pk2(h.z, h.w); ((u32x2*)(a.H + (size_t)r * DM))[lane + 64 * j] = o; }
        }
    }
}

__device__ __forceinline__ int s5_row(int dir, int j, int sl) { const int s = j * 64 + sl; return dir == 0 ? s : (j < 4 ? 255 - s : 16895 - s); }
__device__ __forceinline__ void s5_stage_u(const bf16* U, int row, int g, float* ut, int lane) {
    const u32x4* src = (const u32x4*)(U + (size_t)row * DM + g * 16);
    const u32x4 a = src[0], b = src[1];
    f32x4* d = (f32x4*)(ut + lane * 16);
    d[0] = (f32x4){bflo(a.x), bfhi(a.x), bflo(a.y), bfhi(a.y)}; d[1] = (f32x4){bflo(a.z), bfhi(a.z), bflo(a.w), bfhi(a.w)};
    d[2] = (f32x4){bflo(b.x), bfhi(b.x), bflo(b.y), bfhi(b.y)}; d[3] = (f32x4){bflo(b.z), bfhi(b.z), bflo(b.w), bfhi(b.w)};
}
#define S5_LOAD_BB(dir, g) do { const f32x4* bp_ = (const f32x4*)((const float*)(p->ws + WS_S5BB) + (size_t)(((dir) * 32 + (g)) * 64 + lane) * 32); \
    _Pragma("unroll") for (int q_ = 0; q_ < 4; ++q_) { const f32x4 t_ = bp_[q_]; bbr[4 * q_] = t_.x; bbr[4 * q_ + 1] = t_.y; bbr[4 * q_ + 2] = t_.z; bbr[4 * q_ + 3] = t_.w; } \
    _Pragma("unroll") for (int q_ = 0; q_ < 4; ++q_) { const f32x4 t_ = bp_[4 + q_]; bbi[4 * q_] = t_.x; bbi[4 * q_ + 1] = t_.y; bbi[4 * q_ + 2] = t_.z; bbi[4 * q_ + 3] = t_.w; } } while (0)
#define S5_STEP(utrow) do { const f32x4* up_ = (const f32x4*)(utrow); float bur_ = 0.f, bui_ = 0.f; \
    _Pragma("unroll") for (int q_ = 0; q_ < 4; ++q_) { const f32x4 u_ = up_[q_]; \
        bur_ += bbr[4 * q_] * u_.x + bbr[4 * q_ + 1] * u_.y + bbr[4 * q_ + 2] * u_.z + bbr[4 * q_ + 3] * u_.w; \
        bui_ += bbi[4 * q_] * u_.x + bbi[4 * q_ + 1] * u_.y + bbi[4 * q_ + 2] * u_.z + bbi[4 * q_ + 3] * u_.w; } \
    const float nr_ = ar * hr - ai * hi + bur_, ni_ = ar * hi + ai * hr + bui_; hr = nr_; hi = ni_; } while (0)

__device__ __forceinline__ void pool_s5a_phase(KP p, unsigned char* lds, int tid, int lane, int wave) {
    const bf16* U = (const bf16*)(p->ws + WS_U); bf16* Z = (bf16*)(p->ws + WS_Z);
    const int gw = blockIdx.x * 8 + wave, NGW = gridDim.x * 8;
    for (int it = gw; it < 4 * (T / 4); it += NGW) {
        const int gi = it / (T / 4), r = 4 * (it % (T / 4)) + (lane >> 4), col = 512 + gi * 128 + (lane & 15) * 8;
        const int w = 2 << gi, lo = w >> 1, hi = w - 1 - lo;
        const int s0 = r < NCTX ? 0 : NCTX, s1 = r < NCTX ? NCTX : T;
        const int st = (r - lo) < s0 ? s0 : (r - lo), en = (r + hi + 1) > s1 ? s1 : (r + hi + 1);
        float acc[8];
#pragma unroll
        for (int e = 0; e < 8; ++e) acc[e] = 0.f;
#define POOL_ACC(W) { u32x4 xv[W]; _Pragma("unroll") for (int q = 0; q < W; ++q) { int rr = r - (W / 2) + q; rr = rr < st ? st : (rr >= en ? en - 1 : rr); xv[q] = *(const u32x4*)(U + (size_t)rr * DM + col); } \
        _Pragma("unroll") for (int q = 0; q < W; ++q) { const int rr = r - (W / 2) + q; const float m_ = (rr >= st && rr < en) ? 1.f : 0.f; const u32x4 x = xv[q]; \
            acc[0] += m_ * bflo(x.x); acc[1] += m_ * bfhi(x.x); acc[2] += m_ * bflo(x.y); acc[3] += m_ * bfhi(x.y); acc[4] += m_ * bflo(x.z); acc[5] += m_ * bfhi(x.z); acc[6] += m_ * bflo(x.w); acc[7] += m_ * bfhi(x.w); } }
        if (gi == 0) POOL_ACC(2) else if (gi == 1) POOL_ACC(4) else if (gi == 2) POOL_ACC(8) else POOL_ACC(16)
#undef POOL_ACC
        const u32x4 x = *(const u32x4*)(U + (size_t)r * DM + col);
        const float ic = 1.f / (float)(en - st);
        u32x4 o; o.x = pk2(acc[0] * ic - bflo(x.x), acc[1] * ic - bfhi(x.x)); o.y = pk2(acc[2] * ic - bflo(x.y), acc[3] * ic - bfhi(x.y));
        o.z = pk2(acc[4] * ic - bflo(x.z), acc[5] * ic - bfhi(x.z)); o.w = pk2(acc[6] * ic - bflo(x.w), acc[7] * ic - bfhi(x.w));
        *(u32x4*)(Z + (size_t)r * DM + col) = o;
    }
}
typedef short bf16x8v __attribute__((ext_vector_type(8)));
typedef float f32x16v __attribute__((ext_vector_type(16)));
__device__ __forceinline__ int crow16(int r, int hi) { return (r & 3) + 8 * (r >> 2) + 4 * hi; }
__device__ __forceinline__ void s5_build(KP p, int tid) {
    const float* BBt = (const float*)(p->ws + WS_S5BB); const f32x2* AP = (const f32x2*)(p->ws + WS_AP);
    const int gt = blockIdx.x * 512 + tid, NTH = gridDim.x * 512;
    bf16* KS = (bf16*)(p->ws + WS_KS); bf16* CA = (bf16*)(p->ws + WS_CA); bf16* BA = (bf16*)(p->ws + WS_BA);
    for (int id = gt; id < 32 * 16 * 256; id += NTH) {
        const int cp = id & 15, c = (id >> 4) & 15, d = (id >> 8) & 15, g = id >> 12;
        float L[2];
#pragma unroll
        for (int dir = 0; dir < 2; ++dir) { const int dg = dir * 32 + g; float acc = 0.f;
            const float* crp = p->in[16] + (size_t)(dg * 16 + c) * 64; const float* cip = p->in[17] + (size_t)(dg * 16 + c) * 64;
            for (int q = 0; q < 64; ++q) { const f32x2 P = AP[(dg * 17 + d) * 64 + q]; const float Cr = crp[q], Ci = cip[q];
                const float Br = BBt[(size_t)(dg * 64 + q) * 32 + cp], Bi = BBt[(size_t)(dg * 64 + q) * 32 + 16 + cp];
                const float wr = Cr * P.x - Ci * P.y, wi = Cr * P.y + Ci * P.x; acc += wr * Br - wi * Bi; }
            L[dir] = acc; }
        bf16* Kg = KS + (size_t)g * 65536;
        if (d == 0) { const float v = L[0] + L[1] + (c == cp ? p->in[18][g * 16 + c] : 0.f); const bf16 b = (bf16)f2bf(v);
            for (int i = 0; i < 16; ++i) Kg[(size_t)(i * 16 + c) * 256 + i * 16 + cp] = b; }
        else { const bf16 bf = (bf16)f2bf(L[0]), br = (bf16)f2bf(L[1]);
            for (int i = 0; i + d < 16; ++i) { Kg[(size_t)((i + d) * 16 + c) * 256 + i * 16 + cp] = bf; Kg[(size_t)(i * 16 + c) * 256 + (i + d) * 16 + cp] = br; } }
    }
    for (int id = gt; id < 64 * 256 * 64; id += NTH) {
        const int q = id & 63, n = (id >> 6) & 255, dg = id >> 14, t = n >> 4, c = n & 15, e = (dg < 32) ? t + 1 : 16 - t;
        const f32x2 P = AP[(dg * 17 + e) * 64 + q]; const float Cr = p->in[16][(size_t)(dg * 16 + c) * 64 + q], Ci = p->in[17][(size_t)(dg * 16 + c) * 64 + q];
        CA[(size_t)(dg * 256 + n) * 128 + q] = (bf16)f2bf(Cr * P.x - Ci * P.y); CA[(size_t)(dg * 256 + n) * 128 + 64 + q] = (bf16)f2bf(-(Cr * P.y + Ci * P.x));
    }
    for (int id = gt; id < 64 * 64 * 256; id += NTH) {
        const int kk = id & 255, q = (id >> 8) & 63, dg = id >> 14, sdx = kk >> 4, cp = kk & 15, e = (dg < 32) ? 15 - sdx : sdx;
        const f32x2 P = AP[(dg * 17 + e) * 64 + q]; const float Br = BBt[(size_t)(dg * 64 + q) * 32 + cp], Bi = BBt[(size_t)(dg * 64 + q) * 32 + 16 + cp];
        BA[(size_t)(dg * 128 + q) * 256 + kk] = (bf16)f2bf(P.x * Br - P.y * Bi); BA[(size_t)(dg * 128 + 64 + q) * 256 + kk] = (bf16)f2bf(P.x * Bi + P.y * Br);
    }
}
__device__ __forceinline__ void s5_end_phase(KP p, int lane, int wave) {
    const bf16* U = (const bf16*)(p->ws + WS_U); const bf16* BA = (const bf16*)(p->ws + WS_BA); float* E = (float*)(p->ws + WS_Y);
    const int gw = blockIdx.x * 8 + wave, NGW = gridDim.x * 8, m = lane & 31, half = lane >> 5;
    for (int unit = gw; unit < 33 * 64; unit += NGW) {
        const int ct = unit >> 6, dir = (unit >> 5) & 1, g = unit & 31; const int chunk = (32 * ct + m) < NC16 ? (32 * ct + m) : NC16 - 1;
        const bf16* up = U + (size_t)(16 * chunk) * DM + 16 * g + 8 * half;
        const bf16* bp = BA + (size_t)((dir * 32 + g) * 128 + m) * 256 + 8 * half;
        f32x16v acc[4];
#pragma unroll
        for (int nt = 0; nt < 4; ++nt) acc[nt] = (f32x16v){};
#pragma unroll 8
        for (int ks = 0; ks < 16; ++ks) { const bf16x8v a = *(const bf16x8v*)(up + (size_t)ks * DM);
#pragma unroll
            for (int nt = 0; nt < 4; ++nt) { const bf16x8v b = *(const bf16x8v*)(bp + (size_t)(32 * nt) * 256 + 16 * ks);
                acc[nt] = __builtin_amdgcn_mfma_f32_32x32x16_bf16(a, b, acc[nt], 0, 0, 0); } }
#pragma unroll
        for (int nt = 0; nt < 4; ++nt)
#pragma unroll
            for (int r = 0; r < 16; ++r) { const int ch = 32 * ct + crow16(r, half); if (ch < NC16) E[(size_t)((dir * NC16 + ch) * 32 + g) * 128 + 32 * nt + m] = acc[nt][r]; }
    }
}
__device__ __forceinline__ void s5_carry_phase(KP p, unsigned char* lds, int lane, int wave) {
    const float* E = (const float*)(p->ws + WS_Y); bf16* Hin = (bf16*)(p->ws + WS_H);
    float* seg = (float*)lds;
    for (int dg = blockIdx.x; dg < 64; dg += gridDim.x) {
        const int dir = dg >> 5, g = dg & 31;
        const f32x2 A16 = ((const f32x2*)(p->ws + WS_AP))[(dg * 17 + 16) * 64 + lane];
        float hr = 0.f, hi = 0.f;
        for (int jb = 0; jb < 130; jb += 26) { float er[26], ei[26];
#pragma unroll
            for (int q = 0; q < 26; ++q) { const int j = 130 * wave + jb + q, rc = dir == 0 ? j : (j < 16 ? 15 - j : 1055 - j); const float* ep = E + (size_t)((dir * NC16 + rc) * 32 + g) * 128; er[q] = ep[lane]; ei[q] = ep[64 + lane]; }
#pragma unroll
            for (int q = 0; q < 26; ++q) { const float nr = A16.x * hr - A16.y * hi + er[q], ni = A16.x * hi + A16.y * hr + ei[q]; hr = nr; hi = ni; } }
        seg[wave * 128 + lane] = hr; seg[wave * 128 + 64 + lane] = hi;
        float pr = 1.f, pi = 0.f;
        for (int q = 0; q < 130; ++q) { const float nr = pr * A16.x - pi * A16.y, ni = pr * A16.y + pi * A16.x; pr = nr; pi = ni; }
        __syncthreads();
        hr = 0.f; hi = 0.f;
        for (int w = 0; w < wave; ++w) { const float sr = seg[w * 128 + lane], si = seg[w * 128 + 64 + lane]; const float nr = pr * hr - pi * hi + sr, ni = pr * hi + pi * hr + si; hr = nr; hi = ni; }
        for (int jb = 0; jb < 130; jb += 26) { float er[26], ei[26];
#pragma unroll
            for (int q = 0; q < 26; ++q) { const int j = 130 * wave + jb + q, rc = dir == 0 ? j : (j < 16 ? 15 - j : 1055 - j); const float* ep = E + (size_t)((dir * NC16 + rc) * 32 + g) * 128; er[q] = ep[lane]; ei[q] = ep[64 + lane]; }
#pragma unroll
            for (int q = 0; q < 26; ++q) { const int j = 130 * wave + jb + q, rc = dir == 0 ? j : (j < 16 ? 15 - j : 1055 - j); bf16* hp = Hin + (size_t)(dg * NC16 + rc) * 128;
                hp[lane] = (bf16)f2bf(hr); hp[64 + lane] = (bf16)f2bf(hi);
                const float nr = A16.x * hr - A16.y * hi + er[q], ni = A16.x * hi + A16.y * hr + ei[q]; hr = nr; hi = ni; } }
        __syncthreads();
    }
}
__device__ __forceinline__ void s5_out_phase(KP p, int lane, int wave) {
    const bf16* U = (const bf16*)(p->ws + WS_U); const bf16* KS = (const bf16*)(p->ws + WS_KS); const bf16* CA = (const bf16*)(p->ws + WS_CA);
    const bf16* Hin = (const bf16*)(p->ws + WS_H); bf16* G = (bf16*)(p->ws + WS_G);
    const int gw = blockIdx.x * 8 + wave, NGW = gridDim.x * 8, m = lane & 31, half = lane >> 5;
    for (int unit = gw; unit < 33 * 64; unit += NGW) {
        const int ct = unit >> 6, nh = (unit >> 5) & 1, g = unit & 31; const int chunk = (32 * ct + m) < NC16 ? (32 * ct + m) : NC16 - 1;
        const bf16* up = U + (size_t)(16 * chunk) * DM + 16 * g + 8 * half;
        const bf16* kp = KS + (size_t)(g * 256 + 128 * nh + m) * 256 + 8 * half;
        f32x16v acc[4];
#pragma unroll
        for (int nt = 0; nt < 4; ++nt) acc[nt] = (f32x16v){};
#pragma unroll 8
        for (int ks = 0; ks < 16; ++ks) { const bf16x8v a = *(const bf16x8v*)(up + (size_t)ks * DM);
#pragma unroll
            for (int nt = 0; nt < 4; ++nt) { const bf16x8v b = *(const bf16x8v*)(kp + (size_t)(32 * nt) * 256 + 16 * ks);
                acc[nt] = __builtin_amdgcn_mfma_f32_32x32x16_bf16(a, b, acc[nt], 0, 0, 0); } }
#pragma unroll 1
        for (int dir = 0; dir < 2; ++dir) { const int dg = dir * 32 + g; const bf16* hp = Hin + (size_t)(dg * NC16 + chunk) * 128 + 8 * half;
            const bf16* cp = CA + (size_t)(dg * 256 + 128 * nh + m) * 128 + 8 * half;
#pragma unroll
            for (int ks = 0; ks < 8; ++ks) { const bf16x8v a = *(const bf16x8v*)(hp + 16 * ks);
#pragma unroll
                for (int nt = 0; nt < 4; ++nt) { const bf16x8v b = *(const bf16x8v*)(cp + (size_t)(32 * nt) * 128 + 16 * ks);
                    acc[nt] = __builtin_amdgcn_mfma_f32_32x32x16_bf16(a, b, acc[nt], 0, 0, 0); } } }
#pragma unroll
        for (int nt = 0; nt < 4; ++nt) { const int t = 8 * nh + 2 * nt + (m >> 4), c = m & 15;
#pragma unroll
            for (int r = 0; r < 16; ++r) { const int ch = 32 * ct + crow16(r, half); if (ch < NC16) G[(size_t)(16 * ch + t) * 512 + 16 * g + c] = (bf16)f2bf(gelu_tanh(acc[nt][r])); } }
    }
}

__device__ __forceinline__ void qkv_post_phase(KP p, int lane, int wave) {
    const bf16* raw = (const bf16*)(p->ws + WS_QKV); bf16* Q = (bf16*)(p->ws + WS_Q); bf16* K = (bf16*)(p->ws + WS_K); bf16* V = (bf16*)(p->ws + WS_V);
    const float* R = (const float*)(p->ws + WS_ROPE);
    const int gw = blockIdx.x * 8 + wave, NGW = gridDim.x * 8;
    const int j = lane & 15, hq = lane >> 4;
    const f32x4 qn = ((const f32x4*)p->in[24])[j], kn = ((const f32x4*)p->in[25])[j];
    for (int r = gw; r < T; r += NGW) {
        const bool lat = r >= NCTX; const int tl = r - NCTX;
        const int pos = (j < 8) ? (tl >> 6) : (tl & 63);
        f32x4 cs0 = (f32x4){1.f, 0.f, 1.f, 0.f}, cs1 = cs0;
        if (lat) { const f32x4* rp = (const f32x4*)(R + (size_t)pos * 32 + 8 * (j & 3)); cs0 = rp[0]; cs1 = rp[1]; }
        const bool up = (j & 4) != 0;
        for (int pass = lat ? 0 : 4; pass < 5; ++pass) {
            const int col = pass < 4 ? (pass * 4 + hq) * 64 + 4 * j : 1024 + hq * 64 + 4 * j;
            const u32x2 w = *(const u32x2*)(raw + (size_t)r * NQKV + col);
            f32x4 x = (f32x4){bflo(w.x), bfhi(w.x), bflo(w.y), bfhi(w.y)};
            float ss = (x.x * x.x + x.y * x.y) + (x.z * x.z + x.w * x.w);
            ss += __shfl_xor(ss, 1); ss += __shfl_xor(ss, 2); ss += __shfl_xor(ss, 4); ss += __shfl_xor(ss, 8);
            const float rstd = rsqrtf(ss * (1.f / 64.f) + EPS);
            x = x * rstd * (pass < 4 ? qn : kn);
            if (lat) {
                f32x4 o; o.x = __shfl_xor(x.x, 4); o.y = __shfl_xor(x.y, 4); o.z = __shfl_xor(x.z, 4); o.w = __shfl_xor(x.w, 4);
                const float sg = up ? 1.f : -1.f;
                x.x = x.x * cs0.x + sg * o.x * cs0.y; x.y = x.y * cs0.z + sg * o.y * cs0.w; x.z = x.z * cs1.x + sg * o.z * cs1.y; x.w = x.w * cs1.z + sg * o.w * cs1.w;
            }
            if (pass < 4) { x = x * attn_body::C2; u32x2 o; o.x = pk2(x.x, x.y); o.y = pk2(x.z, x.w); *(u32x2*)(Q + (size_t)r * DM + (pass * 4 + hq) * 64 + 4 * j) = o; }
            else { u32x2 o; o.x = pk2(x.x, x.y); o.y = pk2(x.z, x.w); *(u32x2*)(K + (size_t)r * 256 + hq * 64 + 4 * j) = o; }
        }
        *(u32x2*)(V + (size_t)r * 256 + 4 * lane) = *(const u32x2*)(raw + (size_t)r * NQKV + 1280 + 4 * lane);
    }
}


template <int KIND> __device__ __forceinline__ void skinny_gemm(unsigned char* lds, const bf16* A, const bf16* Bt, int N, int K, bf16* O, int ldc, int tid, int lane, int wave) {
    const int nct = (KIND == 3 ? N / 2 : N) / 32, nunits = 8 * nct, m = lane & 31, half = lane >> 5, kw = K >> 3;
    float* red = (float*)lds;
    for (int u = blockIdx.x; u < nunits; u += gridDim.x) {
        const int rt = u & 7, ct = u >> 3;
        const int brow0 = (KIND == 3) ? 256 * (ct >> 2) + 32 * (ct & 3) : 32 * ct;
        const bf16* ap = A + (size_t)(32 * rt + m) * K + wave * kw + 8 * half;
        const bf16* bp = Bt + (size_t)(brow0 + m) * K + wave * kw + 8 * half;
        f32x16v acc0 = (f32x16v){}, acc1 = (f32x16v){};
#pragma unroll 4
        for (int ks = 0; ks < (kw >> 4); ++ks) { const bf16x8v a = *(const bf16x8v*)(ap + 16 * ks); const bf16x8v b0 = *(const bf16x8v*)(bp + 16 * ks);
            acc0 = __builtin_amdgcn_mfma_f32_32x32x16_bf16(a, b0, acc0, 0, 0, 0);
            if (KIND == 3) { const bf16x8v b1 = *(const bf16x8v*)(bp + (size_t)128 * K + 16 * ks); acc1 = __builtin_amdgcn_mfma_f32_32x32x16_bf16(a, b1, acc1, 0, 0, 0); } }
#pragma unroll
        for (int r = 0; r < 16; ++r) { red[(wave * 2) * 1024 + r * 64 + lane] = acc0[r]; if (KIND == 3) red[(wave * 2 + 1) * 1024 + r * 64 + lane] = acc1[r]; }
        __syncthreads();
        for (int e = tid; e < 1024; e += 512) { float s0 = 0.f, s1 = 0.f;
#pragma unroll
            for (int w = 0; w < 8; ++w) { s0 += red[(w * 2) * 1024 + e]; if (KIND == 3) s1 += red[(w * 2 + 1) * 1024 + e]; }
            const int r = e >> 6, ln = e & 63, row = 32 * rt + crow16(r, ln >> 5), col = 32 * ct + (ln & 31);
            float v = s0; if (KIND == 2) { v = v > 0.f ? v * v : 0.f; } if (KIND == 3) v = s0 / (1.f + __expf(-s1));
            O[(size_t)row * ldc + col] = (bf16)f2bf(v); }
        __syncthreads();
    }
}

template <class Epi> __device__ __forceinline__ void run_gemm(LAS3 unsigned char* lds3, const bf16* A, const bf16* Bt, int M, int N, int K, const Epi& E) {
    pg8::Gemm g{A, Bt, M, N, K}; pg8::StaticOrder S; S.init(M, N, (int)gridDim.x, (int)blockIdx.x);
    pg8::gemm_phase<Epi, pg8::StaticOrder, true, true>(lds3, g, S, E);
}
constexpr int NSTEP = 20;
__global__ void __launch_bounds__(512, 2) mega_fwd(Params p_unused) {
    extern __shared__ __attribute__((aligned(16))) unsigned char lds[];
    cg::grid_group grid = cg::this_grid();
    const size_t LO = (size_t)NCTX;
    bool again = false; (void)again;
#pragma unroll 1
    for (int step = 0; step < NSTEP; ++step) {
        KP p = (KP)__builtin_amdgcn_kernarg_segment_ptr();
        asm volatile("" : "+s"(p));
        int tid_ = threadIdx.x; asm volatile("" : "+v"(tid_));
        const int tid = tid_, lane = tid & 63, wave = __builtin_amdgcn_readfirstlane(tid >> 6);
        unsigned char* ws = p->ws;
        const float* modv = (const float*)(ws + WS_MOD);
        const float* ng = p->in[6];
        bf16* H = (bf16*)(ws + WS_H); bf16* Y = (bf16*)(ws + WS_Y); bf16* HID = (bf16*)(ws + WS_BIG);
        float* XC = (float*)(ws + WS_XC);
        if (step == 0) prologue(p, lds, tid, lane, wave);
        else if (step == 3) { pool_s5a_phase(p, lds, tid, lane, wave); s5_end_phase(p, lane, wave); }
        else if (step == 4) s5_carry_phase(p, lds, lane, wave);
        else if (step == 5) s5_out_phase(p, lane, wave);
        else if (step == 13) qkv_post_phase(p, lane, wave);
        else if (step == 14) {
            const attn_body::AttnTensors AT{(const attn_body::bf16*)(ws + WS_Q) + LO * DM, (const attn_body::bf16*)(ws + WS_K), (const attn_body::bf16*)(ws + WS_V), (attn_body::bf16*)(ws + WS_O) + LO * DM};
            const attn_body::StaticOrder S((int)gridDim.x, (int)blockIdx.x);
            attn_body::attn_phase<attn_body::StaticOrder>((char*)lds, AT, S);
        } else if (step == 1) {
            const RowP ra{p->in[0], p->in[2], nullptr, nullptr, nullptr, ng, modv, ng + 0 * 1024, modv + 0, H, 0};
            row_phase(ra, lane, wave); s5_build(p, tid);
        } else if (step == 8) {
            const RowP ra{p->in[0], p->in[2], p->out, XC, Y, ng + 1 * 1024, modv + 2048, ng + 2 * 1024, modv + 3072, H, 0};
            row_phase(ra, lane, wave);
        } else if (step == 11) {
            const RowP ra{p->out, XC, p->out, XC, Y, ng + 3 * 1024, modv + 5120, ng + 4 * 1024, modv + 2 * 6144 + 0, H, 0};
            row_phase(ra, lane, wave);
        } else if (step == 16) {
            const RowP ra{p->out, XC, p->out, XC, Y, ng + 5 * 1024, modv + 2 * 6144 + 2048, ng + 6 * 1024, modv + 2 * 6144 + 3072, H, NCTX};
            row_phase(ra, lane, wave);
        } else if (step == 19) {
            const RowP ra{p->out, XC, p->out, XC, Y, ng + 7 * 1024, modv + 2 * 6144 + 5120, ng, modv, nullptr, NCTX};
            row_phase(ra, lane, wave);
        } else {
            int gk = 0; const bf16* gA = H; const bf16* gB = nullptr; int gN = 1024, gK = 1024; bf16* gO = Y; int gld = 1024; bool ctx = true;
            switch (step) {
            case 2: gB = (const bf16*)(ws + WS_WIN); gO = (bf16*)(ws + WS_U); break;
            case 6: gk = 3; gA = (const bf16*)(ws + WS_G); gB = (const bf16*)(ws + WS_WGLU); gK = 512; gO = (bf16*)(ws + WS_Z); break;
            case 7: gA = (const bf16*)(ws + WS_Z); gB = (const bf16*)(ws + WS_WOUT); break;
            case 9: gk = 2; gB = (const bf16*)(ws + WS_W1_0); gN = 4096; gO = HID; gld = 4096; break;
            case 10: gA = HID; gB = (const bf16*)(ws + WS_W2_0); gK = 4096; break;
            case 12: gB = (const bf16*)(ws + WS_WQKV); gN = NQKV; gO = (bf16*)(ws + WS_QKV); gld = NQKV; break;
            case 15: gA = (const bf16*)(ws + WS_O); gB = (const bf16*)(ws + WS_WAO); ctx = false; break;
            case 17: gk = 2; gB = (const bf16*)(ws + WS_W1_1); gN = 4096; gO = HID; gld = 4096; ctx = false; break;
            default: gA = HID; gB = (const bf16*)(ws + WS_W2_1); gK = 4096; ctx = false; break;
            }
            const bf16* gAl = gA + LO * (size_t)gK; bf16* gOl = gO + LO * (size_t)gld;
            if (gk == 0) { if (ctx) skinny_gemm<0>(lds, gA, gB, gN, gK, gO, gld, tid, lane, wave); pg8::EpiBf16<0> E{gOl, gld}; run_gemm((LAS3 unsigned char*)lds, gAl, gB, NLAT, gN, gK, E); }
            else if (gk == 2) { if (ctx) skinny_gemm<2>(lds, gA, gB, gN, gK, gO, gld, tid, lane, wave); pg8::EpiBf16<2> E{gOl, gld}; run_gemm((LAS3 unsigned char*)lds, gAl, gB, NLAT, gN, gK, E); }
            else { skinny_gemm<3>(lds, gA, gB, gN, gK, gO, gld, tid, lane, wave); pg8::EpiGlu E{gOl, gld}; run_gemm((LAS3 unsigned char*)lds, gAl, gB, NLAT, gN, gK, E); }
        }
        if (step != NSTEP - 1) grid.sync();
#ifdef PROBE_MASK
        if (((PROBE_MASK >> step) & 1) && !again) { again = true; --step; } else again = false;
#endif
    }
}

extern "C" void kernel_launch(void* const* d_in, const int* in_sizes, int n_in, void* d_out, int out_size, void* d_ws, size_t ws_size, hipStream_t stream) {
    static int grid = 0;
    if (grid == 0) {
        if (n_in != 26 || out_size != NLAT * DM || ws_size < WS_END) { fprintf(stderr, "kernel_launch: unexpected shapes (n_in %d out %d ws %zu)\n", n_in, out_size, ws_size); grid = -1; return; }
        int dev = 0, cus = 0, per_cu = 0;
        (void)hipGetDevice(&dev); (void)hipDeviceGetAttribute(&cus, hipDeviceAttributeMultiprocessorCount, dev);
        if (hipFuncSetAttribute((const void*)mega_fwd, hipFuncAttributeMaxDynamicSharedMemorySize, LDS_TOTAL) != hipSuccess) { fprintf(stderr, "kernel_launch: hipFuncSetAttribute failed\n"); grid = -1; return; }
        if (hipOccupancyMaxActiveBlocksPerMultiprocessor(&per_cu, (const void*)mega_fwd, 512, LDS_TOTAL) != hipSuccess || per_cu < 1) { fprintf(stderr, "kernel_launch: occupancy query says %d\n", per_cu); per_cu = 1; (void)hipGetLastError(); }
        grid = cus * per_cu; if (grid > 256) grid = 256;
    }
    if (grid < 0) return;
    Params p{};
    for (int i = 0; i < 26; ++i) p.in[i] = (const float*)d_in[i];
    p.out = (float*)d_out; p.ws = (unsigned char*)d_ws;
    void* args[] = {&p};
    hipError_t e = hipLaunchCooperativeKernel((const void*)mega_fwd, dim3(grid), dim3(512), args, LDS_TOTAL, stream);
    if (e != hipSuccess) fprintf(stderr, "cooperative launch failed: %s (grid %d)\n", hipGetErrorString(e), grid);
}
```

```cpp
#include <hip/hip_runtime.h>
#include <hip/hip_cooperative_groups.h>
#include <cstdio>
#include <cstdint>
namespace cg = cooperative_groups;
namespace pg8 {
#define PG8_LAS __attribute__((address_space(3)))
typedef unsigned short bf16_t;
typedef short bf16x8 __attribute__((ext_vector_type(8)));
typedef float f32x4 __attribute__((ext_vector_type(4)));
typedef unsigned u32x4 __attribute__((ext_vector_type(4)));
constexpr int BM = 256, BK = 64, HALF = 128, HTB = HALF * BK * 2  , STAGE_BYTES = 8 * HTB, NXCD = 8, WGM = 8;

__host__ __device__ __forceinline__ int lds_byte(int r, int c) { const int st = (r >> 4) * 2 + (c >> 5), rr = r & 15, cc = c & 31, ob = rr * 64 + cc * 2; return st * 1024 + (ob ^ (((ob >> 9) & 1) << 5)); }
__host__ __device__ __forceinline__ void stage_rc(int b, int& R, int& C) { const int st = b / 1024, sb = b % 1024, swz = sb ^ (((sb >> 9) & 1) << 5); R = (st >> 1) * 16 + swz / 64; C = (st & 1) * 32 + (swz % 64) / 2; }
__host__ __device__ __forceinline__ int perm32(int rho) { const int n = rho >> 4, i = rho & 15; return 8 * (i >> 2) + 4 * n + (i & 3); }

struct Unit { int pm, pn; };
struct Gemm { const bf16_t* A; const bf16_t* Bt; int M, N, K; };

struct StaticOrder {
    int nM, nN, nwg, G, c;
    __host__ __device__ void init(int M, int N, int G_, int c_) { nM = M / BM; nN = N / BM; nwg = nM * nN; G = G_; c = c_; }
    __host__ __device__ bool next(int i, Unit& u) const {
        const long L = (long)i * G + c; if (L >= nwg) return false;
        int wgid = (int)L; { const int q = nwg / NXCD, r = nwg % NXCD, xcd = wgid % NXCD, off = wgid / NXCD; wgid = (xcd < r ? xcd * (q + 1) : r * (q + 1) + (xcd - r) * q) + off; }
        const int nig = WGM * nN, gid = wgid / nig, fm = gid * WGM, gsz = (nM - fm) < WGM ? (nM - fm) : WGM;
        u.pm = fm + ((wgid % nig) % gsz); u.pn = (wgid % nig) / gsz; return true;
    }
    __device__ __forceinline__ void a_ready(const Unit&) const {}
    __device__ __forceinline__ void done(const Unit&) const {}
};

__device__ __forceinline__ unsigned cvt_pk_bf16(float lo, float hi) { unsigned r; asm volatile("v_cvt_pk_bf16_f32 %0, %1, %2" : "=v"(r) : "v"(lo), "v"(hi)); return r; }
typedef float f32x2 __attribute__((ext_vector_type(2)));
template <int ACT> struct EpiBf16 {
    static constexpr bool PERM = true, AFTER_DRAIN = false;
    bf16_t* O; int ldc;
    __device__ __forceinline__ void operator()(const f32x4 (&acc)[2][2][4][2], const Unit& u, int wr, int wc, int fr, int fq) const {
        const int row0 = u.pm * BM + wr * 64 + fr; const int col0 = u.pn * BM + wc * 32 + 8 * fq;
#pragma unroll
        for (int ai = 0; ai < 2; ++ai)
#pragma unroll
            for (int m = 0; m < 4; ++m) { bf16_t* rowp = O + (size_t)(row0 + ai * HALF + m * 16) * ldc + col0;
#pragma unroll
                for (int bj = 0; bj < 2; ++bj) { f32x4 v0 = acc[ai][bj][m][0], v1 = acc[ai][bj][m][1];
                    if (ACT == 2) {
#pragma unroll
                        for (int e = 0; e < 4; ++e) { float a = v0[e] > 0.f ? v0[e] : 0.f; v0[e] = a * a; float b = v1[e] > 0.f ? v1[e] : 0.f; v1[e] = b * b; } }
                    u32x4 w; w.x = cvt_pk_bf16(v0[0], v0[1]); w.y = cvt_pk_bf16(v0[2], v0[3]); w.z = cvt_pk_bf16(v1[0], v1[1]); w.w = cvt_pk_bf16(v1[2], v1[3]);
                    *(u32x4*)(rowp + bj * HALF) = w; } }
    }
};
struct EpiGlu {
    static constexpr bool PERM = true, AFTER_DRAIN = false;
    bf16_t* O; int ldc;
    __device__ __forceinline__ void operator()(const f32x4 (&acc)[2][2][4][2], const Unit& u, int wr, int wc, int fr, int fq) const {
        const int row0 = u.pm * BM + wr * 64 + fr; const int col0 = u.pn * HALF + wc * 32 + 8 * fq;
#pragma unroll
        for (int ai = 0; ai < 2; ++ai)
#pragma unroll
            for (int m = 0; m < 4; ++m) { bf16_t* rowp = O + (size_t)(row0 + ai * HALF + m * 16) * ldc + col0;
                f32x4 v0 = acc[ai][0][m][0], v1 = acc[ai][0][m][1]; const f32x4 g0 = acc[ai][1][m][0], g1 = acc[ai][1][m][1];
#pragma unroll
                for (int e = 0; e < 4; ++e) { v0[e] = v0[e] / (1.f + __expf(-g0[e])); v1[e] = v1[e] / (1.f + __expf(-g1[e])); }
                u32x4 w; w.x = cvt_pk_bf16(v0[0], v0[1]); w.y = cvt_pk_bf16(v0[2], v0[3]); w.z = cvt_pk_bf16(v1[0], v1[1]); w.w = cvt_pk_bf16(v1[2], v1[3]);
                *(u32x4*)rowp = w; }
    }
};
struct PanelStats {
    unsigned* xbuf;
    unsigned* cnt;
    unsigned* tmo;
    int ntn; float eps;
    unsigned code;
    __device__ __forceinline__ bool run(const f32x4 (&v)[2][2][4][2], const Unit& u, int wr, int wc, int fr, int fq, PG8_LAS unsigned char* lds, int wid, int lane) const {
        typedef float f32x2v __attribute__((ext_vector_type(2)));
        PG8_LAS f32x2v* P = (PG8_LAS f32x2v*)lds;
        PG8_LAS f32x2v* S = (PG8_LAS f32x2v*)(lds + 8192);
        PG8_LAS unsigned* flag = (PG8_LAS unsigned*)(lds + 8192 + 2048);
#pragma unroll
        for (int ai = 0; ai < 2; ++ai)
#pragma unroll
            for (int m = 0; m < 4; ++m) {
                float s = 0.f;
#pragma unroll
                for (int bj = 0; bj < 2; ++bj)
#pragma unroll
                    for (int n = 0; n < 2; ++n) { const f32x4 x = v[ai][bj][m][n]; s += (x[0] + x[1]) + (x[2] + x[3]); }
                s += __shfl_xor(s, 16); s += __shfl_xor(s, 32);
                const float mw = s * (1.0f / 64.0f); float q = 0.f;
#pragma unroll
                for (int bj = 0; bj < 2; ++bj)
#pragma unroll
                    for (int n = 0; n < 2; ++n) { const f32x4 d = v[ai][bj][m][n] - mw; q += (d[0] * d[0] + d[1] * d[1]) + (d[2] * d[2] + d[3] * d[3]); }
                q += __shfl_xor(q, 16); q += __shfl_xor(q, 32);
                if (fq == 0) P[(ai * HALF + wr * 64 + m * 16 + fr) * 4 + wc] = (f32x2v){mw, q};
            }
        asm volatile("s_waitcnt lgkmcnt(0)" ::: "memory"); __builtin_amdgcn_s_barrier(); asm volatile("" ::: "memory");
#if defined(BROKEN_EXCHANGE_NO_WAIT)
#warning BROKEN CONTROL BUILD: the row-statistics exchange does not wait; results are wrong by design
        if (blockIdx.x >= 64) { const long long t0_ = clock64(); while (clock64() - t0_ < 60000) __builtin_amdgcn_s_sleep(8); }
#endif
        const int row = wid * 32 + (lane & 31);
        if (lane < 32) {
            const f32x2v a = P[row * 4 + 0], b = P[row * 4 + 1], c = P[row * 4 + 2], d = P[row * 4 + 3];
            const float mt = (a.x + b.x + c.x + d.x) * 0.25f;
            const float da = a.x - mt, db = b.x - mt, dc = c.x - mt, dd = d.x - mt;
            const float m2 = (a.y + b.y) + (c.y + d.y) + 64.0f * ((da * da + db * db) + (dc * dc + dd * dd));
            unsigned long long* slot = (unsigned long long*)xbuf + ((size_t)(u.pm * BM + row) * 4 + u.pn);
            __hip_atomic_store(slot, ((unsigned long long)__float_as_uint(m2) << 32) | __float_as_uint(mt), __ATOMIC_RELAXED, __HIP_MEMORY_SCOPE_AGENT);
        }
        asm volatile("s_waitcnt vmcnt(0)" ::: "memory");
        if (lane == 0) __hip_atomic_fetch_add(cnt + 64 * u.pm, 1u, __ATOMIC_RELAXED, __HIP_MEMORY_SCOPE_AGENT);
        if (wid == 0) {
            bool dead = false; const unsigned long long t0 = __builtin_amdgcn_s_memrealtime(); const unsigned want = 8u * (unsigned)ntn;
            for (;;) {
#if defined(BROKEN_EXCHANGE_NO_WAIT)
                break;
#endif
                if ((unsigned)__builtin_amdgcn_readfirstlane(__hip_atomic_load(cnt + 64 * u.pm, __ATOMIC_RELAXED, __HIP_MEMORY_SCOPE_AGENT)) >= want) break;
                if (__builtin_amdgcn_s_memrealtime() - t0 > 2000000ull) {
                    if (lane == 0) { unsigned expect = 0u; __hip_atomic_compare_exchange_strong(tmo + 1, &expect, code | (unsigned)(u.pm & 0xff), __ATOMIC_RELAXED, __ATOMIC_RELAXED, __HIP_MEMORY_SCOPE_AGENT);
                                     __hip_atomic_store(tmo, 1u, __ATOMIC_RELAXED, __HIP_MEMORY_SCOPE_AGENT); }
                    dead = true; break; }
                __builtin_amdgcn_s_sleep(2);
            }
            __builtin_amdgcn_fence(__ATOMIC_ACQUIRE, "agent");
            if (lane == 0) flag[0] = dead ? 1u : 0u;
        }
        asm volatile("s_waitcnt vmcnt(0) lgkmcnt(0)" ::: "memory"); __builtin_amdgcn_s_barrier(); asm volatile("" ::: "memory");
        const bool bad = flag[0] != 0u;
        if (lane < 32) {
            const unsigned long long* slot = (const unsigned long long*)xbuf + (size_t)(u.pm * BM + row) * 4; float mt[4], m2[4]; float ms = 0.f;
#pragma unroll
            for (int t = 0; t < 4; ++t) { if (t < ntn) { const unsigned long long w = __hip_atomic_load(slot + t, __ATOMIC_RELAXED, __HIP_MEMORY_SCOPE_AGENT); mt[t] = __uint_as_float((unsigned)w); m2[t] = __uint_as_float((unsigned)(w >> 32)); } else { mt[t] = 0.f; m2[t] = 0.f; } ms += mt[t]; }
            const float mean = ms / (float)ntn; float q = 0.f;
#pragma unroll
            for (int t = 0; t < 4; ++t) if (t < ntn) { const float dm = mt[t] - mean; q += m2[t] + 256.0f * dm * dm; }
            S[row] = (f32x2v){mean, 1.0f / sqrtf(q / (256.0f * (float)ntn) + mean * mean + eps)};
        }
        asm volatile("s_waitcnt lgkmcnt(0)" ::: "memory"); __builtin_amdgcn_s_barrier(); asm volatile("" ::: "memory");
        return bad;
    }
};

struct EpiRmsRes {
    static constexpr bool PERM = false, AFTER_DRAIN = true;
    const float* base; float* out; bf16_t* xn; int ldc; const float* gate; const float* gA; const float* gB; const float* sh; const float* sc; PanelStats st1, st2;
    __device__ __forceinline__ void fused(f32x4 (&acc)[2][2][4][2], const Unit& u, int wr, int wc, int fr, int fq, PG8_LAS unsigned char* lds, int wid, int lane) const {
        typedef float f32x2v __attribute__((ext_vector_type(2))); typedef unsigned u32x2v __attribute__((ext_vector_type(2)));
        const PG8_LAS f32x2v* S = (const PG8_LAS f32x2v*)(lds + 8192);
        const int col0 = u.pn * BM + wc * 32 + 4 * fq;
        f32x4 pre[4][2][2];
#pragma unroll
        for (int m = 0; m < 4; ++m) { const size_t off = (size_t)(u.pm * BM + wr * 64 + m * 16 + fr) * ldc + col0;
#pragma unroll
            for (int bj = 0; bj < 2; ++bj)
#pragma unroll
                for (int n = 0; n < 2; ++n) pre[m][bj][n] = *(const f32x4*)(base + off + bj * HALF + n * 16); }
        bool bad = st1.run(acc, u, wr, wc, fr, fq, lds, wid, lane);
        const float qnan = __builtin_nanf("");
#pragma unroll
        for (int ai = 0; ai < 2; ++ai)
#pragma unroll
            for (int m = 0; m < 4; ++m) { const int r = ai * HALF + wr * 64 + m * 16 + fr; const f32x2v sr = S[r]; const size_t off = (size_t)(u.pm * BM + r) * ldc + col0;
#pragma unroll
                for (int bj = 0; bj < 2; ++bj)
#pragma unroll
                    for (int n = 0; n < 2; ++n) { const int c = col0 + bj * HALF + n * 16; const f32x4 bs = ai == 0 ? pre[m][bj][n] : *(const f32x4*)(base + off + bj * HALF + n * 16);
                        const f32x4 gt = *(const f32x4*)(gate + c), ga = *(const f32x4*)(gA + c);
                        acc[ai][bj][m][n] = bs + gt * (acc[ai][bj][m][n] * sr.y * ga); }
                asm volatile("" : "+v"(acc[ai][0][m][0]), "+v"(acc[ai][0][m][1]), "+v"(acc[ai][1][m][0]), "+v"(acc[ai][1][m][1]));
                if (m & 1) asm volatile("" ::: "memory"); }
        const bool bad1 = bad;
        if (xn) bad = st2.run(acc, u, wr, wc, fr, fq, lds, wid, lane) || bad;
#pragma unroll
        for (int ai = 0; ai < 2; ++ai)
#pragma unroll
            for (int m = 0; m < 4; ++m) { const int r = ai * HALF + wr * 64 + m * 16 + fr; const f32x2v sr = S[r]; const size_t off = (size_t)(u.pm * BM + r) * ldc + col0;
#pragma unroll
                for (int bj = 0; bj < 2; ++bj)
#pragma unroll
                    for (int n = 0; n < 2; ++n) { const int c = col0 + bj * HALF + n * 16; const f32x4 x1 = acc[ai][bj][m][n];
                        *(f32x4*)(out + off + bj * HALF + n * 16) = bad1 ? (f32x4){qnan, qnan, qnan, qnan} : x1;
                        if (xn) { const f32x4 gb = *(const f32x4*)(gB + c), s1 = *(const f32x4*)(sc + c), s0 = *(const f32x4*)(sh + c);
                            const f32x4 o = (x1 * sr.y * gb) * (s1 + 1.0f) + s0; u32x2v w; w.x = cvt_pk_bf16(o[0], o[1]); w.y = cvt_pk_bf16(o[2], o[3]);
                            if (bad) { w.x = 0x7fc07fc0u; w.y = 0x7fc07fc0u; } *(u32x2v*)(xn + off + bj * HALF + n * 16) = w; } }
                asm volatile("" ::: "memory"); }
    }
};

template <class Epi, class Sched, bool ALIGN_EPI = false, bool SP2 = false>
__device__ __forceinline__ void gemm_phase(PG8_LAS unsigned char* lds, const Gemm g, const Sched& S, const Epi& E) {
    int tid_ = threadIdx.x; asm volatile("" : "+v"(tid_)); const int tid = tid_, wid = __builtin_amdgcn_readfirstlane(tid >> 6), lane = tid & 63, wr = wid >> 2, wc = wid & 3, fr = lane & 15, fq = lane >> 4;
    const int K = g.K, nt = K / BK;
    unsigned voffA[2], voffB[2];
#pragma unroll
    for (int i = 0; i < 2; ++i) { int R, C; stage_rc(tid * 16 + i * 8192, R, C); const int Rb = Epi::PERM ? ((R & ~31) + perm32(R & 31)) : R;
        voffA[i] = (unsigned)(R * K + C) * 2u; voffB[i] = (unsigned)(Rb * K + C) * 2u; }
    const size_t kstep = (size_t)(BK * 2);
    const size_t hstep = (size_t)HALF * K * 2;
    const size_t tstep = 2 * hstep;
    const unsigned ldsw = (unsigned)wid * 1024u;
    const int aoff = lds_byte(wr * 64 + fr, fq * 8), boff = lds_byte(wc * 32 + fr, fq * 8);
#define PG8_SA(b, h) (((b) * 2 + (h)) * HTB)
#define PG8_SB(b, h) ((4 + (b) * 2 + (h)) * HTB)
#define PG8_STAGE(bufoff, gbase, voff) do { _Pragma("unroll") for (int _i = 0; _i < 2; ++_i) \
        __builtin_amdgcn_global_load_lds((const unsigned*)((const char*)(gbase) + (voff)[_i]), (PG8_LAS unsigned*)(lds + (bufoff) + ldsw + _i * 8192), 16, 0, 0); } while (0)
#define PG8_LDA(dst, b, h) do { _Pragma("unroll") for (int m = 0; m < 4; ++m) _Pragma("unroll") for (int k = 0; k < 2; ++k) dst[m][k] = *(const PG8_LAS bf16x8*)(lds + PG8_SA(b, h) + aoff + m * 2048 + k * 1024); } while (0)
#define PG8_LDB(dst, b, h) do { _Pragma("unroll") for (int n = 0; n < 2; ++n) _Pragma("unroll") for (int k = 0; k < 2; ++k) dst[n][k] = *(const PG8_LAS bf16x8*)(lds + PG8_SB(b, h) + boff + n * 2048 + k * 1024); } while (0)
#define PG8_MMA(ai, bj, At, Bt) do { __builtin_amdgcn_s_setprio(1); _Pragma("unroll") for (int m = 0; m < 4; ++m) _Pragma("unroll") for (int n = 0; n < 2; ++n) _Pragma("unroll") for (int k = 0; k < 2; ++k) \
        acc[ai][bj][m][n] = __builtin_amdgcn_mfma_f32_16x16x32_bf16(Bt[n][k], At[m][k], acc[ai][bj][m][n], 0, 0, 0); __builtin_amdgcn_s_setprio(0); } while (0)
#define PG8_WAIT_V(n) asm volatile("s_waitcnt vmcnt(" #n ")" ::: "memory")
#define PG8_WAIT_L(n) asm volatile("s_waitcnt lgkmcnt(" #n ")" ::: "memory")
#define PG8_BAR __builtin_amdgcn_s_barrier()
#define PG8_SCHED __builtin_amdgcn_sched_barrier(0)
    Unit cur, nxt; int ui = 0;
    if (!S.next(0, cur)) return;
    f32x4 acc[2][2][4][2];
#pragma unroll
    for (int a = 0; a < 2; ++a)
#pragma unroll
        for (int b = 0; b < 2; ++b)
#pragma unroll
            for (int m = 0; m < 4; ++m)
#pragma unroll
                for (int n = 0; n < 2; ++n) acc[a][b][m][n] = (f32x4){0.f, 0.f, 0.f, 0.f};
    bf16x8 At[4][2], B0[2][2], B1[2][2];
    const char* cA = (const char*)g.A + (size_t)cur.pm * tstep; const char* cB = (const char*)g.Bt + (size_t)cur.pn * tstep;
    S.a_ready(cur);
    if constexpr (SP2) {
        PG8_STAGE(PG8_SB(0, 0), cB, voffB); PG8_STAGE(PG8_SB(0, 1), cB + hstep, voffB); PG8_STAGE(PG8_SA(0, 0), cA, voffA); PG8_STAGE(PG8_SA(0, 1), cA + hstep, voffA);
        if (wr == 1) PG8_BAR;
        PG8_WAIT_V(2); PG8_BAR;
        PG8_STAGE(PG8_SB(1, 0), cB + kstep, voffB); PG8_STAGE(PG8_SA(1, 0), cA + kstep, voffA); PG8_STAGE(PG8_SB(1, 1), cB + hstep + kstep, voffB);
        PG8_WAIT_V(6); PG8_BAR;
    } else {
        PG8_STAGE(PG8_SB(0, 0), cB, voffB); PG8_STAGE(PG8_SA(0, 0), cA, voffA); PG8_STAGE(PG8_SB(0, 1), cB + hstep, voffB); PG8_STAGE(PG8_SA(0, 1), cA + hstep, voffA);
        if (wr == 1) PG8_BAR;
        PG8_WAIT_V(4); PG8_BAR;
        PG8_STAGE(PG8_SB(1, 0), cB + kstep, voffB); PG8_STAGE(PG8_SA(1, 0), cA + kstep, voffA); PG8_STAGE(PG8_SB(1, 1), cB + hstep + kstep, voffB);
        PG8_WAIT_V(6); PG8_BAR;
    }
    for (;;) {
        const bool has_next = S.next(ui + 1, nxt);
        const char* nA = has_next ? (const char*)g.A + (size_t)nxt.pm * tstep : cA; const char* nB = has_next ? (const char*)g.Bt + (size_t)nxt.pn * tstep : cB;
        for (int t = 0; t < nt; t += 2) {
            const bool last = (t == nt - 2);
            const char* a1 = cA + (size_t)(t + 1) * kstep;
            const char* a2 = last ? nA : cA + (size_t)(t + 2) * kstep; const char* b2 = last ? nB : cB + (size_t)(t + 2) * kstep;
            const char* a3 = a2 + kstep; const char* b3 = b2 + kstep;
            if (last && has_next) S.a_ready(nxt);
            if constexpr (SP2) {
            PG8_LDB(B0, 0, 0); PG8_LDB(B1, 0, 1); PG8_SCHED; PG8_LDA(At, 0, 0); PG8_STAGE(PG8_SA(1, 1), a1 + hstep, voffA);
            PG8_WAIT_V(8); PG8_WAIT_L(0); PG8_BAR; PG8_MMA(0, 0, At, B0); PG8_MMA(0, 1, At, B1); PG8_BAR; PG8_SCHED;
            PG8_LDA(At, 0, 1); PG8_STAGE(PG8_SB(0, 0), b2, voffB); PG8_STAGE(PG8_SB(0, 1), b2 + hstep, voffB); PG8_STAGE(PG8_SA(0, 0), a2, voffA);
            PG8_WAIT_V(8); PG8_WAIT_L(0); PG8_BAR; PG8_MMA(1, 0, At, B0); PG8_MMA(1, 1, At, B1); PG8_BAR; PG8_SCHED;
            PG8_LDB(B0, 1, 0); PG8_LDB(B1, 1, 1); PG8_SCHED; PG8_LDA(At, 1, 0); PG8_STAGE(PG8_SA(0, 1), a2 + hstep, voffA);
            PG8_WAIT_V(8); PG8_WAIT_L(0); PG8_BAR; PG8_MMA(0, 0, At, B0); PG8_MMA(0, 1, At, B1); PG8_BAR; PG8_SCHED;
            PG8_LDA(At, 1, 1); PG8_STAGE(PG8_SB(1, 0), b3, voffB); PG8_STAGE(PG8_SB(1, 1), b3 + hstep, voffB); PG8_STAGE(PG8_SA(1, 0), a3, voffA);
            PG8_WAIT_V(8); PG8_WAIT_L(0); PG8_BAR; PG8_MMA(1, 0, At, B0); PG8_MMA(1, 1, At, B1); PG8_BAR; PG8_SCHED;
            } else {
            PG8_LDB(B0, 0, 0); PG8_SCHED; PG8_LDA(At, 0, 0); PG8_STAGE(PG8_SA(1, 1), a1 + hstep, voffA);
            PG8_WAIT_L(8); PG8_BAR; PG8_WAIT_L(0); PG8_MMA(0, 0, At, B0); PG8_BAR; PG8_SCHED;
            PG8_LDB(B1, 0, 1); PG8_STAGE(PG8_SB(0, 0), b2, voffB);
            PG8_BAR; PG8_WAIT_L(0); PG8_MMA(0, 1, At, B1); PG8_BAR;
            PG8_LDA(At, 0, 1); PG8_STAGE(PG8_SA(0, 0), a2, voffA);
            PG8_BAR; PG8_WAIT_L(0); PG8_MMA(1, 0, At, B0); PG8_BAR; PG8_SCHED;
            PG8_STAGE(PG8_SB(0, 1), b2 + hstep, voffB);
            PG8_WAIT_V(6); PG8_BAR; PG8_MMA(1, 1, At, B1); PG8_BAR;
            PG8_LDB(B0, 1, 0); PG8_SCHED; PG8_LDA(At, 1, 0); PG8_STAGE(PG8_SA(0, 1), a2 + hstep, voffA);
            PG8_WAIT_L(8); PG8_BAR; PG8_WAIT_L(0); PG8_MMA(0, 0, At, B0); PG8_BAR; PG8_SCHED;
            PG8_LDB(B1, 1, 1); PG8_STAGE(PG8_SB(1, 0), b3, voffB);
            PG8_BAR; PG8_WAIT_L(0); PG8_MMA(0, 1, At, B1); PG8_BAR;
            PG8_LDA(At, 1, 1); PG8_STAGE(PG8_SA(1, 0), a3, voffA);
            PG8_BAR; PG8_WAIT_L(0); PG8_MMA(1, 0, At, B0); PG8_BAR; PG8_SCHED;
            PG8_STAGE(PG8_SB(1, 1), b3 + hstep, voffB);
            PG8_WAIT_V(6); PG8_BAR; PG8_MMA(1, 1, At, B1); PG8_BAR;
            }
        }
        if constexpr (ALIGN_EPI) { if (wr == 0) PG8_BAR; }
        if constexpr (!Epi::AFTER_DRAIN) { E(acc, cur, wr, wc, fr, fq); S.done(cur); }
        if (!has_next) break;
#pragma unroll
        for (int a = 0; a < 2; ++a)
#pragma unroll
            for (int b = 0; b < 2; ++b)
#pragma unroll
                for (int m = 0; m < 4; ++m)
#pragma unroll
                    for (int n = 0; n < 2; ++n) acc[a][b][m][n] = (f32x4){0.f, 0.f, 0.f, 0.f};
        cur = nxt; cA = nA; cB = nB; ++ui;
        if constexpr (ALIGN_EPI) { if (wr == 1) PG8_BAR; }
    }
    PG8_WAIT_V(0);
    if constexpr (!ALIGN_EPI) { if (wr == 0) PG8_BAR; }
    PG8_BAR;
    if constexpr (Epi::AFTER_DRAIN) { E.fused(acc, cur, wr, wc, fr, fq, lds, wid, lane); S.done(cur); }
#undef PG8_SA
#undef PG8_SB
#undef PG8_STAGE
#undef PG8_LDA
#undef PG8_LDB
#undef PG8_MMA
#undef PG8_WAIT_V
#undef PG8_WAIT_L
#undef PG8_BAR
#undef PG8_SCHED
}
}
#include <hip/hip_bf16.h>
#include <cmath>
namespace attn_body {
using bf16=__hip_bfloat16;
using bf16x8=__attribute__((ext_vector_type(8)))short;
using s16x4=__attribute__((ext_vector_type(4)))short;
using f32x16=__attribute__((ext_vector_type(16)))float;
using u32x4=__attribute__((ext_vector_type(4)))unsigned;
constexpr int BATCH=1,NHEAD=16,SEQ=16384,D=64,DM=NHEAD*D,KVP=256,NKT=260;
constexpr int NW=8,QBLK=32,QB=QBLK*NW,KVBLK=64,NQB=SEQ/QB;
constexpr int ATTN_PITCH=DM, ATTN_UNIT_ROWS=QB;
__device__ __forceinline__ int crow(int r,int hi){return (r&3)+8*(r>>2)+4*hi;}
#define SBAR() __builtin_amdgcn_sched_barrier(0)
__device__ __forceinline__ void cmask(f32x16&p0,f32x16&p1,int jb,int qrel,int hi){
  const float NEG=-INFINITY; int kb=64*jb+4*hi;
  #pragma unroll
  for(int r=0;r<16;++r){int kv=kb+(r&3)+8*(r>>2); if(kv>qrel)p0[r]=NEG; if(kv+32>qrel)p1[r]=NEG;}
}

constexpr int NSLOT=3, SLOTB=8192;
constexpr int LDS_K=0, LDS_V=NSLOT*SLOTB, LDS_WS=2*NSLOT*SLOTB, LDS_OST=LDS_WS+NW*64*4, LDS_BYTES=LDS_OST+NW*4096;
constexpr float C2=0.125f*1.4426950408889634f;
__device__ __forceinline__ void glds16(const void*gsrc,unsigned lds_dst){unsigned keep;
  asm volatile("s_mov_b32 %0, m0\n\ts_mov_b32 m0, %2\n\ts_nop 0\n\tglobal_load_lds_dwordx4 %1, off\n\ts_mov_b32 m0, %0":"=&s"(keep):"v"(gsrc),"s"(lds_dst):"memory");}
__device__ __forceinline__ float max3f(float a,float b,float c){float r;asm("v_max3_f32 %0, %1, %2, %3":"=v"(r):"v"(a),"v"(b),"v"(c));return r;}
__device__ __forceinline__ float max2f(float a,float b){float r;asm("v_max_f32_e32 %0, %1, %2":"=v"(r):"v"(a),"v"(b));return r;}
__device__ __forceinline__ float fadd_s(float a,float b){float r;asm("v_add_f32_e32 %0, %1, %2":"=v"(r):"v"(a),"v"(b));return r;}
__device__ __forceinline__ float fsub_s(float a,float b){float r;asm("v_sub_f32_e32 %0, %1, %2":"=v"(r):"v"(a),"v"(b));return r;}
typedef float f32x2_t __attribute__((ext_vector_type(2))); typedef __bf16 bf16x2_t __attribute__((ext_vector_type(2)));
__device__ __forceinline__ unsigned cvtpk_s(float lo,float hi){f32x2_t v={lo,hi};bf16x2_t b=__builtin_convertvector(v,bf16x2_t);return __builtin_bit_cast(unsigned,b);}
#define WAIT_BAR(N) asm volatile("s_waitcnt vmcnt(" #N ") lgkmcnt(0)\n\ts_barrier":::"memory")

__device__ __forceinline__ void qkt(f32x16&p0,f32x16&p1,const char*Kslot,const bf16x8*qr,const f32x16&negm,int r32,int hi){
  const char*kb=Kslot+hi*1024+r32*16;
  #pragma unroll
  for(int d0=0;d0<4;++d0){
    const bf16x8 b0=*reinterpret_cast<const bf16x8*>(kb+d0*2048);
    const bf16x8 b1=*reinterpret_cast<const bf16x8*>(kb+d0*2048+512);
    if(d0==0){p0=__builtin_amdgcn_mfma_f32_32x32x16_bf16(b0,qr[0],negm,0,0,0);p1=__builtin_amdgcn_mfma_f32_32x32x16_bf16(b1,qr[0],negm,0,0,0);}
    else{p0=__builtin_amdgcn_mfma_f32_32x32x16_bf16(b0,qr[d0],p0,0,0,0);p1=__builtin_amdgcn_mfma_f32_32x32x16_bf16(b1,qr[d0],p1,0,0,0);}}
}
typedef __attribute__((address_space(3))) const char* lds_cptr;
typedef short v4i16_t __attribute__((ext_vector_type(4)));
__device__ __forceinline__ void kload8(bf16x8*kf,lds_cptr kp){
  kf[0]=*(const __attribute__((address_space(3))) bf16x8*)(kp);      kf[1]=*(const __attribute__((address_space(3))) bf16x8*)(kp+512);
  kf[2]=*(const __attribute__((address_space(3))) bf16x8*)(kp+2048); kf[3]=*(const __attribute__((address_space(3))) bf16x8*)(kp+2560);
  kf[4]=*(const __attribute__((address_space(3))) bf16x8*)(kp+4096); kf[5]=*(const __attribute__((address_space(3))) bf16x8*)(kp+4608);
  kf[6]=*(const __attribute__((address_space(3))) bf16x8*)(kp+6144); kf[7]=*(const __attribute__((address_space(3))) bf16x8*)(kp+6656);
}
__device__ __forceinline__ void kload2(bf16x8*kf,lds_cptr kp,int j){ kf[2*j]=*(const __attribute__((address_space(3))) bf16x8*)(kp+j*2048); kf[2*j+1]=*(const __attribute__((address_space(3))) bf16x8*)(kp+j*2048+512); }
__device__ __forceinline__ s16x4 vtr(lds_cptr p){ return __builtin_bit_cast(s16x4,__builtin_amdgcn_ds_read_tr16_b64_v4i16((__attribute__((address_space(3))) v4i16_t*)p)); }
__device__ __forceinline__ float rowmax(const f32x16&p0,const f32x16&p1){
  float a=max3f(p0[0],p0[1],p1[0]),b=max3f(p0[2],p0[3],p1[1]);a=max3f(a,p1[2],p1[3]);
  #pragma unroll
  for(int r=4;r<16;r+=4){a=max3f(a,p0[r],p0[r+1]);b=max3f(b,p0[r+2],p0[r+3]);a=max3f(a,p1[r],p1[r+1]);b=max3f(b,p1[r+2],p1[r+3]);}
  const float m=max2f(a,b);
  auto rr=__builtin_amdgcn_permlane32_swap(__float_as_uint(m),__float_as_uint(m),false,false);
  return max2f(__uint_as_float(rr[0]),__uint_as_float(rr[1]));
}
__device__ __forceinline__ void pv(f32x16*o,int vb,bf16x8 pa0,bf16x8 pa1,bf16x8 pa2,bf16x8 pa3){
  #pragma unroll
  for(int d0=0;d0<2;++d0){s16x4 lo[4],hi[4];
    #pragma unroll
    for(int ks=0;ks<4;++ks){
      asm volatile("ds_read_b64_tr_b16 %0,%1 offset:%c2":"=&v"(lo[ks]):"v"(vb),"i"(d0*4096+ks*1024):"memory");
      asm volatile("ds_read_b64_tr_b16 %0,%1 offset:%c2":"=&v"(hi[ks]):"v"(vb),"i"(d0*4096+ks*1024+512):"memory");}
    asm volatile("s_waitcnt lgkmcnt(0)":::"memory");SBAR();
    #define PK(k) (bf16x8){lo[k][0],lo[k][1],lo[k][2],lo[k][3],hi[k][0],hi[k][1],hi[k][2],hi[k][3]}
    o[d0]=__builtin_amdgcn_mfma_f32_32x32x16_bf16(pa0,PK(0),o[d0],0,0,0);
    o[d0]=__builtin_amdgcn_mfma_f32_32x32x16_bf16(pa1,PK(1),o[d0],0,0,0);
    o[d0]=__builtin_amdgcn_mfma_f32_32x32x16_bf16(pa2,PK(2),o[d0],0,0,0);
    o[d0]=__builtin_amdgcn_mfma_f32_32x32x16_bf16(pa3,PK(3),o[d0],0,0,0);
    #undef PK
  }
}

#ifndef ATTN_STORE16
#define ATTN_STORE16(p,v) (*(u32x4*)(p)=(v))
#endif
template<int THRL> __device__ __forceinline__ void attn_unit(int b,int h,int qb,const bf16*Q,const bf16*__restrict__ K,const bf16*__restrict__ V,bf16*O,char*shm){
  int tid_=threadIdx.x; asm volatile("":"+v"(tid_)); const int tid=tid_,lane=tid&63,r32=lane&31,hi=lane>>5; const int wid=__builtin_amdgcn_readfirstlane(tid>>6);
  const long rowbase=(long)b*SEQ; const int q0=qb*QB;
  const bf16*Qw=Q+(rowbase+q0+wid*QBLK)*DM+h*D;
  const bf16*Kh=K+(h>>2)*D,*Vh=V+(h>>2)*D;
  const unsigned lds0=(unsigned)(uintptr_t)shm;
  float*wsf=(float*)(shm+LDS_WS)+wid*64;
  const bf16*ksrc=Kh+(long)lane*KVP+wid*8;
  const bf16*vsrc=Vh+(long)(16*(wid&3)+(lane>>2))*KVP+(wid>>2)*32+(lane&3)*8;
  const unsigned kdst=lds0+LDS_K+wid*1024, vdst=lds0+LDS_V+wid*1024;
  #define DMA_K(t,slot) glds16(ksrc+(long)(t)*KVBLK*KVP,(unsigned)__builtin_amdgcn_readfirstlane(kdst+(slot)))
  #define DMA_V(t,slot) glds16(vsrc+(long)(t)*KVBLK*KVP,(unsigned)__builtin_amdgcn_readfirstlane(vdst+(slot)))
  const int vb0=(int)(lds0+LDS_V)+((lane>>4)&1)*32+(lane&3)*8+(4*hi+((lane&15)>>2))*64;
  const char*Kbase=shm+LDS_K; bf16x8 kf[8];
  const lds_cptr shm3=(lds_cptr)shm; const lds_cptr kp0=shm3+LDS_K+hi*1024+r32*16; const lds_cptr vp0=shm3+LDS_V+((lane>>4)&1)*32+(lane&3)*8+(4*hi+((lane&15)>>2))*64;
  const int NT=NKT;
  DMA_K(0,0);DMA_V(0,0);DMA_K(1,SLOTB);
  bf16x8 qr[4];
  #pragma unroll
  for(int d0=0;d0<4;++d0)qr[d0]=*reinterpret_cast<const bf16x8*>(&Qw[(long)r32*DM+d0*16+hi*8]);
  float mhat=0.f,l_reg=0.f;f32x16 o[2];o[0]=f32x16{};o[1]=f32x16{};f32x16 negm=f32x16{};asm volatile("":"+v"(negm));
  const int qrel=wid*QBLK+r32;
  #define CMASK(P0,P1,t) do{}while(0)
  bool resc=false;
  #define START(P0,P1) do{ const float rm=rowmax(P0,P1); resc=false; \
    { const float dl=rm; mhat=fadd_s(mhat,dl); \
      _Pragma("unroll") for(int r=0;r<16;++r){P0[r]=fsub_s(P0[r],dl);P1[r]=fsub_s(P1[r],dl);} \
      _Pragma("unroll") for(int r=0;r<16;++r)negm[r]=-mhat; asm volatile("":"+v"(negm)); } \
    _Pragma("unroll") for(int r=0;r<16;++r)P0[r]=__builtin_amdgcn_exp2f(P0[r]); }while(0)
  #define RESC() do{ if(resc){ asm volatile("s_waitcnt lgkmcnt(0)":::"memory"); \
      _Pragma("unroll") for(int d_=0;d_<2;++d_) _Pragma("unroll") for(int r=0;r<16;++r)o[d_][r]*=wsf[crow(r,hi)]; } }while(0)
  f32x16 pA0,pA1,pB0,pB1;
  int sl_prev=0,sl_cur=0,sl_next=SLOTB;
  #define ROT() do{sl_prev=sl_cur;sl_cur=sl_next;sl_next=(sl_next==(NSLOT-1)*SLOTB)?0:sl_next+SLOTB;}while(0)
  DMA_K(2,2*SLOTB);
  WAIT_BAR(3);
  qkt(pA0,pA1,Kbase,qr,negm,r32,hi);asm volatile("s_nop 15\n\ts_nop 7":"+v"(pA0),"+v"(pA1));CMASK(pA0,pA1,0);
  START(pA0,pA1);
  _Pragma("unroll") for(int r=0;r<16;++r)pA1[r]=__builtin_amdgcn_exp2f(pA1[r]);
  WAIT_BAR(0);
  DMA_K(3,0);DMA_V(1,SLOTB);
  ROT();
  kload8(kf,kp0+sl_cur);
  WAIT_BAR(2);
  s16x4 vlo[8],vhi[8]; u32x4 pw0,pw1,pw2,pw3;
  #define PKW(P,B) cvtpk_s(P[B],P[B+1])
  #define PAF(k) __builtin_bit_cast(bf16x8,pw##k)
  #define VFR(i) (bf16x8){vlo[i][0],vlo[i][1],vlo[i][2],vlo[i][3],vhi[i][0],vhi[i][1],vhi[i][2],vhi[i][3]}
  #define PIN(x) asm volatile("":"+v"(x))
  #define MX3(a,b,c) __builtin_fmaxf(__builtin_fmaxf((a),(b)),(c))
  #define GAPA(MF,A0,A1,A2,A3,W0,W1,PW) do{ MF; sacc+=A0; sacc+=A1; sacc+=A2; sacc+=A3; PIN(sacc); W0; W1; PIN(PW); SBAR(); }while(0)
  #define EX(v) __builtin_amdgcn_exp2f(v)
  #define GAPB(MF,X,B) do{ MF; X[B]=EX(X[B]); X[B+1]=EX(X[B+1]); X[B+2]=EX(X[B+2]); X[B+3]=EX(X[B+3]); PIN(X); SBAR(); }while(0)
  #define VRD(i) do{ vlo[i]=vtr(vp_+(((i)>>2)*4096+((i)&3)*1024)); vhi[i]=vtr(vp_+(((i)>>2)*4096+((i)&3)*1024+512)); }while(0)
  #define KRD(G,j) do{ if(G){ kload2(kf,kp0+sl_next,j); SBAR(); } }while(0)
  #define STEP(C0,C1,P0,P1,t,GK,GV,GL) do{ SBAR(); \
    const lds_cptr vp_=vp0+sl_prev; \
    VRD(0); SBAR(); float sacc=(P0[0]+P0[1]); \
    GAPA(C0=__builtin_amdgcn_mfma_f32_32x32x16_bf16(kf[0],qr[0],negm,0,0,0), P0[2],P0[3],P0[4],P0[5],     pw0[0]=PKW(P0,0), pw0[1]=PKW(P0,2), pw0); \
    VRD(4); SBAR(); GAPA(C1=__builtin_amdgcn_mfma_f32_32x32x16_bf16(kf[1],qr[0],negm,0,0,0), P0[6],P0[7],P0[8],P0[9],     pw0[2]=PKW(P0,4), pw0[3]=PKW(P0,6), pw0); \
    VRD(1); SBAR(); GAPA(C0=__builtin_amdgcn_mfma_f32_32x32x16_bf16(kf[2],qr[1],C0,0,0,0),   P0[10],P0[11],P0[12],P0[13], pw1[0]=PKW(P0,8), pw1[1]=PKW(P0,10), pw1); \
    VRD(5); SBAR(); GAPA(C1=__builtin_amdgcn_mfma_f32_32x32x16_bf16(kf[3],qr[1],C1,0,0,0),   P0[14],P0[15],P1[0],P1[1],   pw1[2]=PKW(P0,12),pw1[3]=PKW(P0,14), pw1); \
    VRD(2); SBAR(); GAPA(C0=__builtin_amdgcn_mfma_f32_32x32x16_bf16(kf[4],qr[2],C0,0,0,0),   P1[2],P1[3],P1[4],P1[5],     pw2[0]=PKW(P1,0), pw2[1]=PKW(P1,2), pw2); \
    VRD(6); SBAR(); GAPA(C1=__builtin_amdgcn_mfma_f32_32x32x16_bf16(kf[5],qr[2],C1,0,0,0),   P1[6],P1[7],P1[8],P1[9],     pw2[2]=PKW(P1,4), pw2[3]=PKW(P1,6), pw2); \
    VRD(3); SBAR(); GAPA(C0=__builtin_amdgcn_mfma_f32_32x32x16_bf16(kf[6],qr[3],C0,0,0,0),   P1[10],P1[11],P1[12],P1[13], pw3[0]=PKW(P1,8), pw3[1]=PKW(P1,10), pw3); \
    VRD(7); SBAR(); GAPA(C1=__builtin_amdgcn_mfma_f32_32x32x16_bf16(kf[7],qr[3],C1,0,0,0),   P1[14],P1[15],0.f,0.f,       pw3[2]=PKW(P1,12),pw3[3]=PKW(P1,14), pw3); \
    l_reg+=sacc; \
    if(GK){DMA_K((t)+3,sl_cur);} if(GV){DMA_V((t)+1,sl_next);} \
    CMASK(C0,C1,t); \
    { float a=MX3(C0[0],C0[1],C1[0]),b=MX3(C0[2],C0[3],C1[1]); a=MX3(a,C1[2],C1[3]); \
      _Pragma("unroll") for(int r=4;r<16;r+=4){a=MX3(a,C0[r],C0[r+1]);b=MX3(b,C0[r+2],C0[r+3]);a=MX3(a,C1[r],C1[r+1]);b=MX3(b,C1[r+2],C1[r+3]);} \
      float rm=__builtin_fmaxf(a,b); { auto rr=__builtin_amdgcn_permlane32_swap(__float_as_uint(rm),__float_as_uint(rm),false,false); rm=__builtin_fmaxf(__uint_as_float(rr[0]),__uint_as_float(rr[1])); } \
      resc=false; \
      if(__builtin_expect(__any(rm>(float)THRL),0)){ const float dl=__builtin_fmaxf(rm,0.f); mhat+=dl; \
        _Pragma("unroll") for(int r=0;r<16;++r){C0[r]-=dl;C1[r]-=dl;} \
        _Pragma("unroll") for(int r=0;r<16;++r)negm[r]=-mhat; asm volatile("":"+v"(negm)); \
        const float f=__builtin_amdgcn_exp2f(-dl); l_reg*=f; if(hi==0)wsf[r32]=f; resc=true; } } \
    SBAR(); \
    GAPB(o[0]=__builtin_amdgcn_mfma_f32_32x32x16_bf16(PAF(0),VFR(0),o[0],0,0,0), C0,0); \
    GAPB(o[1]=__builtin_amdgcn_mfma_f32_32x32x16_bf16(PAF(0),VFR(4),o[1],0,0,0), C0,4); \
    KRD(GL,0); GAPB(o[0]=__builtin_amdgcn_mfma_f32_32x32x16_bf16(PAF(1),VFR(1),o[0],0,0,0), C0,8); \
    KRD(GL,1); GAPB(o[1]=__builtin_amdgcn_mfma_f32_32x32x16_bf16(PAF(1),VFR(5),o[1],0,0,0), C0,12); \
    KRD(GL,2); GAPB(o[0]=__builtin_amdgcn_mfma_f32_32x32x16_bf16(PAF(2),VFR(2),o[0],0,0,0), C1,0); \
    KRD(GL,3); GAPB(o[1]=__builtin_amdgcn_mfma_f32_32x32x16_bf16(PAF(2),VFR(6),o[1],0,0,0), C1,4); \
    GAPB(o[0]=__builtin_amdgcn_mfma_f32_32x32x16_bf16(PAF(3),VFR(3),o[0],0,0,0), C1,8); \
    GAPB(o[1]=__builtin_amdgcn_mfma_f32_32x32x16_bf16(PAF(3),VFR(7),o[1],0,0,0), C1,12); \
    }while(0)
  int t=1;
  #undef CMASK
  #define CMASK(P0,P1,t) do{}while(0)
  asm volatile(".p2align 6\n\t.rept 8\n\ts_nop 0\n\t.endr":::"memory");
  for(;t+5<NT;t+=2){
    STEP(pB0,pB1,pA0,pA1,t,true,true,true);     WAIT_BAR(2); RESC(); ROT();
    STEP(pA0,pA1,pB0,pB1,t+1,true,true,true);   WAIT_BAR(2); RESC(); ROT();
  }
  #undef CMASK
  #define CMASK(P0,P1,t) do{}while(0)
  #define ENDW(tt) do{ if((tt)+3<NT){WAIT_BAR(2);} else if((tt)+2<NT){WAIT_BAR(1);} else {WAIT_BAR(0);} }while(0)
  for(;t+1<NT;t+=2){
    STEP(pB0,pB1,pA0,pA1,t,(t+3<NT),(t+1<NT),(t+1<NT));       ENDW(t);   RESC(); ROT();
    STEP(pA0,pA1,pB0,pB1,t+1,(t+4<NT),(t+2<NT),(t+2<NT));     ENDW(t+1); RESC(); ROT();
  }
  STEP(pB0,pB1,pA0,pA1,NT-1,false,false,false); RESC();
  { float sacc=pB0[0]+pB0[1]; _Pragma("unroll") for(int r=2;r<16;++r)sacc+=pB0[r]; _Pragma("unroll") for(int r=0;r<16;++r)sacc+=pB1[r]; l_reg+=sacc;
    pw0=(u32x4){PKW(pB0,0),PKW(pB0,2),PKW(pB0,4),PKW(pB0,6)};pw1=(u32x4){PKW(pB0,8),PKW(pB0,10),PKW(pB0,12),PKW(pB0,14)};pw2=(u32x4){PKW(pB1,0),PKW(pB1,2),PKW(pB1,4),PKW(pB1,6)};pw3=(u32x4){PKW(pB1,8),PKW(pB1,10),PKW(pB1,12),PKW(pB1,14)};
    SBAR(); pv(o,vb0+sl_cur,PAF(0),PAF(1),PAF(2),PAF(3)); }
  #undef PKW
  #undef PAF
  #undef VFR
  #undef PIN
  #undef MX3
  #undef GAPA
  #undef GAPB
  #undef EX
  #undef VRD
  #undef KRD
  #undef STEP
  #undef ENDW
  {auto rr=__builtin_amdgcn_permlane32_swap(__float_as_uint(l_reg),__float_as_uint(l_reg),false,false);l_reg=__uint_as_float(rr[0])+__uint_as_float(rr[1]);}
  if(hi==0)wsf[32+r32]=l_reg;asm volatile("s_waitcnt lgkmcnt(0)":::"memory");
  float rli[16];
  #pragma unroll
  for(int r=0;r<16;++r)rli[r]=__builtin_amdgcn_rcpf(wsf[32+crow(r,hi)]);
  bf16*Ow=O+(rowbase+q0+wid*QBLK)*DM+h*D;
  { bf16*stg=(bf16*)(shm+LDS_OST)+wid*2048;
    #pragma unroll
    for(int r=0;r<16;++r){const int orow=crow(r,hi);
      #pragma unroll
      for(int d0=0;d0<2;++d0)stg[orow*64+d0*32+r32]=__float2bfloat16(o[d0][r]*rli[r]);}
    asm volatile("s_waitcnt lgkmcnt(0)":::"memory");
    #pragma unroll
    for(int i=0;i<4;++i){const int row=i*8+(lane>>3),ch=lane&7; const u32x4 v=*(const u32x4*)(stg+row*64+ch*8); ATTN_STORE16(Ow+(long)row*DM+ch*8,v);} }
  asm volatile("s_waitcnt lgkmcnt(0)\n\ts_barrier":::"memory");
  #undef DMA_K
  #undef DMA_V
  #undef CMASK
  #undef START
  #undef RESC
  #undef ROT
}
constexpr int ATTN_LDS_BYTES=LDS_BYTES;
struct AttnTensors { const bf16* Q; const bf16* K; const bf16* V; bf16* O; };
struct AttnUnit { int bh; int qb; };
struct StaticOrder {
  int vcu;
  __device__ __forceinline__ explicit StaticOrder(int grid,int block):vcu((grid%8==0)?(block%8)*(grid/8)+block/8:block){}
  __device__ __forceinline__ bool next(int i,AttnUnit&u)const{ if(i>=4)return false; const int x=vcu>>5, c=vcu&31; const int ul=(x&1)*128+c*4+i; u.bh=(x>>1)*4+(ul>>6); u.qb=ul&63; return true; }
  __device__ __forceinline__ void a_ready(const AttnUnit&)const{}
  __device__ __forceinline__ void done(const AttnUnit&)const{}
};
template<class Sched,int THRL=8> __device__ __forceinline__ void attn_phase(char*lds,const AttnTensors&T,const Sched&S){
  AttnUnit u;
  for(int i=0;S.next(i,u);++i){ S.a_ready(u); attn_unit<THRL>(u.bh/NHEAD,u.bh%NHEAD,u.qb,T.Q,T.K,T.V,T.O,lds); S.done(u); }
}
#undef SBAR
#undef WAIT_BAR
}
typedef unsigned short bf16;
typedef float f32x4 __attribute__((ext_vector_type(4)));
typedef float f32x2 __attribute__((ext_vector_type(2)));
typedef unsigned u32x4 __attribute__((ext_vector_type(4)));
typedef unsigned u32x2 __attribute__((ext_vector_type(2)));
#define LAS3 __attribute__((address_space(3)))

constexpr int T = 16640, NCTX = 256, NLAT = 16384, DM = 1024, FF = 4096, NQKV = 1536;
constexpr float EPS = 1e-6f;
constexpr size_t MiB = 1u << 20;
constexpr size_t WS_MOD = 0, WS_S5A = 128 * 1024, WS_S5BB = 256 * 1024, WS_ROPE = 768 * 1024;
constexpr size_t WS_WIN = 2 * MiB, WS_WGLU = 4 * MiB, WS_WOUT = 5 * MiB, WS_W1_0 = 7 * MiB, WS_W2_0 = 15 * MiB, WS_WQKV = 23 * MiB, WS_WAO = 26 * MiB, WS_W1_1 = 28 * MiB, WS_W2_1 = 36 * MiB;
constexpr size_t WS_XC = 44 * MiB, WS_H = 45 * MiB, WS_Y = 78 * MiB, WS_BIG = 111 * MiB;
constexpr size_t WS_U = WS_BIG, WS_G = 144 * MiB, WS_Z = 161 * MiB, WS_S5E = 194 * MiB, WS_S5H = 203 * MiB;
constexpr size_t WS_O = WS_BIG;
constexpr size_t WS_QKV = WS_BIG, WS_Q = 160 * MiB, WS_K = 193 * MiB, WS_V = 202 * MiB;
constexpr size_t WS_AP = 1 * MiB;
constexpr size_t WS_KS = 194 * MiB, WS_CA = 198 * MiB, WS_BA = 202 * MiB;
constexpr size_t OUT_E = 0, OUT_HIN = 40 * MiB;
constexpr int NC16 = 1040;
constexpr size_t WS_MODP = 243 * MiB;
constexpr size_t WS_CTL = 0x1C0000;
constexpr size_t WS_XB = 242 * MiB;
constexpr size_t WS_END = 246 * MiB;
constexpr int LDS_TOTAL = 143360 + 64;
constexpr size_t WS_BAR = 0x1F0000;
constexpr int NCH = 260;

struct Params { const float* in[26]; float* out; unsigned char* ws; };
typedef const __attribute__((address_space(4))) Params* KP;

__device__ __forceinline__ float wave_sum(float v) {
#pragma unroll
    for (int o = 1; o < 64; o <<= 1) v += __shfl_xor(v, o);
    return v;
}
__device__ __forceinline__ float siluf(float x) { return x / (1.f + __expf(-x)); }
__device__ __forceinline__ unsigned f2bf(float f) { unsigned u = __float_as_uint(f); return (u + 0x7fffu + ((u >> 16) & 1u)) >> 16; }
__device__ __forceinline__ unsigned pk2(float lo, float hi) { return f2bf(lo) | (f2bf(hi) << 16); }
__device__ __forceinline__ float bflo(unsigned w) { return __uint_as_float(w << 16); }
__device__ __forceinline__ float bfhi(unsigned w) { return __uint_as_float(w & 0xffff0000u); }
__device__ __forceinline__ float gelu_tanh(float x) { const float a = 0.7978845608028654f * (x + 0.044715f * x * x * x); const float th = 1.f - 2.f / (1.f + __expf(2.f * a)); return 0.5f * x * (1.f + th); }

__device__ __forceinline__ void tr_item(const float* W, int ldw, bf16* WT, int ldt, float* scr, int lane) {
#pragma unroll 16
    for (int i = 0; i < 32; ++i) { const int kk = 2 * i + (lane >> 5); scr[kk * 33 + (lane & 31)] = W[(size_t)kk * ldw + (lane & 31)]; }
    __builtin_amdgcn_wave_barrier();
    const int c = lane & 7;
#pragma unroll
    for (int j = 0; j < 4; ++j) { const int n = (lane >> 3) + 8 * j; const float* s = scr + (8 * c) * 33 + n;
        u32x4 o; o.x = pk2(s[0 * 33], s[1 * 33]); o.y = pk2(s[2 * 33], s[3 * 33]); o.z = pk2(s[4 * 33], s[5 * 33]); o.w = pk2(s[6 * 33], s[7 * 33]);
        *(u32x4*)(WT + (size_t)n * ldt + 8 * c) = o; }
    __builtin_amdgcn_wave_barrier();
}

__device__ __forceinline__ void tr_one(KP p, int it, float* scr, int lane) {
    constexpr int I_IN = 512, I_GLU = 256, I_OUT = 256, I_W1 = 2048, I_W2 = 2048, I_QKV = 768, I_AO = 512;
    int r = it; const float* W; int N, ldt; bf16* WT; bool glu = false;
    if (r < I_IN) { W = p->in[9]; N = 1024; ldt = 1024; WT = (bf16*)(p->ws + WS_WIN); }
    else if ((r -= I_IN) < I_GLU) { W = p->in[19]; N = 1024; ldt = 512; WT = (bf16*)(p->ws + WS_WGLU); glu = true; }
    else if ((r -= I_GLU) < I_OUT) { W = p->in[10]; N = 1024; ldt = 1024; WT = (bf16*)(p->ws + WS_WOUT); }
    else if ((r -= I_OUT) < I_W1) { W = p->in[7]; N = 4096; ldt = 1024; WT = (bf16*)(p->ws + WS_W1_0); }
    else if ((r -= I_W1) < I_W2) { W = p->in[8]; N = 1024; ldt = 4096; WT = (bf16*)(p->ws + WS_W2_0); }
    else if ((r -= I_W2) < I_QKV) { W = p->in[22]; N = 1536; ldt = 1024; WT = (bf16*)(p->ws + WS_WQKV); }
    else if ((r -= I_QKV) < I_AO) { W = p->in[23]; N = 1024; ldt = 1024; WT = (bf16*)(p->ws + WS_WAO); }
    else if ((r -= I_AO) < I_W1) { W = p->in[7] + (size_t)1024 * 4096; N = 4096; ldt = 1024; WT = (bf16*)(p->ws + WS_W1_1); }
    else { r -= I_W1; W = p->in[8] + (size_t)4096 * 1024; N = 1024; ldt = 4096; WT = (bf16*)(p->ws + WS_W2_1); }
    const int nblk = N / 32, kb = r / nblk, nb = r % nblk, k0 = 64 * kb, n0 = 32 * nb;
    int drow = n0;
    if (glu) { const int bj = n0 >> 9, rem = n0 & 511; drow = 256 * (rem >> 7) + 128 * bj + (rem & 127); }
    tr_item(W + (size_t)k0 * N + n0, N, WT + (size_t)drow * ldt + k0, ldt, scr, lane);
}
__device__ __forceinline__ void prologue(KP p, unsigned char* lds, int tid, int lane, int wave) {
    float* misc = (float*)(lds + 131072);
    { const float* c = p->in[1]; const float* cc = p->in[3];
      for (int i = tid; i < 1024; i += 512) { misc[i] = siluf(c[i]); misc[1024 + i] = siluf(cc[i]); } }
    __syncthreads();
    float* modv = (float*)(p->ws + WS_MOD);
    float* scr = (float*)(lds + wave * 16384);
    const int gw = blockIdx.x * 8 + wave, NGW = gridDim.x * 8, half = NGW >> 1;
    constexpr int NITEMS = 512 + 256 + 256 + 2 * (2048 + 2048) + 768 + 512;
    const int TRA = 4608;
    if (gw < half) {
        for (int wi = gw; wi < 1024; wi += half) {
            const int id = wi * 64 + lane, n = id & 1023, ib = (id >> 10) & 15, gi = id >> 14;
            const float* pw = p->in[20] + (size_t)gi * 16384 + (size_t)(ib * 8) * 128;
            const float* sc = p->in[21] + gi * 128;
            const float* wo = p->in[10] + (size_t)(512 + gi * 128) * 1024 + n;
            float acc[8];
#pragma unroll
            for (int e = 0; e < 8; ++e) acc[e] = 0.f;
#pragma unroll 8
            for (int j = 0; j < 128; ++j) { const float wv = wo[(size_t)j * 1024] * sc[j];
#pragma unroll
                for (int e = 0; e < 8; ++e) acc[e] += pw[e * 128 + j] * wv; }
            u32x4 o; o.x = pk2(acc[0], acc[1]); o.y = pk2(acc[2], acc[3]); o.z = pk2(acc[4], acc[5]); o.w = pk2(acc[6], acc[7]);
            *(u32x4*)((bf16*)(p->ws + WS_WOUT) + (size_t)n * 1024 + 512 + gi * 128 + ib * 8) = o;
        }
        for (int it = gw; it < TRA; it += half) tr_one(p, it, scr, lane);
    } else {
        const int gb = gw - half;
        for (int it = gb; it < 2 * 96 * 8; it += half) {
            const int l = it / 768, r = it % 768, cb = r >> 3, kq = r & 7;
            const float* w = p->in[4] + (size_t)l * 1024 * 6144 + cb * 64 + lane;
            float a0 = 0.f, a1 = 0.f;
#pragma unroll 32
            for (int k = kq * 128; k < kq * 128 + 128; ++k) { const float wv = w[(size_t)k * 6144]; a0 += misc[k] * wv; a1 += misc[1024 + k] * wv; }
            float* mp = (float*)(p->ws + WS_MODP) + (size_t)((l * 8 + kq) * 2) * 6144 + cb * 64 + lane; mp[0] = a0; mp[6144] = a1;
        }
        for (int it = TRA + gb; it < NITEMS; it += half) tr_one(p, it, scr, lane);
    }
    const int gt = blockIdx.x * 512 + tid, NTH = gridDim.x * 512;
    for (int id = gt; id < 4096; id += NTH) {
        const float lr = p->in[11][id], li = p->in[12][id], dt = __expf(p->in[13][id >> 6]);
        const float mag = expf(lr * dt), ar = mag * cosf(li * dt), ai = mag * sinf(li * dt);
        const float den = lr * lr + li * li;
        const float fr = ((ar - 1.f) * lr + ai * li) / den, fi = (ai * lr - (ar - 1.f) * li) / den;
        float* A = (float*)(p->ws + WS_S5A); A[2 * id] = ar; A[2 * id + 1] = ai;
        float* BB = (float*)(p->ws + WS_S5BB) + (size_t)id * 32;
        const float* br = p->in[14] + (size_t)id * 16; const float* bi = p->in[15] + (size_t)id * 16;
#pragma unroll
        for (int c = 0; c < 16; ++c) { const float x = br[c], y = bi[c]; BB[c] = fr * x - fi * y; BB[16 + c] = fr * y + fi * x; }
        const int pos = id >> 4, fq = id & 15;
        const float inv = powf(10000.f, -(float)fq / 16.f), ang = (float)pos * inv;
        float* R = (float*)(p->ws + WS_ROPE); R[2 * id] = cosf(ang); R[2 * id + 1] = sinf(ang);
    }
    for (int id = gt; id < 64 * 17 * 64; id += NTH) {
        const int pp = id & 63, d = (id >> 6) % 17, dg = id / (64 * 17);
        const float lr = p->in[11][dg * 64 + pp], li = p->in[12][dg * 64 + pp], e = (float)d * expf(p->in[13][dg]);
        const float mag = expf(lr * e), ang = li * e;
        ((f32x2*)(p->ws + WS_AP))[id] = (f32x2){mag * cosf(ang), mag * sinf(ang)};
    }
}

struct RowP { const float* xlat; const float* xctx; float* olat; float* octx; const bf16* Y; const float* gA; const float* gate;
              const float* gB; const float* shsc; bf16* H; int r0; int r1; int xb_in; int xb_out; };
struct RowRegs { f32x4 v[4]; u32x2 y[4]; };
__device__ __forceinline__ void row_load(RowRegs& R, const RowP& a, int r, int lane) {
    const bool isctx = r < NCTX;
    const float* xs = isctx ? a.xctx + (size_t)r * DM : a.xlat + (size_t)(r - NCTX) * DM;
    if (!isctx && a.xb_in) {
#pragma unroll
        for (int j = 0; j < 4; ++j) { const u32x2 w = ((const u32x2*)xs)[lane + 64 * j]; R.v[j] = (f32x4){bflo(w.x), bfhi(w.x), bflo(w.y), bfhi(w.y)}; }
    } else {
#pragma unroll
        for (int j = 0; j < 4; ++j) R.v[j] = ((const f32x4*)xs)[lane + 64 * j];
    }
    if (a.Y) {
#pragma unroll
        for (int j = 0; j < 4; ++j) R.y[j] = ((const u32x2*)(a.Y + (size_t)r * DM))[lane + 64 * j];
    }
}
__device__ __forceinline__ void row_finish(RowRegs& R, const RowP& a, int r, int lane) {
    const bool isctx = r < NCTX; const int vo = isctx ? 6144 : 0;
    f32x4 v[4];
#pragma unroll
    for (int j = 0; j < 4; ++j) v[j] = R.v[j];
    if (a.Y) {
        f32x4 y[4]; float ss = 0.f;
#pragma unroll
        for (int j = 0; j < 4; ++j) { const u32x2 w = R.y[j]; y[j] = (f32x4){bflo(w.x), bfhi(w.x), bflo(w.y), bfhi(w.y)};
            ss += (y[j].x * y[j].x + y[j].y * y[j].y) + (y[j].z * y[j].z + y[j].w * y[j].w); }
        const float rstd = rsqrtf(wave_sum(ss) * (1.f / DM) + EPS);
#pragma unroll
        for (int j = 0; j < 4; ++j) { const f32x4 g = ((const f32x4*)a.gA)[lane + 64 * j], gt = ((const f32x4*)(a.gate + vo))[lane + 64 * j];
            v[j] = v[j] + gt * (y[j] * rstd * g); }
    }
    if (isctx) { if (a.Y && a.octx) { float* xo = a.octx + (size_t)r * DM;
#pragma unroll
            for (int j = 0; j < 4; ++j) ((f32x4*)xo)[lane + 64 * j] = v[j]; } }
    else if (a.olat) { float* xo = a.olat + (size_t)(r - NCTX) * DM;
        if (a.xb_out) {
#pragma unroll
            for (int j = 0; j < 4; ++j) { u32x2 o; o.x = pk2(v[j].x, v[j].y); o.y = pk2(v[j].z, v[j].w); ((u32x2*)xo)[lane + 64 * j] = o; }
        } else {
#pragma unroll
            for (int j = 0; j < 4; ++j) ((f32x4*)xo)[lane + 64 * j] = v[j];
        } }
    if (a.H) {
        float ss = 0.f;
#pragma unroll
        for (int j = 0; j < 4; ++j) ss += (v[j].x * v[j].x + v[j].y * v[j].y) + (v[j].z * v[j].z + v[j].w * v[j].w);
        const float rstd = rsqrtf(wave_sum(ss) * (1.f / DM) + EPS);
#pragma unroll
        for (int j = 0; j < 4; ++j) { const f32x4 g = ((const f32x4*)a.gB)[lane + 64 * j], sh = ((const f32x4*)(a.shsc + vo))[lane + 64 * j], sc = ((const f32x4*)(a.shsc + vo + 1024))[lane + 64 * j];
            const f32x4 h = (v[j] * rstd * g) * (sc + 1.f) + sh;
            u32x2 o; o.x = pk2(h.x, h.y); o.y = pk2(h.z, h.w); ((u32x2*)(a.H + (size_t)r * DM))[lane + 64 * j] = o; }
    }
}
__device__ __forceinline__ void row_phase(const RowP& a, int lane, int wave) {
    const int gw = blockIdx.x * 8 + wave, NGW = gridDim.x * 8;
    for (int r = a.r0 + gw; r < a.r1; r += 3 * NGW) {
        const int r2 = r + NGW, r3 = r + 2 * NGW; RowRegs A, B, C;
        row_load(A, a, r, lane);
        if (r2 < a.r1) row_load(B, a, r2, lane);
        if (r3 < a.r1) row_load(C, a, r3, lane);
        row_finish(A, a, r, lane);
        if (r2 < a.r1) row_finish(B, a, r2, lane);
        if (r3 < a.r1) row_finish(C, a, r3, lane);
    }
}

__device__ __forceinline__ int s5_row(int dir, int j, int sl) { const int s = j * 64 + sl; return dir == 0 ? s : (j < 4 ? 255 - s : 16895 - s); }
__device__ __forceinline__ void s5_stage_u(const bf16* U, int row, int g, float* ut, int lane) {
    const u32x4* src = (const u32x4*)(U + (size_t)row * DM + g * 16);
    const u32x4 a = src[0], b = src[1];
    f32x4* d = (f32x4*)(ut + lane * 16);
    d[0] = (f32x4){bflo(a.x), bfhi(a.x), bflo(a.y), bfhi(a.y)}; d[1] = (f32x4){bflo(a.z), bfhi(a.z), bflo(a.w), bfhi(a.w)};
    d[2] = (f32x4){bflo(b.x), bfhi(b.x), bflo(b.y), bfhi(b.y)}; d[3] = (f32x4){bflo(b.z), bfhi(b.z), bflo(b.w), bfhi(b.w)};
}
#define S5_LOAD_BB(dir, g) do { const f32x4* bp_ = (const f32x4*)((const float*)(p->ws + WS_S5BB) + (size_t)(((dir) * 32 + (g)) * 64 + lane) * 32); \
    _Pragma("unroll") for (int q_ = 0; q_ < 4; ++q_) { const f32x4 t_ = bp_[q_]; bbr[4 * q_] = t_.x; bbr[4 * q_ + 1] = t_.y; bbr[4 * q_ + 2] = t_.z; bbr[4 * q_ + 3] = t_.w; } \
    _Pragma("unroll") for (int q_ = 0; q_ < 4; ++q_) { const f32x4 t_ = bp_[4 + q_]; bbi[4 * q_] = t_.x; bbi[4 * q_ + 1] = t_.y; bbi[4 * q_ + 2] = t_.z; bbi[4 * q_ + 3] = t_.w; } } while (0)
#define S5_STEP(utrow) do { const f32x4* up_ = (const f32x4*)(utrow); float bur_ = 0.f, bui_ = 0.f; \
    _Pragma("unroll") for (int q_ = 0; q_ < 4; ++q_) { const f32x4 u_ = up_[q_]; \
        bur_ += bbr[4 * q_] * u_.x + bbr[4 * q_ + 1] * u_.y + bbr[4 * q_ + 2] * u_.z + bbr[4 * q_ + 3] * u_.w; \
        bui_ += bbi[4 * q_] * u_.x + bbi[4 * q_ + 1] * u_.y + bbi[4 * q_ + 2] * u_.z + bbi[4 * q_ + 3] * u_.w; } \
    const float nr_ = ar * hr - ai * hi + bur_, ni_ = ar * hi + ai * hr + bui_; hr = nr_; hi = ni_; } while (0)

__device__ __forceinline__ void pool_s5a_phase(KP p, int lane, int wave, int b0, int nb) {
    const bf16* U = (const bf16*)(p->ws + WS_U); bf16* Z = (bf16*)(p->ws + WS_Z);
    const int gw = ((int)blockIdx.x - b0) * 8 + wave, NGW = nb * 8;
    for (int it = gw; it < 4 * (T / 4); it += NGW) {
        const int gi = it / (T / 4), r = 4 * (it % (T / 4)) + (lane >> 4), col = 512 + gi * 128 + (lane & 15) * 8;
        const int w = 2 << gi, lo = w >> 1, hi = w - 1 - lo;
        const int s0 = r < NCTX ? 0 : NCTX, s1 = r < NCTX ? NCTX : T;
        const int st = (r - lo) < s0 ? s0 : (r - lo), en = (r + hi + 1) > s1 ? s1 : (r + hi + 1);
        float acc[8];
#pragma unroll
        for (int e = 0; e < 8; ++e) acc[e] = 0.f;
#define POOL_ACC(W) { u32x4 xv[W]; _Pragma("unroll") for (int q = 0; q < W; ++q) { int rr = r - (W / 2) + q; rr = rr < st ? st : (rr >= en ? en - 1 : rr); xv[q] = *(const u32x4*)(U + (size_t)rr * DM + col); } \
        _Pragma("unroll") for (int q = 0; q < W; ++q) { const int rr = r - (W / 2) + q; const float m_ = (rr >= st && rr < en) ? 1.f : 0.f; const u32x4 x = xv[q]; \
            acc[0] += m_ * bflo(x.x); acc[1] += m_ * bfhi(x.x); acc[2] += m_ * bflo(x.y); acc[3] += m_ * bfhi(x.y); acc[4] += m_ * bflo(x.z); acc[5] += m_ * bfhi(x.z); acc[6] += m_ * bflo(x.w); acc[7] += m_ * bfhi(x.w); } }
        if (gi == 0) POOL_ACC(2) else if (gi == 1) POOL_ACC(4) else if (gi == 2) POOL_ACC(8) else POOL_ACC(16)
#undef POOL_ACC
        const u32x4 x = *(const u32x4*)(U + (size_t)r * DM + col);
        const float ic = 1.f / (float)(en - st);
        u32x4 o; o.x = pk2(acc[0] * ic - bflo(x.x), acc[1] * ic - bfhi(x.x)); o.y = pk2(acc[2] * ic - bflo(x.y), acc[3] * ic - bfhi(x.y));
        o.z = pk2(acc[4] * ic - bflo(x.z), acc[5] * ic - bfhi(x.z)); o.w = pk2(acc[6] * ic - bflo(x.w), acc[7] * ic - bfhi(x.w));
        *(u32x4*)(Z + (size_t)r * DM + col) = o;
    }
}
typedef short bf16x8v __attribute__((ext_vector_type(8)));
typedef float f32x16v __attribute__((ext_vector_type(16)));
__device__ __forceinline__ int crow16(int r, int hi) { return (r & 3) + 8 * (r >> 2) + 4 * hi; }
__device__ __forceinline__ size_t frag_idx(int n, int k, int KSN) { return ((size_t)(((n >> 5) * KSN + (k >> 4)) * 64 + ((k >> 3) & 1) * 32 + (n & 31))) * 8 + (k & 7); }
__device__ __forceinline__ void s5_build(KP p, int tid, int part, int b0, int nb) {
    const float* BBt = (const float*)(p->ws + WS_S5BB); const f32x2* AP = (const f32x2*)(p->ws + WS_AP);
    const int gt = ((int)blockIdx.x - b0) * 512 + tid, NTH = nb * 512;
    bf16* KS = (bf16*)(p->ws + WS_KS); bf16* CA = (bf16*)(p->ws + WS_CA); bf16* BA = (bf16*)(p->ws + WS_BA);
    if (part == 1) for (int id = gt; id < 32 * 16 * 256; id += NTH) {
        const int cp = id & 15, c = (id >> 4) & 15, d = (id >> 8) & 15, g = id >> 12;
        float L[2];
#pragma unroll
        for (int dir = 0; dir < 2; ++dir) { const int dg = dir * 32 + g; float acc = 0.f;
            const float* crp = p->in[16] + (size_t)(dg * 16 + c) * 64; const float* cip = p->in[17] + (size_t)(dg * 16 + c) * 64;
#pragma unroll 8
            for (int q = 0; q < 64; ++q) { const f32x2 P = AP[(dg * 17 + d) * 64 + q]; const float Cr = crp[q], Ci = cip[q];
                const float Br = BBt[(size_t)(dg * 64 + q) * 32 + cp], Bi = BBt[(size_t)(dg * 64 + q) * 32 + 16 + cp];
                const float wr = Cr * P.x - Ci * P.y, wi = Cr * P.y + Ci * P.x; acc += wr * Br - wi * Bi; }
            L[dir] = acc; }
        bf16* Kg = KS + (size_t)g * 65536;
        if (d == 0) { const float v = L[0] + L[1] + (c == cp ? p->in[18][g * 16 + c] : 0.f); const bf16 b = (bf16)f2bf(v);
            for (int i = 0; i < 16; ++i) Kg[frag_idx(i * 16 + c, i * 16 + cp, 16)] = b; }
        else { const bf16 bf = (bf16)f2bf(L[0]), br = (bf16)f2bf(L[1]);
            for (int i = 0; i + d < 16; ++i) { Kg[frag_idx((i + d) * 16 + c, i * 16 + cp, 16)] = bf; Kg[frag_idx(i * 16 + c, (i + d) * 16 + cp, 16)] = br; } }
    }
    if (part == 1) for (int id = gt; id < 64 * 256 * 64; id += NTH) {
        const int q = id & 63, n = (id >> 6) & 255, dg = id >> 14, t = n >> 4, c = n & 15, e = (dg < 32) ? t + 1 : 16 - t;
        const f32x2 P = AP[(dg * 17 + e) * 64 + q]; const float Cr = p->in[16][(size_t)(dg * 16 + c) * 64 + q], Ci = p->in[17][(size_t)(dg * 16 + c) * 64 + q];
        CA[(size_t)dg * 32768 + frag_idx(n, q, 8)] = (bf16)f2bf(Cr * P.x - Ci * P.y); CA[(size_t)dg * 32768 + frag_idx(n, 64 + q, 8)] = (bf16)f2bf(-(Cr * P.y + Ci * P.x));
    }
    if (part == 0) for (int id = gt; id < 64 * 64 * 256; id += NTH) {
        const int kk = id & 255, q = (id >> 8) & 63, dg = id >> 14, sdx = kk >> 4, cp = kk & 15, e = (dg < 32) ? 15 - sdx : sdx;
        const f32x2 P = AP[(dg * 17 + e) * 64 + q]; const float Br = BBt[(size_t)(dg * 64 + q) * 32 + cp], Bi = BBt[(size_t)(dg * 64 + q) * 32 + 16 + cp];
        BA[(size_t)dg * 32768 + frag_idx(q, kk, 16)] = (bf16)f2bf(P.x * Br - P.y * Bi); BA[(size_t)dg * 32768 + frag_idx(64 + q, kk, 16)] = (bf16)f2bf(P.x * Bi + P.y * Br);
    }
}
template <int NTL> __device__ __forceinline__ void s5_end_unit(KP p, int ct, int dir, int g, int nt0, int lane) {
    const bf16* U = (const bf16*)(p->ws + WS_U); const bf16* BA = (const bf16*)(p->ws + WS_BA); bf16* E = (bf16*)(p->ws + WS_Y);
    const int m = lane & 31, half = lane >> 5; const int chunk = (32 * ct + m) < NC16 ? (32 * ct + m) : NC16 - 1;
    const bf16* up = U + (size_t)(16 * chunk) * DM + 16 * g + 8 * half;
    const bf16* bp = BA + (size_t)(dir * 32 + g) * 32768 + (size_t)lane * 8;
    f32x16v acc[NTL];
#pragma unroll
    for (int nt = 0; nt < NTL; ++nt) acc[nt] = (f32x16v){};
#pragma unroll 8
    for (int ks = 0; ks < 16; ++ks) { const bf16x8v a = *(const bf16x8v*)(up + (size_t)ks * DM);
#pragma unroll
        for (int nt = 0; nt < NTL; ++nt) { const bf16x8v b = *(const bf16x8v*)(bp + (size_t)(((nt0 + nt) * 16 + ks) * 64) * 8);
            acc[nt] = __builtin_amdgcn_mfma_f32_32x32x16_bf16(a, b, acc[nt], 0, 0, 0); } }
#pragma unroll
    for (int nt = 0; nt < NTL; ++nt)
#pragma unroll
        for (int r = 0; r < 16; ++r) { const int ch = 32 * ct + crow16(r, half); if (ch < NC16) E[(size_t)((dir * NC16 + ch) * 32 + g) * 128 + 32 * (nt0 + nt) + m] = (bf16)f2bf(acc[nt][r]); }
}
__device__ __forceinline__ void s5_end_phase(KP p, int lane, int wave) {
    const int gw = blockIdx.x * 8 + wave, NGW = gridDim.x * 8;
    for (int unit = gw; unit < 32 * 64; unit += NGW) s5_end_unit<4>(p, unit >> 6, (unit >> 5) & 1, unit & 31, 0, lane);
    if (wave == 0) for (int tu = blockIdx.x; tu < 256; tu += gridDim.x) s5_end_unit<1>(p, 32, (tu >> 5) & 1, tu & 31, tu >> 6, lane);
}
__device__ __forceinline__ void s5_carry_phase(KP p, unsigned char* lds, int lane, int wave) {
    const bf16* E = (const bf16*)(p->ws + WS_Y); bf16* Hin = (bf16*)(p->ws + WS_H);
    float* seg = (float*)lds;
    for (int dg = blockIdx.x; dg < 64; dg += gridDim.x) {
        const int dir = dg >> 5, g = dg & 31;
        const f32x2 A16 = ((const f32x2*)(p->ws + WS_AP))[(dg * 17 + 16) * 64 + lane];
        float hr = 0.f, hi = 0.f;
        for (int jb = 0; jb < 130; jb += 26) { float er[26], ei[26];
#pragma unroll
            for (int q = 0; q < 26; ++q) { const int j = 130 * wave + jb + q, rc = dir == 0 ? j : (j < 16 ? 15 - j : 1055 - j); const bf16* ep = E + (size_t)((dir * NC16 + rc) * 32 + g) * 128; er[q] = __uint_as_float((unsigned)ep[lane] << 16); ei[q] = __uint_as_float((unsigned)ep[64 + lane] << 16); }
#pragma unroll
            for (int q = 0; q < 26; ++q) { const float nr = A16.x * hr - A16.y * hi + er[q], ni = A16.x * hi + A16.y * hr + ei[q]; hr = nr; hi = ni; } }
        seg[wave * 128 + lane] = hr; seg[wave * 128 + 64 + lane] = hi;
        float pr = 1.f, pi = 0.f;
        for (int q = 0; q < 130; ++q) { const float nr = pr * A16.x - pi * A16.y, ni = pr * A16.y + pi * A16.x; pr = nr; pi = ni; }
        __syncthreads();
        hr = 0.f; hi = 0.f;
        for (int w = 0; w < wave; ++w) { const float sr = seg[w * 128 + lane], si = seg[w * 128 + 64 + lane]; const float nr = pr * hr - pi * hi + sr, ni = pr * hi + pi * hr + si; hr = nr; hi = ni; }
        for (int jb = 0; jb < 130; jb += 26) { float er[26], ei[26];
#pragma unroll
            for (int q = 0; q < 26; ++q) { const int j = 130 * wave + jb + q, rc = dir == 0 ? j : (j < 16 ? 15 - j : 1055 - j); const bf16* ep = E + (size_t)((dir * NC16 + rc) * 32 + g) * 128; er[q] = __uint_as_float((unsigned)ep[lane] << 16); ei[q] = __uint_as_float((unsigned)ep[64 + lane] << 16); }
#pragma unroll
            for (int q = 0; q < 26; ++q) { const int j = 130 * wave + jb + q, rc = dir == 0 ? j : (j < 16 ? 15 - j : 1055 - j); bf16* hp = Hin + (size_t)(dg * NC16 + rc) * 128;
                hp[lane] = (bf16)f2bf(hr); hp[64 + lane] = (bf16)f2bf(hi);
                const float nr = A16.x * hr - A16.y * hi + er[q], ni = A16.x * hi + A16.y * hr + ei[q]; hr = nr; hi = ni; } }
        __syncthreads();
    }
}
template <int NTL> __device__ __forceinline__ void s5_out_unit(KP p, int ct, int g, int nt0, int lane) {
    const bf16* U = (const bf16*)(p->ws + WS_U); const bf16* KS = (const bf16*)(p->ws + WS_KS); const bf16* CA = (const bf16*)(p->ws + WS_CA);
    const bf16* Hin = (const bf16*)(p->ws + WS_H); bf16* G = (bf16*)(p->ws + WS_G);
    const int m = lane & 31, half = lane >> 5; const int chunk = (32 * ct + m) < NC16 ? (32 * ct + m) : NC16 - 1;
    const bf16* up = U + (size_t)(16 * chunk) * DM + 16 * g + 8 * half;
    const bf16* kp = KS + (size_t)g * 65536 + (size_t)lane * 8;
    f32x16v acc[NTL];
#pragma unroll
    for (int nt = 0; nt < NTL; ++nt) acc[nt] = (f32x16v){};
#pragma unroll 8
    for (int ks = 0; ks < 16; ++ks) { const bf16x8v a = *(const bf16x8v*)(up + (size_t)ks * DM);
#pragma unroll
        for (int nt = 0; nt < NTL; ++nt) { const bf16x8v b = *(const bf16x8v*)(kp + (size_t)(((nt0 + nt) * 16 + ks) * 64) * 8);
            acc[nt] = __builtin_amdgcn_mfma_f32_32x32x16_bf16(a, b, acc[nt], 0, 0, 0); } }
#pragma unroll 1
    for (int dir = 0; dir < 2; ++dir) { const int dg = dir * 32 + g; const bf16* hp = Hin + (size_t)(dg * NC16 + chunk) * 128 + 8 * half;
        const bf16* cp = CA + (size_t)dg * 32768 + (size_t)lane * 8;
#pragma unroll
        for (int ks = 0; ks < 8; ++ks) { const bf16x8v a = *(const bf16x8v*)(hp + 16 * ks);
#pragma unroll
            for (int nt = 0; nt < NTL; ++nt) { const bf16x8v b = *(const bf16x8v*)(cp + (size_t)(((nt0 + nt) * 8 + ks) * 64) * 8);
                acc[nt] = __builtin_amdgcn_mfma_f32_32x32x16_bf16(a, b, acc[nt], 0, 0, 0); } } }
#pragma unroll
    for (int nt = 0; nt < NTL; ++nt) { const int t = 2 * (nt0 + nt) + (m >> 4), c = m & 15;
#pragma unroll
        for (int r = 0; r < 16; ++r) { const int ch = 32 * ct + crow16(r, half); if (ch < NC16) G[(size_t)(16 * ch + t) * 512 + 16 * g + c] = (bf16)f2bf(gelu_tanh(acc[nt][r])); } }
}
__device__ __forceinline__ void s5_out_phase(KP p, int lane, int wave) {
    const int gw = blockIdx.x * 8 + wave, NGW = gridDim.x * 8;
    for (int unit = gw; unit < 32 * 64; unit += NGW) s5_out_unit<4>(p, unit >> 6, unit & 31, 4 * ((unit >> 5) & 1), lane);
    if (wave == 0) for (int tu = blockIdx.x; tu < 256; tu += gridDim.x) s5_out_unit<1>(p, 32, tu & 31, tu >> 5, lane);
}

__device__ __forceinline__ float row16_sum(float v) {
    v += __int_as_float(__builtin_amdgcn_update_dpp(0, __float_as_int(v), 0x128, 0xf, 0xf, false));
    v += __int_as_float(__builtin_amdgcn_update_dpp(0, __float_as_int(v), 0x124, 0xf, 0xf, false));
    v += __int_as_float(__builtin_amdgcn_update_dpp(0, __float_as_int(v), 0x122, 0xf, 0xf, false));
    v += __int_as_float(__builtin_amdgcn_update_dpp(0, __float_as_int(v), 0x121, 0xf, 0xf, false));
    return v;
}
__device__ __forceinline__ void qkv_post_phase(KP p, int lane, int wave) {
    const bf16* raw = (const bf16*)(p->ws + WS_QKV); bf16* Q = (bf16*)(p->ws + WS_Q); bf16* K = (bf16*)(p->ws + WS_K); bf16* V = (bf16*)(p->ws + WS_V);
    const float* R = (const float*)(p->ws + WS_ROPE);
    const int gw = blockIdx.x * 8 + wave, NGW = gridDim.x * 8;
    const int j = lane & 15, hq = lane >> 4;
    const f32x4 qn = ((const f32x4*)p->in[24])[j], kn = ((const f32x4*)p->in[25])[j];
    for (int r = gw; r < T; r += NGW) {
        const bool lat = r >= NCTX; const int tl = r - NCTX;
        const int pos = (j < 8) ? (tl >> 6) : (tl & 63);
        f32x4 cs0 = (f32x4){1.f, 0.f, 1.f, 0.f}, cs1 = cs0;
        if (lat) { const f32x4* rp = (const f32x4*)(R + (size_t)pos * 32 + 8 * (j & 3)); cs0 = rp[0]; cs1 = rp[1]; }
        const bool up = (j & 4) != 0;
        u32x2 wv[5];
#pragma unroll
        for (int pass = 0; pass < 5; ++pass) { const int col = pass < 4 ? (pass * 4 + hq) * 64 + 4 * j : 1024 + hq * 64 + 4 * j; wv[pass] = (lat || pass == 4) ? *(const u32x2*)(raw + (size_t)r * NQKV + col) : (u32x2){0u, 0u}; }
        const u32x2 vv = *(const u32x2*)(raw + (size_t)r * NQKV + 1280 + 4 * lane);
#pragma unroll
        for (int pass = 0; pass < 5; ++pass) {
            if (!lat && pass < 4) continue;
            const u32x2 w = wv[pass];
            f32x4 x = (f32x4){bflo(w.x), bfhi(w.x), bflo(w.y), bfhi(w.y)};
            float ss = (x.x * x.x + x.y * x.y) + (x.z * x.z + x.w * x.w);
            ss = row16_sum(ss);
            const float rstd = rsqrtf(ss * (1.f / 64.f) + EPS);
            x = x * rstd * (pass < 4 ? qn : kn);
            if (lat) {
                f32x4 o; o.x = __shfl_xor(x.x, 4); o.y = __shfl_xor(x.y, 4); o.z = __shfl_xor(x.z, 4); o.w = __shfl_xor(x.w, 4);
                const float sg = up ? 1.f : -1.f;
                x.x = x.x * cs0.x + sg * o.x * cs0.y; x.y = x.y * cs0.z + sg * o.y * cs0.w; x.z = x.z * cs1.x + sg * o.z * cs1.y; x.w = x.w * cs1.z + sg * o.w * cs1.w;
            }
            if (pass < 4) { x = x * attn_body::C2; u32x2 o; o.x = pk2(x.x, x.y); o.y = pk2(x.z, x.w); *(u32x2*)(Q + (size_t)r * DM + (pass * 4 + hq) * 64 + 4 * j) = o; }
            else { u32x2 o; o.x = pk2(x.x, x.y); o.y = pk2(x.z, x.w); *(u32x2*)(K + (size_t)r * 256 + hq * 64 + 4 * j) = o; }
        }
        *(u32x2*)(V + (size_t)r * 256 + 4 * lane) = vv;
    }
}


template <int KIND> __device__ __forceinline__ void skinny_gemm(unsigned char* lds, const bf16* A, const bf16* Bt, int N, int K, bf16* O, int ldc, int tid, int lane, int wave) {
    const int nct = (KIND == 3 ? N / 2 : N) / 32, nunits = 8 * nct, m = lane & 31, half = lane >> 5, kw = K >> 3;
    float* red = (float*)lds;
    for (int u = blockIdx.x; u < nunits; u += gridDim.x) {
        const int rt = u & 7, ct = u >> 3;
        const int brow0 = (KIND == 3) ? 256 * (ct >> 2) + 32 * (ct & 3) : 32 * ct;
        const bf16* ap = A + (size_t)(32 * rt + m) * K + wave * kw + 8 * half;
        const bf16* bp = Bt + (size_t)(brow0 + m) * K + wave * kw + 8 * half;
        f32x16v acc0 = (f32x16v){}, acc1 = (f32x16v){};
#pragma unroll 4
        for (int ks = 0; ks < (kw >> 4); ++ks) { const bf16x8v a = *(const bf16x8v*)(ap + 16 * ks); const bf16x8v b0 = *(const bf16x8v*)(bp + 16 * ks);
            acc0 = __builtin_amdgcn_mfma_f32_32x32x16_bf16(a, b0, acc0, 0, 0, 0);
            if (KIND == 3) { const bf16x8v b1 = *(const bf16x8v*)(bp + (size_t)128 * K + 16 * ks); acc1 = __builtin_amdgcn_mfma_f32_32x32x16_bf16(a, b1, acc1, 0, 0, 0); } }
#pragma unroll
        for (int r = 0; r < 16; ++r) { red[(wave * 2) * 1024 + r * 64 + lane] = acc0[r]; if (KIND == 3) red[(wave * 2 + 1) * 1024 + r * 64 + lane] = acc1[r]; }
        __syncthreads();
        for (int e = tid; e < 1024; e += 512) { float s0 = 0.f, s1 = 0.f;
#pragma unroll
            for (int w = 0; w < 8; ++w) { s0 += red[(w * 2) * 1024 + e]; if (KIND == 3) s1 += red[(w * 2 + 1) * 1024 + e]; }
            const int r = e >> 6, ln = e & 63, row = 32 * rt + crow16(r, ln >> 5), col = 32 * ct + (ln & 31);
            float v = s0; if (KIND == 2) { v = v > 0.f ? v * v : 0.f; } if (KIND == 3) v = s0 / (1.f + __expf(-s1));
            O[(size_t)row * ldc + col] = (bf16)f2bf(v); }
        __syncthreads();
    }
}

#define GAS __attribute__((address_space(1)))
#define LAS __attribute__((address_space(3)))
typedef GAS unsigned gu32;
typedef GAS unsigned long long gu64;
#define RLX_AGENT __ATOMIC_RELAXED, __HIP_MEMORY_SCOPE_AGENT
#define LDS_WAIT() asm volatile("s_waitcnt lgkmcnt(0)" ::: "memory")
#define VM_WAIT() asm volatile("s_waitcnt vmcnt(0)" ::: "memory")
__device__ __forceinline__ unsigned long long rt() { return __builtin_amdgcn_s_memrealtime(); }
#define XB_TMO      128
#define XB_XCNT(j)  (256  + 64 * (j))
#define XB_XSUB(j)  (1280 + 64 * (j))
#define XB_XGEN(j)  (2304 + 64 * (j))
#define XB_TOP      3328
#define XB_TOPGEN   3392
#define XCD_BAR_WORDS 3456
#define XB_SPIN_CAP (1u << 18)

__device__ __forceinline__ unsigned xb_ld(unsigned* p)              { return __hip_atomic_load(p, __ATOMIC_RELAXED, __HIP_MEMORY_SCOPE_AGENT); }
__device__ __forceinline__ unsigned xb_add(unsigned* p, unsigned v) { return __hip_atomic_fetch_add(p, v, __ATOMIC_RELAXED, __HIP_MEMORY_SCOPE_AGENT); }
__device__ __forceinline__ unsigned xb_xcc_id() { return (unsigned)__builtin_amdgcn_s_getreg((3 << 11) | 20) & 0xFu; }
#define XB_SPIN(cond, bar) do { unsigned _sp = 0; while (cond) { __builtin_amdgcn_s_sleep(1); \
    if ((++_sp & 255u) == 0u) { if (xb_ld(&(bar)[XB_TMO])) break; if (_sp > XB_SPIN_CAP) { atomicAdd(&(bar)[XB_TMO], 1u); break; } } } } while (0)

struct XcdBarrier {
    unsigned* bar; unsigned x;
    volatile LAS unsigned* st;
};

__device__ __forceinline__ XcdBarrier xcd_barrier_post(unsigned* bar, volatile LAS unsigned* st) {
    XcdBarrier b; b.bar = bar; b.x = xb_xcc_id(); b.st = st;
    if (threadIdx.x == 0) (void)xb_add(&bar[XB_XCNT(b.x)], 1u);
    return b;
}
__device__ __forceinline__ void xcd_barrier_complete(unsigned* bar, unsigned x, unsigned& nloc, unsigned& nx) {
    const unsigned G = gridDim.x * gridDim.y * gridDim.z;
    unsigned sum, cnt, mine, sp = 0u;
    for (;;) {
        sum = 0u; cnt = 0u; mine = 0u;
#pragma unroll
        for (unsigned j = 0; j < 16; ++j) { const unsigned c = xb_ld(&bar[XB_XCNT(j)]); sum += c; cnt += (c > 0u) ? 1u : 0u; mine = (j == x) ? c : mine; }
        if (sum == G) break;
        __builtin_amdgcn_s_sleep(1);
        if ((++sp & 255u) == 0u) { if (xb_ld(&bar[XB_TMO])) break; if (sp > XB_SPIN_CAP) { atomicAdd(&bar[XB_TMO], 1u); break; } }
    }
    nloc = mine > 0u ? mine : 1u; nx = cnt > 0u ? cnt : 1u;
}

__device__ __forceinline__ void xcd_barrier(const XcdBarrier& b) {
    asm volatile("s_waitcnt vmcnt(0)" ::: "memory");
    __syncthreads();
    if (threadIdx.x == 0) {
        unsigned* bar = b.bar;
        __builtin_amdgcn_s_waitcnt(0);
        unsigned nloc = b.st[0], nx = b.st[1];
        if (nloc == 0u) { xcd_barrier_complete(bar, b.x, nloc, nx); b.st[0] = nloc; b.st[1] = nx; }
        const unsigned old = xb_add(&bar[XB_XSUB(b.x)], 1u);
        const unsigned gen = old / nloc;
        if (old + 1u == (gen + 1u) * nloc) {
            __builtin_amdgcn_fence(__ATOMIC_RELEASE, "agent");
            asm volatile("s_waitcnt vmcnt(0)" ::: "memory");
            const unsigned og = xb_add(&bar[XB_TOP], 1u);
            const unsigned tg = og / nx;
            if (og + 1u == (tg + 1u) * nx) xb_add(&bar[XB_TOPGEN], 1u);
            else XB_SPIN(xb_ld(&bar[XB_TOPGEN]) == tg, bar);
            __builtin_amdgcn_fence(__ATOMIC_ACQUIRE, "agent");
            xb_add(&bar[XB_XGEN(b.x)], 1u);
            asm volatile("s_waitcnt vmcnt(0)" ::: "memory");
        } else {
            XB_SPIN(xb_ld(&bar[XB_XGEN(b.x)]) == gen, bar);
            __builtin_amdgcn_fence(__ATOMIC_ACQUIRE, "agent");
            asm volatile("s_waitcnt vmcnt(0)" ::: "memory");
        }
    }
    __syncthreads();
}

template <class Epi> __device__ __forceinline__ void run_gemm(LAS3 unsigned char* lds3, const bf16* A, const bf16* Bt, int M, int N, int K, const Epi& E) {
    pg8::Gemm g{A, Bt, M, N, K}; pg8::StaticOrder S; S.init(M, N, (int)gridDim.x, (int)blockIdx.x);
    pg8::gemm_phase<Epi, pg8::StaticOrder, true, true>(lds3, g, S, E);
}
__device__ __forceinline__ void run_gemm_fused(LAS3 unsigned char* lds3, const bf16* A, const bf16* Bt, int K, const pg8::EpiRmsRes& E) {
    pg8::Gemm g{A, Bt, NLAT, 1024, K}; pg8::StaticOrder S; S.init(NLAT, 1024, (int)gridDim.x, (int)blockIdx.x);
    pg8::gemm_phase<pg8::EpiRmsRes, pg8::StaticOrder, false, true>(lds3, g, S, E);
}
constexpr int NSTEP = 20;
__global__ void __launch_bounds__(512, 2) mega_fwd(Params p_unused) {
    extern __shared__ __attribute__((aligned(16))) unsigned char lds[];
    cg::grid_group grid = cg::this_grid();
    const size_t LO = (size_t)NCTX;
    bool again = false; (void)again;
    if (threadIdx.x < 2) ((volatile LAS unsigned*)((LAS unsigned char*)lds + 143360))[threadIdx.x] = 0u;
    __syncthreads();
    {
        KP p0 = (KP)__builtin_amdgcn_kernarg_segment_ptr();
        if (p0->ws == nullptr) grid.sync();
        (void)xcd_barrier_post((unsigned*)(p0->ws + WS_BAR), (volatile LAS unsigned*)((LAS unsigned char*)lds + 143360));
    }
#pragma unroll 1
    for (int step = 0; step < NSTEP; ++step) {
        KP p = (KP)__builtin_amdgcn_kernarg_segment_ptr();
        asm volatile("" : "+s"(p));
        int tid_ = threadIdx.x; asm volatile("" : "+v"(tid_));
        const int tid = tid_, lane = tid & 63, wave = __builtin_amdgcn_readfirstlane(tid >> 6);
        unsigned char* ws = p->ws;
        const float* modv = (const float*)(ws + WS_MOD);
        const float* ng = p->in[6];
        bf16* H = (bf16*)(ws + WS_H); bf16* Y = (bf16*)(ws + WS_Y); bf16* HID = (bf16*)(ws + WS_BIG);
        float* XC = (float*)(ws + WS_XC);
        if (step == 0) prologue(p, lds, tid, lane, wave);
        else if (step == 3) s5_end_phase(p, lane, wave);
        else if (step == 4) {
            if (blockIdx.x < 64) s5_carry_phase(p, lds, lane, wave); else { pool_s5a_phase(p, lane, wave, 64, 192); s5_build(p, tid, 1, 64, 192); }
        }
        else if (step == 5) s5_out_phase(p, lane, wave);
        else if (step == 13) qkv_post_phase(p, lane, wave);
        else if (step == 14) {
            const attn_body::AttnTensors AT{(const attn_body::bf16*)(ws + WS_Q) + LO * DM, (const attn_body::bf16*)(ws + WS_K), (const attn_body::bf16*)(ws + WS_V), (attn_body::bf16*)(ws + WS_O) + LO * DM};
            const attn_body::StaticOrder S((int)gridDim.x, (int)blockIdx.x);
            attn_body::attn_phase<attn_body::StaticOrder>((char*)lds, AT, S);
        } else if (step == 1) {
            float* ml = (float*)lds; const float* MP = (const float*)(ws + WS_MODP); const float* bias = p->in[5];
            for (int i = tid; i < 4096; i += 512) { const int v = i >> 11, c = i & 2047; float sacc = bias[c];
#pragma unroll
                for (int q = 0; q < 8; ++q) sacc += MP[(size_t)(q * 2 + v) * 6144 + c];
                ml[v * 6144 + c] = sacc; }
            for (int i = blockIdx.x * 512 + tid; i < 24576; i += gridDim.x * 512) { const int l = i / 12288, v = (i / 6144) & 1, c = i % 6144; float sacc = bias[l * 6144 + c];
#pragma unroll
                for (int q = 0; q < 8; ++q) sacc += MP[(size_t)((l * 8 + q) * 2 + v) * 6144 + c];
                ((float*)(ws + WS_MOD))[(size_t)(l * 2 + v) * 6144 + c] = sacc; }
            __syncthreads();
            const RowP ra{p->in[0], p->in[2], p->out, nullptr, nullptr, ng, modv, ng + 0 * 1024, ml, H, 0, T, 0, 1};
            row_phase(ra, lane, wave); s5_build(p, tid, 0, 0, (int)gridDim.x);
        } else if (step == 8) {
            const RowP ra{p->out, p->in[2], p->out, XC, Y, ng + 1 * 1024, modv + 2048, ng + 2 * 1024, modv + 3072, H, 0, T, 1, 1};
            row_phase(ra, lane, wave);
        } else if (step == 11) {
            const RowP ra{p->out, XC, p->out, XC, Y, ng + 3 * 1024, modv + 5120, ng + 4 * 1024, modv + 2 * 6144 + 0, H, 0, T, 1, 1};
            row_phase(ra, lane, wave);
        } else if (step == 16) {
            const RowP ra{p->out, XC, p->out, XC, Y, ng + 5 * 1024, modv + 2 * 6144 + 2048, ng + 6 * 1024, modv + 2 * 6144 + 3072, H, NCTX, T, 1, 1};
            row_phase(ra, lane, wave);
        } else if (step == 19) {
            const RowP ra{p->out, XC, p->out, XC, Y, ng + 7 * 1024, modv + 2 * 6144 + 5120, ng, modv, nullptr, NCTX, T, 1, 0};
            row_phase(ra, lane, wave);
        } else {
            int gk = 0; const bf16* gA = H; const bf16* gB = nullptr; int gN = 1024, gK = 1024; bf16* gO = Y; int gld = 1024; bool ctx = true; int gM = NLAT; size_t lo = LO;
            switch (step) {
            case 2: gB = (const bf16*)(ws + WS_WIN); gO = (bf16*)(ws + WS_U); break;
            case 6: gk = 3; gA = (const bf16*)(ws + WS_G); gB = (const bf16*)(ws + WS_WGLU); gK = 512; gO = (bf16*)(ws + WS_Z); break;
            case 7: gA = (const bf16*)(ws + WS_Z); gB = (const bf16*)(ws + WS_WOUT); break;
            case 9: gk = 2; gB = (const bf16*)(ws + WS_W1_0); gN = 4096; gO = HID; gld = 4096; ctx = false; gM = T; lo = 0; break;
            case 10: gA = HID; gB = (const bf16*)(ws + WS_W2_0); gK = 4096; break;
            case 12: gB = (const bf16*)(ws + WS_WQKV); gN = NQKV; gO = (bf16*)(ws + WS_QKV); gld = NQKV; ctx = false; gM = T; lo = 0; break;
            case 15: gA = (const bf16*)(ws + WS_O); gB = (const bf16*)(ws + WS_WAO); ctx = false; break;
            case 17: gk = 2; gB = (const bf16*)(ws + WS_W1_1); gN = 4096; gO = HID; gld = 4096; ctx = false; break;
            default: gA = HID; gB = (const bf16*)(ws + WS_W2_1); gK = 4096; ctx = false; break;
            }
            const bf16* gAl = gA + lo * (size_t)gK; bf16* gOl = gO + lo * (size_t)gld;
            if (gk == 0) { if (ctx) skinny_gemm<0>(lds, gA, gB, gN, gK, gO, gld, tid, lane, wave); pg8::EpiBf16<0> E{gOl, gld}; run_gemm((LAS3 unsigned char*)lds, gAl, gB, gM, gN, gK, E); }
            else if (gk == 2) { if (ctx) skinny_gemm<2>(lds, gA, gB, gN, gK, gO, gld, tid, lane, wave); pg8::EpiBf16<2> E{gOl, gld}; run_gemm((LAS3 unsigned char*)lds, gAl, gB, gM, gN, gK, E); }
            else { skinny_gemm<3>(lds, gA, gB, gN, gK, gO, gld, tid, lane, wave); pg8::EpiGlu E{gOl, gld}; run_gemm((LAS3 unsigned char*)lds, gAl, gB, NLAT, gN, gK, E); }
        }
        if (step != NSTEP - 1) { XcdBarrier xb; xb.bar = (unsigned*)(p->ws + WS_BAR); xb.x = xb_xcc_id(); xb.st = (volatile LAS unsigned*)((LAS unsigned char*)lds + 143360); xcd_barrier(xb); }
#ifdef PROBE_MASK
        if (((PROBE_MASK >> step) & 1) && !again) { again = true; --step; } else again = false;
#endif
    }
}

extern "C" void kernel_launch(void* const* d_in, const int* in_sizes, int n_in, void* d_out, int out_size, void* d_ws, size_t ws_size, hipStream_t stream) {
    static int grid = 0;
    if (grid == 0) {
        if (n_in != 26 || out_size != NLAT * DM || ws_size < WS_END) { fprintf(stderr, "kernel_launch: unexpected shapes (n_in %d out %d ws %zu)\n", n_in, out_size, ws_size); grid = -1; return; }
        int dev = 0, cus = 0, per_cu = 0;
        (void)hipGetDevice(&dev); (void)hipDeviceGetAttribute(&cus, hipDeviceAttributeMultiprocessorCount, dev);
        if (hipFuncSetAttribute((const void*)mega_fwd, hipFuncAttributeMaxDynamicSharedMemorySize, LDS_TOTAL) != hipSuccess) { fprintf(stderr, "kernel_launch: hipFuncSetAttribute failed\n"); grid = -1; return; }
        if (hipOccupancyMaxActiveBlocksPerMultiprocessor(&per_cu, (const void*)mega_fwd, 512, LDS_TOTAL) != hipSuccess || per_cu < 1) { fprintf(stderr, "kernel_launch: occupancy query says %d\n", per_cu); per_cu = 1; (void)hipGetLastError(); }
        grid = cus * per_cu; if (grid > 256) grid = 256;
        if (grid != 256) { fprintf(stderr, "kernel_launch: this kernel needs a 256-workgroup cooperative grid (got %d)\n", grid); grid = -1; return; }
    }
    if (grid < 0) return;
    Params p{};
    for (int i = 0; i < 26; ++i) p.in[i] = (const float*)d_in[i];
    p.out = (float*)d_out; p.ws = (unsigned char*)d_ws;
    if (hipMemsetAsync((unsigned char*)d_ws + WS_BAR, 0, XCD_BAR_WORDS * 4, stream) != hipSuccess) { fprintf(stderr, "kernel_launch: hipMemsetAsync failed\n"); return; }
    void* args[] = {&p};
    hipError_t e = hipLaunchCooperativeKernel((const void*)mega_fwd, dim3(grid), dim3(512), args, LDS_TOTAL, stream);
    if (e != hipSuccess) fprintf(stderr, "cooperative launch failed: %s (grid %d)\n", hipGetErrorString(e), grid);
}
```

```cpp
#include <hip/hip_runtime.h>
#include <hip/hip_cooperative_groups.h>
#include <cstdio>
#include <cstdint>
namespace cg = cooperative_groups;
namespace pg8 {
#define PG8_LAS __attribute__((address_space(3)))
typedef unsigned short bf16_t;
typedef short bf16x8 __attribute__((ext_vector_type(8)));
typedef float f32x4 __attribute__((ext_vector_type(4)));
typedef unsigned u32x4 __attribute__((ext_vector_type(4)));
constexpr int BM = 256, BK = 64, HALF = 128, HTB = HALF * BK * 2  , STAGE_BYTES = 8 * HTB, NXCD = 8, WGM = 8;

__host__ __device__ __forceinline__ int lds_byte(int r, int c) { const int st = (r >> 4) * 2 + (c >> 5), rr = r & 15, cc = c & 31, ob = rr * 64 + cc * 2; return st * 1024 + (ob ^ (((ob >> 9) & 1) << 5)); }
__host__ __device__ __forceinline__ void stage_rc(int b, int& R, int& C) { const int st = b / 1024, sb = b % 1024, swz = sb ^ (((sb >> 9) & 1) << 5); R = (st >> 1) * 16 + swz / 64; C = (st & 1) * 32 + (swz % 64) / 2; }
__host__ __device__ __forceinline__ int perm32(int rho) { const int n = rho >> 4, i = rho & 15; return 8 * (i >> 2) + 4 * n + (i & 3); }

struct Unit { int pm, pn; };
struct Gemm { const bf16_t* A; const bf16_t* Bt; int M, N, K; };

struct StaticOrder {
    int nM, nN, nwg, G, c;
    __host__ __device__ void init(int M, int N, int G_, int c_) { nM = M / BM; nN = N / BM; nwg = nM * nN; G = G_; c = c_; }
    __host__ __device__ bool next(int i, Unit& u) const {
        const long L = (long)i * G + c; if (L >= nwg) return false;
        int wgid = (int)L; { const int q = nwg / NXCD, r = nwg % NXCD, xcd = wgid % NXCD, off = wgid / NXCD; wgid = (xcd < r ? xcd * (q + 1) : r * (q + 1) + (xcd - r) * q) + off; }
        const int nig = WGM * nN, gid = wgid / nig, fm = gid * WGM, gsz = (nM - fm) < WGM ? (nM - fm) : WGM;
        u.pm = fm + ((wgid % nig) % gsz); u.pn = (wgid % nig) / gsz; return true;
    }
    __device__ __forceinline__ void a_ready(const Unit&) const {}
    __device__ __forceinline__ void done(const Unit&) const {}
};

__device__ __forceinline__ unsigned cvt_pk_bf16(float lo, float hi) { unsigned r; asm volatile("v_cvt_pk_bf16_f32 %0, %1, %2" : "=v"(r) : "v"(lo), "v"(hi)); return r; }
typedef float f32x2 __attribute__((ext_vector_type(2)));
template <int ACT> struct EpiBf16 {
    static constexpr bool PERM = true, AFTER_DRAIN = false;
    bf16_t* O; int ldc;
    __device__ __forceinline__ void operator()(const f32x4 (&acc)[2][2][4][2], const Unit& u, int wr, int wc, int fr, int fq) const {
        const int row0 = u.pm * BM + wr * 64 + fr; const int col0 = u.pn * BM + wc * 32 + 8 * fq;
#pragma unroll
        for (int ai = 0; ai < 2; ++ai)
#pragma unroll
            for (int m = 0; m < 4; ++m) { bf16_t* rowp = O + (size_t)(row0 + ai * HALF + m * 16) * ldc + col0;
#pragma unroll
                for (int bj = 0; bj < 2; ++bj) { f32x4 v0 = acc[ai][bj][m][0], v1 = acc[ai][bj][m][1];
                    if (ACT == 2) {
#pragma unroll
                        for (int e = 0; e < 4; ++e) { float a = v0[e] > 0.f ? v0[e] : 0.f; v0[e] = a * a; float b = v1[e] > 0.f ? v1[e] : 0.f; v1[e] = b * b; } }
                    u32x4 w; w.x = cvt_pk_bf16(v0[0], v0[1]); w.y = cvt_pk_bf16(v0[2], v0[3]); w.z = cvt_pk_bf16(v1[0], v1[1]); w.w = cvt_pk_bf16(v1[2], v1[3]);
                    *(u32x4*)(rowp + bj * HALF) = w; } }
    }
};
struct EpiGlu {
    static constexpr bool PERM = true, AFTER_DRAIN = false;
    bf16_t* O; int ldc;
    __device__ __forceinline__ void operator()(const f32x4 (&acc)[2][2][4][2], const Unit& u, int wr, int wc, int fr, int fq) const {
        const int row0 = u.pm * BM + wr * 64 + fr; const int col0 = u.pn * HALF + wc * 32 + 8 * fq;
#pragma unroll
        for (int ai = 0; ai < 2; ++ai)
#pragma unroll
            for (int m = 0; m < 4; ++m) { bf16_t* rowp = O + (size_t)(row0 + ai * HALF + m * 16) * ldc + col0;
                f32x4 v0 = acc[ai][0][m][0], v1 = acc[ai][0][m][1]; const f32x4 g0 = acc[ai][1][m][0], g1 = acc[ai][1][m][1];
#pragma unroll
                for (int e = 0; e < 4; ++e) { v0[e] = v0[e] / (1.f + __expf(-g0[e])); v1[e] = v1[e] / (1.f + __expf(-g1[e])); }
                u32x4 w; w.x = cvt_pk_bf16(v0[0], v0[1]); w.y = cvt_pk_bf16(v0[2], v0[3]); w.z = cvt_pk_bf16(v1[0], v1[1]); w.w = cvt_pk_bf16(v1[2], v1[3]);
                *(u32x4*)rowp = w; }
    }
};
struct PanelStats {
    unsigned* xbuf;
    unsigned* cnt;
    unsigned* tmo;
    int ntn; float eps;
    unsigned code;
    __device__ __forceinline__ bool run(const f32x4 (&v)[2][2][4][2], const Unit& u, int wr, int wc, int fr, int fq, PG8_LAS unsigned char* lds, int wid, int lane) const {
        typedef float f32x2v __attribute__((ext_vector_type(2)));
        PG8_LAS f32x2v* P = (PG8_LAS f32x2v*)lds;
        PG8_LAS f32x2v* S = (PG8_LAS f32x2v*)(lds + 8192);
        PG8_LAS unsigned* flag = (PG8_LAS unsigned*)(lds + 8192 + 2048);
#pragma unroll
        for (int ai = 0; ai < 2; ++ai)
#pragma unroll
            for (int m = 0; m < 4; ++m) {
                float s = 0.f;
#pragma unroll
                for (int bj = 0; bj < 2; ++bj)
#pragma unroll
                    for (int n = 0; n < 2; ++n) { const f32x4 x = v[ai][bj][m][n]; s += (x[0] + x[1]) + (x[2] + x[3]); }
                s += __shfl_xor(s, 16); s += __shfl_xor(s, 32);
                const float mw = s * (1.0f / 64.0f); float q = 0.f;
#pragma unroll
                for (int bj = 0; bj < 2; ++bj)
#pragma unroll
                    for (int n = 0; n < 2; ++n) { const f32x4 d = v[ai][bj][m][n] - mw; q += (d[0] * d[0] + d[1] * d[1]) + (d[2] * d[2] + d[3] * d[3]); }
                q += __shfl_xor(q, 16); q += __shfl_xor(q, 32);
                if (fq == 0) P[(ai * HALF + wr * 64 + m * 16 + fr) * 4 + wc] = (f32x2v){mw, q};
            }
        asm volatile("s_waitcnt lgkmcnt(0)" ::: "memory"); __builtin_amdgcn_s_barrier(); asm volatile("" ::: "memory");
#if defined(BROKEN_EXCHANGE_NO_WAIT)
#warning BROKEN CONTROL BUILD: the row-statistics exchange does not wait; results are wrong by design
        if (blockIdx.x >= 64) { const long long t0_ = clock64(); while (clock64() - t0_ < 60000) __builtin_amdgcn_s_sleep(8); }
#endif
        const int row = wid * 32 + (lane & 31);
        if (lane < 32) {
            const f32x2v a = P[row * 4 + 0], b = P[row * 4 + 1], c = P[row * 4 + 2], d = P[row * 4 + 3];
            const float mt = (a.x + b.x + c.x + d.x) * 0.25f;
            const float da = a.x - mt, db = b.x - mt, dc = c.x - mt, dd = d.x - mt;
            const float m2 = (a.y + b.y) + (c.y + d.y) + 64.0f * ((da * da + db * db) + (dc * dc + dd * dd));
            unsigned long long* slot = (unsigned long long*)xbuf + ((size_t)(u.pm * BM + row) * 4 + u.pn);
            __hip_atomic_store(slot, ((unsigned long long)__float_as_uint(m2) << 32) | __float_as_uint(mt), __ATOMIC_RELAXED, __HIP_MEMORY_SCOPE_AGENT);
        }
        asm volatile("s_waitcnt vmcnt(0)" ::: "memory");
        if (lane == 0) __hip_atomic_fetch_add(cnt + 64 * u.pm, 1u, __ATOMIC_RELAXED, __HIP_MEMORY_SCOPE_AGENT);
        if (wid == 0) {
            bool dead = false; const unsigned long long t0 = __builtin_amdgcn_s_memrealtime(); const unsigned want = 8u * (unsigned)ntn;
            for (;;) {
#if defined(BROKEN_EXCHANGE_NO_WAIT)
                break;
#endif
                if ((unsigned)__builtin_amdgcn_readfirstlane(__hip_atomic_load(cnt + 64 * u.pm, __ATOMIC_RELAXED, __HIP_MEMORY_SCOPE_AGENT)) >= want) break;
                if (__builtin_amdgcn_s_memrealtime() - t0 > 2000000ull) {
                    if (lane == 0) { unsigned expect = 0u; __hip_atomic_compare_exchange_strong(tmo + 1, &expect, code | (unsigned)(u.pm & 0xff), __ATOMIC_RELAXED, __ATOMIC_RELAXED, __HIP_MEMORY_SCOPE_AGENT);
                                     __hip_atomic_store(tmo, 1u, __ATOMIC_RELAXED, __HIP_MEMORY_SCOPE_AGENT); }
                    dead = true; break; }
                __builtin_amdgcn_s_sleep(2);
            }
            __builtin_amdgcn_fence(__ATOMIC_ACQUIRE, "agent");
            if (lane == 0) flag[0] = dead ? 1u : 0u;
        }
        asm volatile("s_waitcnt vmcnt(0) lgkmcnt(0)" ::: "memory"); __builtin_amdgcn_s_barrier(); asm volatile("" ::: "memory");
        const bool bad = flag[0] != 0u;
        if (lane < 32) {
            const unsigned long long* slot = (const unsigned long long*)xbuf + (size_t)(u.pm * BM + row) * 4; float mt[4], m2[4]; float ms = 0.f;
#pragma unroll
            for (int t = 0; t < 4; ++t) { if (t < ntn) { const unsigned long long w = __hip_atomic_load(slot + t, __ATOMIC_RELAXED, __HIP_MEMORY_SCOPE_AGENT); mt[t] = __uint_as_float((unsigned)w); m2[t] = __uint_as_float((unsigned)(w >> 32)); } else { mt[t] = 0.f; m2[t] = 0.f; } ms += mt[t]; }
            const float mean = ms / (float)ntn; float q = 0.f;
#pragma unroll
            for (int t = 0; t < 4; ++t) if (t < ntn) { const float dm = mt[t] - mean; q += m2[t] + 256.0f * dm * dm; }
            S[row] = (f32x2v){mean, 1.0f / sqrtf(q / (256.0f * (float)ntn) + mean * mean + eps)};
        }
        asm volatile("s_waitcnt lgkmcnt(0)" ::: "memory"); __builtin_amdgcn_s_barrier(); asm volatile("" ::: "memory");
        return bad;
    }
};

struct EpiRmsRes {
    static constexpr bool PERM = false, AFTER_DRAIN = true;
    const float* base; float* out; bf16_t* xn; int ldc; const float* gate; const float* gA; const float* gB; const float* sh; const float* sc; PanelStats st1, st2;
    __device__ __forceinline__ void fused(f32x4 (&acc)[2][2][4][2], const Unit& u, int wr, int wc, int fr, int fq, PG8_LAS unsigned char* lds, int wid, int lane) const {
        typedef float f32x2v __attribute__((ext_vector_type(2))); typedef unsigned u32x2v __attribute__((ext_vector_type(2)));
        const PG8_LAS f32x2v* S = (const PG8_LAS f32x2v*)(lds + 8192);
        const int col0 = u.pn * BM + wc * 32 + 4 * fq;
        f32x4 pre[4][2][2];
#pragma unroll
        for (int m = 0; m < 4; ++m) { const size_t off = (size_t)(u.pm * BM + wr * 64 + m * 16 + fr) * ldc + col0;
#pragma unroll
            for (int bj = 0; bj < 2; ++bj)
#pragma unroll
                for (int n = 0; n < 2; ++n) pre[m][bj][n] = *(const f32x4*)(base + off + bj * HALF + n * 16); }
        bool bad = st1.run(acc, u, wr, wc, fr, fq, lds, wid, lane);
        const float qnan = __builtin_nanf("");
#pragma unroll
        for (int ai = 0; ai < 2; ++ai)
#pragma unroll
            for (int m = 0; m < 4; ++m) { const int r = ai * HALF + wr * 64 + m * 16 + fr; const f32x2v sr = S[r]; const size_t off = (size_t)(u.pm * BM + r) * ldc + col0;
#pragma unroll
                for (int bj = 0; bj < 2; ++bj)
#pragma unroll
                    for (int n = 0; n < 2; ++n) { const int c = col0 + bj * HALF + n * 16; const f32x4 bs = ai == 0 ? pre[m][bj][n] : *(const f32x4*)(base + off + bj * HALF + n * 16);
                        const f32x4 gt = *(const f32x4*)(gate + c), ga = *(const f32x4*)(gA + c);
                        acc[ai][bj][m][n] = bs + gt * (acc[ai][bj][m][n] * sr.y * ga); }
                asm volatile("" : "+v"(acc[ai][0][m][0]), "+v"(acc[ai][0][m][1]), "+v"(acc[ai][1][m][0]), "+v"(acc[ai][1][m][1]));
                if (m & 1) asm volatile("" ::: "memory"); }
        const bool bad1 = bad;
        if (xn) bad = st2.run(acc, u, wr, wc, fr, fq, lds, wid, lane) || bad;
#pragma unroll
        for (int ai = 0; ai < 2; ++ai)
#pragma unroll
            for (int m = 0; m < 4; ++m) { const int r = ai * HALF + wr * 64 + m * 16 + fr; const f32x2v sr = S[r]; const size_t off = (size_t)(u.pm * BM + r) * ldc + col0;
#pragma unroll
                for (int bj = 0; bj < 2; ++bj)
#pragma unroll
                    for (int n = 0; n < 2; ++n) { const int c = col0 + bj * HALF + n * 16; const f32x4 x1 = acc[ai][bj][m][n];
                        *(f32x4*)(out + off + bj * HALF + n * 16) = bad1 ? (f32x4){qnan, qnan, qnan, qnan} : x1;
                        if (xn) { const f32x4 gb = *(const f32x4*)(gB + c), s1 = *(const f32x4*)(sc + c), s0 = *(const f32x4*)(sh + c);
                            const f32x4 o = (x1 * sr.y * gb) * (s1 + 1.0f) + s0; u32x2v w; w.x = cvt_pk_bf16(o[0], o[1]); w.y = cvt_pk_bf16(o[2], o[3]);
                            if (bad) { w.x = 0x7fc07fc0u; w.y = 0x7fc07fc0u; } *(u32x2v*)(xn + off + bj * HALF + n * 16) = w; } }
                asm volatile("" ::: "memory"); }
    }
};

template <class Epi, class Sched, bool ALIGN_EPI = false, bool SP2 = false>
__device__ __forceinline__ void gemm_phase(PG8_LAS unsigned char* lds, const Gemm g, const Sched& S, const Epi& E) {
    int tid_ = threadIdx.x; asm volatile("" : "+v"(tid_)); const int tid = tid_, wid = __builtin_amdgcn_readfirstlane(tid >> 6), lane = tid & 63, wr = wid >> 2, wc = wid & 3, fr = lane & 15, fq = lane >> 4;
    const int K = g.K, nt = K / BK;
    unsigned voffA[2], voffB[2];
#pragma unroll
    for (int i = 0; i < 2; ++i) { int R, C; stage_rc(tid * 16 + i * 8192, R, C); const int Rb = Epi::PERM ? ((R & ~31) + perm32(R & 31)) : R;
        voffA[i] = (unsigned)(R * K + C) * 2u; voffB[i] = (unsigned)(Rb * K + C) * 2u; }
    const size_t kstep = (size_t)(BK * 2);
    const size_t hstep = (size_t)HALF * K * 2;
    const size_t tstep = 2 * hstep;
    const unsigned ldsw = (unsigned)wid * 1024u;
    const int aoff = lds_byte(wr * 64 + fr, fq * 8), boff = lds_byte(wc * 32 + fr, fq * 8);
#define PG8_SA(b, h) (((b) * 2 + (h)) * HTB)
#define PG8_SB(b, h) ((4 + (b) * 2 + (h)) * HTB)
#define PG8_STAGE(bufoff, gbase, voff) do { _Pragma("unroll") for (int _i = 0; _i < 2; ++_i) \
        __builtin_amdgcn_global_load_lds((const unsigned*)((const char*)(gbase) + (voff)[_i]), (PG8_LAS unsigned*)(lds + (bufoff) + ldsw + _i * 8192), 16, 0, 0); } while (0)
#define PG8_LDA(dst, b, h) do { _Pragma("unroll") for (int m = 0; m < 4; ++m) _Pragma("unroll") for (int k = 0; k < 2; ++k) dst[m][k] = *(const PG8_LAS bf16x8*)(lds + PG8_SA(b, h) + aoff + m * 2048 + k * 1024); } while (0)
#define PG8_LDB(dst, b, h) do { _Pragma("unroll") for (int n = 0; n < 2; ++n) _Pragma("unroll") for (int k = 0; k < 2; ++k) dst[n][k] = *(const PG8_LAS bf16x8*)(lds + PG8_SB(b, h) + boff + n * 2048 + k * 1024); } while (0)
#define PG8_MMA(ai, bj, At, Bt) do { __builtin_amdgcn_s_setprio(1); _Pragma("unroll") for (int m = 0; m < 4; ++m) _Pragma("unroll") for (int n = 0; n < 2; ++n) _Pragma("unroll") for (int k = 0; k < 2; ++k) \
        acc[ai][bj][m][n] = __builtin_amdgcn_mfma_f32_16x16x32_bf16(Bt[n][k], At[m][k], acc[ai][bj][m][n], 0, 0, 0); __builtin_amdgcn_s_setprio(0); } while (0)
#define PG8_WAIT_V(n) asm volatile("s_waitcnt vmcnt(" #n ")" ::: "memory")
#define PG8_WAIT_L(n) asm volatile("s_waitcnt lgkmcnt(" #n ")" ::: "memory")
#define PG8_BAR __builtin_amdgcn_s_barrier()
#define PG8_SCHED __builtin_amdgcn_sched_barrier(0)
    Unit cur, nxt; int ui = 0;
    if (!S.next(0, cur)) return;
    f32x4 acc[2][2][4][2];
#pragma unroll
    for (int a = 0; a < 2; ++a)
#pragma unroll
        for (int b = 0; b < 2; ++b)
#pragma unroll
            for (int m = 0; m < 4; ++m)
#pragma unroll
                for (int n = 0; n < 2; ++n) acc[a][b][m][n] = (f32x4){0.f, 0.f, 0.f, 0.f};
    bf16x8 At[4][2], B0[2][2], B1[2][2];
    const char* cA = (const char*)g.A + (size_t)cur.pm * tstep; const char* cB = (const char*)g.Bt + (size_t)cur.pn * tstep;
    S.a_ready(cur);
    if constexpr (SP2) {
        PG8_STAGE(PG8_SB(0, 0), cB, voffB); PG8_STAGE(PG8_SB(0, 1), cB + hstep, voffB); PG8_STAGE(PG8_SA(0, 0), cA, voffA); PG8_STAGE(PG8_SA(0, 1), cA + hstep, voffA);
        if (wr == 1) PG8_BAR;
        PG8_WAIT_V(2); PG8_BAR;
        PG8_STAGE(PG8_SB(1, 0), cB + kstep, voffB); PG8_STAGE(PG8_SA(1, 0), cA + kstep, voffA); PG8_STAGE(PG8_SB(1, 1), cB + hstep + kstep, voffB);
        PG8_WAIT_V(6); PG8_BAR;
    } else {
        PG8_STAGE(PG8_SB(0, 0), cB, voffB); PG8_STAGE(PG8_SA(0, 0), cA, voffA); PG8_STAGE(PG8_SB(0, 1), cB + hstep, voffB); PG8_STAGE(PG8_SA(0, 1), cA + hstep, voffA);
        if (wr == 1) PG8_BAR;
        PG8_WAIT_V(4); PG8_BAR;
        PG8_STAGE(PG8_SB(1, 0), cB + kstep, voffB); PG8_STAGE(PG8_SA(1, 0), cA + kstep, voffA); PG8_STAGE(PG8_SB(1, 1), cB + hstep + kstep, voffB);
        PG8_WAIT_V(6); PG8_BAR;
    }
    for (;;) {
        const bool has_next = S.next(ui + 1, nxt);
        const char* nA = has_next ? (const char*)g.A + (size_t)nxt.pm * tstep : cA; const char* nB = has_next ? (const char*)g.Bt + (size_t)nxt.pn * tstep : cB;
        for (int t = 0; t < nt; t += 2) {
            const bool last = (t == nt - 2);
            const char* a1 = cA + (size_t)(t + 1) * kstep;
            const char* a2 = last ? nA : cA + (size_t)(t + 2) * kstep; const char* b2 = last ? nB : cB + (size_t)(t + 2) * kstep;
            const char* a3 = a2 + kstep; const char* b3 = b2 + kstep;
            if (last && has_next) S.a_ready(nxt);
            if constexpr (SP2) {
            PG8_LDB(B0, 0, 0); PG8_LDB(B1, 0, 1); PG8_SCHED; PG8_LDA(At, 0, 0); PG8_STAGE(PG8_SA(1, 1), a1 + hstep, voffA);
            PG8_WAIT_V(8); PG8_WAIT_L(0); PG8_BAR; PG8_MMA(0, 0, At, B0); PG8_MMA(0, 1, At, B1); PG8_BAR; PG8_SCHED;
            PG8_LDA(At, 0, 1); PG8_STAGE(PG8_SB(0, 0), b2, voffB); PG8_STAGE(PG8_SB(0, 1), b2 + hstep, voffB); PG8_STAGE(PG8_SA(0, 0), a2, voffA);
            PG8_WAIT_V(8); PG8_WAIT_L(0); PG8_BAR; PG8_MMA(1, 0, At, B0); PG8_MMA(1, 1, At, B1); PG8_BAR; PG8_SCHED;
            PG8_LDB(B0, 1, 0); PG8_LDB(B1, 1, 1); PG8_SCHED; PG8_LDA(At, 1, 0); PG8_STAGE(PG8_SA(0, 1), a2 + hstep, voffA);
            PG8_WAIT_V(8); PG8_WAIT_L(0); PG8_BAR; PG8_MMA(0, 0, At, B0); PG8_MMA(0, 1, At, B1); PG8_BAR; PG8_SCHED;
            PG8_LDA(At, 1, 1); PG8_STAGE(PG8_SB(1, 0), b3, voffB); PG8_STAGE(PG8_SB(1, 1), b3 + hstep, voffB); PG8_STAGE(PG8_SA(1, 0), a3, voffA);
            PG8_WAIT_V(8); PG8_WAIT_L(0); PG8_BAR; PG8_MMA(1, 0, At, B0); PG8_MMA(1, 1, At, B1); PG8_BAR; PG8_SCHED;
            } else {
            PG8_LDB(B0, 0, 0); PG8_SCHED; PG8_LDA(At, 0, 0); PG8_STAGE(PG8_SA(1, 1), a1 + hstep, voffA);
            PG8_WAIT_L(8); PG8_BAR; PG8_WAIT_L(0); PG8_MMA(0, 0, At, B0); PG8_BAR; PG8_SCHED;
            PG8_LDB(B1, 0, 1); PG8_STAGE(PG8_SB(0, 0), b2, voffB);
            PG8_BAR; PG8_WAIT_L(0); PG8_MMA(0, 1, At, B1); PG8_BAR;
            PG8_LDA(At, 0, 1); PG8_STAGE(PG8_SA(0, 0), a2, voffA);
            PG8_BAR; PG8_WAIT_L(0); PG8_MMA(1, 0, At, B0); PG8_BAR; PG8_SCHED;
            PG8_STAGE(PG8_SB(0, 1), b2 + hstep, voffB);
            PG8_WAIT_V(6); PG8_BAR; PG8_MMA(1, 1, At, B1); PG8_BAR;
            PG8_LDB(B0, 1, 0); PG8_SCHED; PG8_LDA(At, 1, 0); PG8_STAGE(PG8_SA(0, 1), a2 + hstep, voffA);
            PG8_WAIT_L(8); PG8_BAR; PG8_WAIT_L(0); PG8_MMA(0, 0, At, B0); PG8_BAR; PG8_SCHED;
            PG8_LDB(B1, 1, 1); PG8_STAGE(PG8_SB(1, 0), b3, voffB);
            PG8_BAR; PG8_WAIT_L(0); PG8_MMA(0, 1, At, B1); PG8_BAR;
            PG8_LDA(At, 1, 1); PG8_STAGE(PG8_SA(1, 0), a3, voffA);
            PG8_BAR; PG8_WAIT_L(0); PG8_MMA(1, 0, At, B0); PG8_BAR; PG8_SCHED;
            PG8_STAGE(PG8_SB(1, 1), b3 + hstep, voffB);
            PG8_WAIT_V(6); PG8_BAR; PG8_MMA(1, 1, At, B1); PG8_BAR;
            }
        }
        if constexpr (ALIGN_EPI) { if (wr == 0) PG8_BAR; }
        if constexpr (!Epi::AFTER_DRAIN) { E(acc, cur, wr, wc, fr, fq); S.done(cur); }
        if (!has_next) break;
#pragma unroll
        for (int a = 0; a < 2; ++a)
#pragma unroll
            for (int b = 0; b < 2; ++b)
#pragma unroll
                for (int m = 0; m < 4; ++m)
#pragma unroll
                    for (int n = 0; n < 2; ++n) acc[a][b][m][n] = (f32x4){0.f, 0.f, 0.f, 0.f};
        cur = nxt; cA = nA; cB = nB; ++ui;
        if constexpr (ALIGN_EPI) { if (wr == 1) PG8_BAR; }
    }
    PG8_WAIT_V(0);
    if constexpr (!ALIGN_EPI) { if (wr == 0) PG8_BAR; }
    PG8_BAR;
    if constexpr (Epi::AFTER_DRAIN) { E.fused(acc, cur, wr, wc, fr, fq, lds, wid, lane); S.done(cur); }
#undef PG8_SA
#undef PG8_SB
#undef PG8_STAGE
#undef PG8_LDA
#undef PG8_LDB
#undef PG8_MMA
#undef PG8_WAIT_V
#undef PG8_WAIT_L
#undef PG8_BAR
#undef PG8_SCHED
}
}
#include <hip/hip_bf16.h>
#include <cmath>
namespace attn_body {
using bf16=__hip_bfloat16;
using bf16x8=__attribute__((ext_vector_type(8)))short;
using s16x4=__attribute__((ext_vector_type(4)))short;
using f32x16=__attribute__((ext_vector_type(16)))float;
using u32x4=__attribute__((ext_vector_type(4)))unsigned;
constexpr int BATCH=1,NHEAD=16,SEQ=16384,D=64,DM=NHEAD*D,KVP=256,NKT=260;
constexpr int NW=8,QBLK=32,QB=QBLK*NW,KVBLK=64,NQB=SEQ/QB;
constexpr int ATTN_PITCH=DM, ATTN_UNIT_ROWS=QB;
__device__ __forceinline__ int crow(int r,int hi){return (r&3)+8*(r>>2)+4*hi;}
#define SBAR() __builtin_amdgcn_sched_barrier(0)
__device__ __forceinline__ void cmask(f32x16&p0,f32x16&p1,int jb,int qrel,int hi){
  const float NEG=-INFINITY; int kb=64*jb+4*hi;
  #pragma unroll
  for(int r=0;r<16;++r){int kv=kb+(r&3)+8*(r>>2); if(kv>qrel)p0[r]=NEG; if(kv+32>qrel)p1[r]=NEG;}
}

constexpr int NSLOT=3, SLOTB=8192;
constexpr int LDS_K=0, LDS_V=NSLOT*SLOTB, LDS_WS=2*NSLOT*SLOTB, LDS_OST=LDS_WS+NW*64*4, LDS_BYTES=LDS_OST+NW*4096;
constexpr float C2=0.125f*1.4426950408889634f;
__device__ __forceinline__ void glds16(const void*gsrc,unsigned lds_dst){unsigned keep;
  asm volatile("s_mov_b32 %0, m0\n\ts_mov_b32 m0, %2\n\ts_nop 0\n\tglobal_load_lds_dwordx4 %1, off\n\ts_mov_b32 m0, %0":"=&s"(keep):"v"(gsrc),"s"(lds_dst):"memory");}
__device__ __forceinline__ float max3f(float a,float b,float c){float r;asm("v_max3_f32 %0, %1, %2, %3":"=v"(r):"v"(a),"v"(b),"v"(c));return r;}
__device__ __forceinline__ float max2f(float a,float b){float r;asm("v_max_f32_e32 %0, %1, %2":"=v"(r):"v"(a),"v"(b));return r;}
__device__ __forceinline__ float fadd_s(float a,float b){float r;asm("v_add_f32_e32 %0, %1, %2":"=v"(r):"v"(a),"v"(b));return r;}
__device__ __forceinline__ float fsub_s(float a,float b){float r;asm("v_sub_f32_e32 %0, %1, %2":"=v"(r):"v"(a),"v"(b));return r;}
typedef float f32x2_t __attribute__((ext_vector_type(2))); typedef __bf16 bf16x2_t __attribute__((ext_vector_type(2)));
__device__ __forceinline__ unsigned cvtpk_s(float lo,float hi){f32x2_t v={lo,hi};bf16x2_t b=__builtin_convertvector(v,bf16x2_t);return __builtin_bit_cast(unsigned,b);}
#define WAIT_BAR(N) asm volatile("s_waitcnt vmcnt(" #N ") lgkmcnt(0)\n\ts_barrier":::"memory")

__device__ __forceinline__ void qkt(f32x16&p0,f32x16&p1,const char*Kslot,const bf16x8*qr,const f32x16&negm,int r32,int hi){
  const char*kb=Kslot+hi*1024+r32*16;
  #pragma unroll
  for(int d0=0;d0<4;++d0){
    const bf16x8 b0=*reinterpret_cast<const bf16x8*>(kb+d0*2048);
    const bf16x8 b1=*reinterpret_cast<const bf16x8*>(kb+d0*2048+512);
    if(d0==0){p0=__builtin_amdgcn_mfma_f32_32x32x16_bf16(b0,qr[0],negm,0,0,0);p1=__builtin_amdgcn_mfma_f32_32x32x16_bf16(b1,qr[0],negm,0,0,0);}
    else{p0=__builtin_amdgcn_mfma_f32_32x32x16_bf16(b0,qr[d0],p0,0,0,0);p1=__builtin_amdgcn_mfma_f32_32x32x16_bf16(b1,qr[d0],p1,0,0,0);}}
}
typedef __attribute__((address_space(3))) const char* lds_cptr;
typedef short v4i16_t __attribute__((ext_vector_type(4)));
__device__ __forceinline__ void kload8(bf16x8*kf,lds_cptr kp){
  kf[0]=*(const __attribute__((address_space(3))) bf16x8*)(kp);      kf[1]=*(const __attribute__((address_space(3))) bf16x8*)(kp+512);
  kf[2]=*(const __attribute__((address_space(3))) bf16x8*)(kp+2048); kf[3]=*(const __attribute__((address_space(3))) bf16x8*)(kp+2560);
  kf[4]=*(const __attribute__((address_space(3))) bf16x8*)(kp+4096); kf[5]=*(const __attribute__((address_space(3))) bf16x8*)(kp+4608);
  kf[6]=*(const __attribute__((address_space(3))) bf16x8*)(kp+6144); kf[7]=*(const __attribute__((address_space(3))) bf16x8*)(kp+6656);
}
__device__ __forceinline__ void kload2(bf16x8*kf,lds_cptr kp,int j){ kf[2*j]=*(const __attribute__((address_space(3))) bf16x8*)(kp+j*2048); kf[2*j+1]=*(const __attribute__((address_space(3))) bf16x8*)(kp+j*2048+512); }
__device__ __forceinline__ s16x4 vtr(lds_cptr p){ return __builtin_bit_cast(s16x4,__builtin_amdgcn_ds_read_tr16_b64_v4i16((__attribute__((address_space(3))) v4i16_t*)p)); }
__device__ __forceinline__ float rowmax(const f32x16&p0,const f32x16&p1){
  float a=max3f(p0[0],p0[1],p1[0]),b=max3f(p0[2],p0[3],p1[1]);a=max3f(a,p1[2],p1[3]);
  #pragma unroll
  for(int r=4;r<16;r+=4){a=max3f(a,p0[r],p0[r+1]);b=max3f(b,p0[r+2],p0[r+3]);a=max3f(a,p1[r],p1[r+1]);b=max3f(b,p1[r+2],p1[r+3]);}
  const float m=max2f(a,b);
  auto rr=__builtin_amdgcn_permlane32_swap(__float_as_uint(m),__float_as_uint(m),false,false);
  return max2f(__uint_as_float(rr[0]),__uint_as_float(rr[1]));
}
__device__ __forceinline__ void pv(f32x16*o,int vb,bf16x8 pa0,bf16x8 pa1,bf16x8 pa2,bf16x8 pa3){
  #pragma unroll
  for(int d0=0;d0<2;++d0){s16x4 lo[4],hi[4];
    #pragma unroll
    for(int ks=0;ks<4;++ks){
      asm volatile("ds_read_b64_tr_b16 %0,%1 offset:%c2":"=&v"(lo[ks]):"v"(vb),"i"(d0*4096+ks*1024):"memory");
      asm volatile("ds_read_b64_tr_b16 %0,%1 offset:%c2":"=&v"(hi[ks]):"v"(vb),"i"(d0*4096+ks*1024+512):"memory");}
    asm volatile("s_waitcnt lgkmcnt(0)":::"memory");SBAR();
    #define PK(k) (bf16x8){lo[k][0],lo[k][1],lo[k][2],lo[k][3],hi[k][0],hi[k][1],hi[k][2],hi[k][3]}
    o[d0]=__builtin_amdgcn_mfma_f32_32x32x16_bf16(pa0,PK(0),o[d0],0,0,0);
    o[d0]=__builtin_amdgcn_mfma_f32_32x32x16_bf16(pa1,PK(1),o[d0],0,0,0);
    o[d0]=__builtin_amdgcn_mfma_f32_32x32x16_bf16(pa2,PK(2),o[d0],0,0,0);
    o[d0]=__builtin_amdgcn_mfma_f32_32x32x16_bf16(pa3,PK(3),o[d0],0,0,0);
    #undef PK
  }
}

#ifndef ATTN_STORE16
#define ATTN_STORE16(p,v) (*(u32x4*)(p)=(v))
#endif
template<int THRL> __device__ __forceinline__ void attn_unit(int b,int h,int qb,const bf16*Q,const bf16*__restrict__ K,const bf16*__restrict__ V,bf16*O,char*shm){
  int tid_=threadIdx.x; asm volatile("":"+v"(tid_)); const int tid=tid_,lane=tid&63,r32=lane&31,hi=lane>>5; const int wid=__builtin_amdgcn_readfirstlane(tid>>6);
  const long rowbase=(long)b*SEQ; const int q0=qb*QB;
  const bf16*Qw=Q+(rowbase+q0+wid*QBLK)*DM+h*D;
  const bf16*Kh=K+(h>>2)*D,*Vh=V+(h>>2)*D;
  const unsigned lds0=(unsigned)(uintptr_t)shm;
  float*wsf=(float*)(shm+LDS_WS)+wid*64;
  const bf16*ksrc=Kh+(long)lane*KVP+wid*8;
  const bf16*vsrc=Vh+(long)(16*(wid&3)+(lane>>2))*KVP+(wid>>2)*32+(lane&3)*8;
  const unsigned kdst=lds0+LDS_K+wid*1024, vdst=lds0+LDS_V+wid*1024;
  #define DMA_K(t,slot) glds16(ksrc+(long)(t)*KVBLK*KVP,(unsigned)__builtin_amdgcn_readfirstlane(kdst+(slot)))
  #define DMA_V(t,slot) glds16(vsrc+(long)(t)*KVBLK*KVP,(unsigned)__builtin_amdgcn_readfirstlane(vdst+(slot)))
  const int vb0=(int)(lds0+LDS_V)+((lane>>4)&1)*32+(lane&3)*8+(4*hi+((lane&15)>>2))*64;
  const char*Kbase=shm+LDS_K; bf16x8 kf[8];
  const lds_cptr shm3=(lds_cptr)shm; const lds_cptr kp0=shm3+LDS_K+hi*1024+r32*16; const lds_cptr vp0=shm3+LDS_V+((lane>>4)&1)*32+(lane&3)*8+(4*hi+((lane&15)>>2))*64;
  const int NT=NKT;
  DMA_K(0,0);DMA_V(0,0);DMA_K(1,SLOTB);
  bf16x8 qr[4];
  #pragma unroll
  for(int d0=0;d0<4;++d0)qr[d0]=*reinterpret_cast<const bf16x8*>(&Qw[(long)r32*DM+d0*16+hi*8]);
  float mhat=0.f,l_reg=0.f;f32x16 o[2];o[0]=f32x16{};o[1]=f32x16{};f32x16 negm=f32x16{};asm volatile("":"+v"(negm));
  const int qrel=wid*QBLK+r32;
  #define CMASK(P0,P1,t) do{}while(0)
  bool resc=false;
  #define START(P0,P1) do{ const float rm=rowmax(P0,P1); resc=false; \
    { const float dl=rm; mhat=fadd_s(mhat,dl); \
      _Pragma("unroll") for(int r=0;r<16;++r){P0[r]=fsub_s(P0[r],dl);P1[r]=fsub_s(P1[r],dl);} \
      _Pragma("unroll") for(int r=0;r<16;++r)negm[r]=-mhat; asm volatile("":"+v"(negm)); } \
    _Pragma("unroll") for(int r=0;r<16;++r)P0[r]=__builtin_amdgcn_exp2f(P0[r]); }while(0)
  #define RESC() do{ if(resc){ asm volatile("s_waitcnt lgkmcnt(0)":::"memory"); \
      _Pragma("unroll") for(int d_=0;d_<2;++d_) _Pragma("unroll") for(int r=0;r<16;++r)o[d_][r]*=wsf[crow(r,hi)]; } }while(0)
  f32x16 pA0,pA1,pB0,pB1;
  int sl_prev=0,sl_cur=0,sl_next=SLOTB;
  #define ROT() do{sl_prev=sl_cur;sl_cur=sl_next;sl_next=(sl_next==(NSLOT-1)*SLOTB)?0:sl_next+SLOTB;}while(0)
  DMA_K(2,2*SLOTB);
  WAIT_BAR(3);
  qkt(pA0,pA1,Kbase,qr,negm,r32,hi);asm volatile("s_nop 15\n\ts_nop 7":"+v"(pA0),"+v"(pA1));CMASK(pA0,pA1,0);
  START(pA0,pA1);
  _Pragma("unroll") for(int r=0;r<16;++r)pA1[r]=__builtin_amdgcn_exp2f(pA1[r]);
  WAIT_BAR(0);
  DMA_K(3,0);DMA_V(1,SLOTB);
  ROT();
  kload8(kf,kp0+sl_cur);
  WAIT_BAR(2);
  s16x4 vlo[8],vhi[8]; u32x4 pw0,pw1,pw2,pw3;
  #define PKW(P,B) cvtpk_s(P[B],P[B+1])
  #define PAF(k) __builtin_bit_cast(bf16x8,pw##k)
  #define VFR(i) (bf16x8){vlo[i][0],vlo[i][1],vlo[i][2],vlo[i][3],vhi[i][0],vhi[i][1],vhi[i][2],vhi[i][3]}
  #define PIN(x) asm volatile("":"+v"(x))
  #define MX3(a,b,c) __builtin_fmaxf(__builtin_fmaxf((a),(b)),(c))
  #define GAPA(MF,A0,A1,A2,A3,W0,W1,PW) do{ MF; sacc+=A0; sacc+=A1; sacc+=A2; sacc+=A3; PIN(sacc); W0; W1; PIN(PW); SBAR(); }while(0)
  #define EX(v) __builtin_amdgcn_exp2f(v)
  #define GAPB(MF,X,B) do{ MF; X[B]=EX(X[B]); X[B+1]=EX(X[B+1]); X[B+2]=EX(X[B+2]); X[B+3]=EX(X[B+3]); PIN(X); SBAR(); }while(0)
  #define VRD(i) do{ vlo[i]=vtr(vp_+(((i)>>2)*4096+((i)&3)*1024)); vhi[i]=vtr(vp_+(((i)>>2)*4096+((i)&3)*1024+512)); }while(0)
  #define KRD(G,j) do{ if(G){ kload2(kf,kp0+sl_next,j); SBAR(); } }while(0)
  #define STEP(C0,C1,P0,P1,t,GK,GV,GL) do{ SBAR(); \
    const lds_cptr vp_=vp0+sl_prev; \
    VRD(0); SBAR(); float sacc=(P0[0]+P0[1]); \
    GAPA(C0=__builtin_amdgcn_mfma_f32_32x32x16_bf16(kf[0],qr[0],negm,0,0,0), P0[2],P0[3],P0[4],P0[5],     pw0[0]=PKW(P0,0), pw0[1]=PKW(P0,2), pw0); \
    VRD(4); SBAR(); GAPA(C1=__builtin_amdgcn_mfma_f32_32x32x16_bf16(kf[1],qr[0],negm,0,0,0), P0[6],P0[7],P0[8],P0[9],     pw0[2]=PKW(P0,4), pw0[3]=PKW(P0,6), pw0); \
    VRD(1); SBAR(); GAPA(C0=__builtin_amdgcn_mfma_f32_32x32x16_bf16(kf[2],qr[1],C0,0,0,0),   P0[10],P0[11],P0[12],P0[13], pw1[0]=PKW(P0,8), pw1[1]=PKW(P0,10), pw1); \
    VRD(5); SBAR(); GAPA(C1=__builtin_amdgcn_mfma_f32_32x32x16_bf16(kf[3],qr[1],C1,0,0,0),   P0[14],P0[15],P1[0],P1[1],   pw1[2]=PKW(P0,12),pw1[3]=PKW(P0,14), pw1); \
    VRD(2); SBAR(); GAPA(C0=__builtin_amdgcn_mfma_f32_32x32x16_bf16(kf[4],qr[2],C0,0,0,0),   P1[2],P1[3],P1[4],P1[5],     pw2[0]=PKW(P1,0), pw2[1]=PKW(P1,2), pw2); \
    VRD(6); SBAR(); GAPA(C1=__builtin_amdgcn_mfma_f32_32x32x16_bf16(kf[5],qr[2],C1,0,0,0),   P1[6],P1[7],P1[8],P1[9],     pw2[2]=PKW(P1,4), pw2[3]=PKW(P1,6), pw2); \
    VRD(3); SBAR(); GAPA(C0=__builtin_amdgcn_mfma_f32_32x32x16_bf16(kf[6],qr[3],C0,0,0,0),   P1[10],P1[11],P1[12],P1[13], pw3[0]=PKW(P1,8), pw3[1]=PKW(P1,10), pw3); \
    VRD(7); SBAR(); GAPA(C1=__builtin_amdgcn_mfma_f32_32x32x16_bf16(kf[7],qr[3],C1,0,0,0),   P1[14],P1[15],0.f,0.f,       pw3[2]=PKW(P1,12),pw3[3]=PKW(P1,14), pw3); \
    l_reg+=sacc; \
    if(GK){DMA_K((t)+3,sl_cur);} if(GV){DMA_V((t)+1,sl_next);} \
    CMASK(C0,C1,t); \
    { float a=MX3(C0[0],C0[1],C1[0]),b=MX3(C0[2],C0[3],C1[1]); a=MX3(a,C1[2],C1[3]); \
      _Pragma("unroll") for(int r=4;r<16;r+=4){a=MX3(a,C0[r],C0[r+1]);b=MX3(b,C0[r+2],C0[r+3]);a=MX3(a,C1[r],C1[r+1]);b=MX3(b,C1[r+2],C1[r+3]);} \
      float rm=__builtin_fmaxf(a,b); { auto rr=__builtin_amdgcn_permlane32_swap(__float_as_uint(rm),__float_as_uint(rm),false,false); rm=__builtin_fmaxf(__uint_as_float(rr[0]),__uint_as_float(rr[1])); } \
      resc=false; \
      if(__builtin_expect(__any(rm>(float)THRL),0)){ const float dl=__builtin_fmaxf(rm,0.f); mhat+=dl; \
        _Pragma("unroll") for(int r=0;r<16;++r){C0[r]-=dl;C1[r]-=dl;} \
        _Pragma("unroll") for(int r=0;r<16;++r)negm[r]=-mhat; asm volatile("":"+v"(negm)); \
        const float f=__builtin_amdgcn_exp2f(-dl); l_reg*=f; if(hi==0)wsf[r32]=f; resc=true; } } \
    SBAR(); \
    GAPB(o[0]=__builtin_amdgcn_mfma_f32_32x32x16_bf16(PAF(0),VFR(0),o[0],0,0,0), C0,0); \
    GAPB(o[1]=__builtin_amdgcn_mfma_f32_32x32x16_bf16(PAF(0),VFR(4),o[1],0,0,0), C0,4); \
    KRD(GL,0); GAPB(o[0]=__builtin_amdgcn_mfma_f32_32x32x16_bf16(PAF(1),VFR(1),o[0],0,0,0), C0,8); \
    KRD(GL,1); GAPB(o[1]=__builtin_amdgcn_mfma_f32_32x32x16_bf16(PAF(1),VFR(5),o[1],0,0,0), C0,12); \
    KRD(GL,2); GAPB(o[0]=__builtin_amdgcn_mfma_f32_32x32x16_bf16(PAF(2),VFR(2),o[0],0,0,0), C1,0); \
    KRD(GL,3); GAPB(o[1]=__builtin_amdgcn_mfma_f32_32x32x16_bf16(PAF(2),VFR(6),o[1],0,0,0), C1,4); \
    GAPB(o[0]=__builtin_amdgcn_mfma_f32_32x32x16_bf16(PAF(3),VFR(3),o[0],0,0,0), C1,8); \
    GAPB(o[1]=__builtin_amdgcn_mfma_f32_32x32x16_bf16(PAF(3),VFR(7),o[1],0,0,0), C1,12); \
    }while(0)
  int t=1;
  #undef CMASK
  #define CMASK(P0,P1,t) do{}while(0)
  asm volatile(".p2align 6\n\t.rept 8\n\ts_nop 0\n\t.endr":::"memory");
  for(;t+5<NT;t+=2){
    STEP(pB0,pB1,pA0,pA1,t,true,true,true);     WAIT_BAR(2); RESC(); ROT();
    STEP(pA0,pA1,pB0,pB1,t+1,true,true,true);   WAIT_BAR(2); RESC(); ROT();
  }
  #undef CMASK
  #define CMASK(P0,P1,t) do{}while(0)
  #define ENDW(tt) do{ if((tt)+3<NT){WAIT_BAR(2);} else if((tt)+2<NT){WAIT_BAR(1);} else {WAIT_BAR(0);} }while(0)
  for(;t+1<NT;t+=2){
    STEP(pB0,pB1,pA0,pA1,t,(t+3<NT),(t+1<NT),(t+1<NT));       ENDW(t);   RESC(); ROT();
    STEP(pA0,pA1,pB0,pB1,t+1,(t+4<NT),(t+2<NT),(t+2<NT));     ENDW(t+1); RESC(); ROT();
  }
  STEP(pB0,pB1,pA0,pA1,NT-1,false,false,false); RESC();
  { float sacc=pB0[0]+pB0[1]; _Pragma("unroll") for(int r=2;r<16;++r)sacc+=pB0[r]; _Pragma("unroll") for(int r=0;r<16;++r)sacc+=pB1[r]; l_reg+=sacc;
    pw0=(u32x4){PKW(pB0,0),PKW(pB0,2),PKW(pB0,4),PKW(pB0,6)};pw1=(u32x4){PKW(pB0,8),PKW(pB0,10),PKW(pB0,12),PKW(pB0,14)};pw2=(u32x4){PKW(pB1,0),PKW(pB1,2),PKW(pB1,4),PKW(pB1,6)};pw3=(u32x4){PKW(pB1,8),PKW(pB1,10),PKW(pB1,12),PKW(pB1,14)};
    SBAR(); pv(o,vb0+sl_cur,PAF(0),PAF(1),PAF(2),PAF(3)); }
  #undef PKW
  #undef PAF
  #undef VFR
  #undef PIN
  #undef MX3
  #undef GAPA
  #undef GAPB
  #undef EX
  #undef VRD
  #undef KRD
  #undef STEP
  #undef ENDW
  {auto rr=__builtin_amdgcn_permlane32_swap(__float_as_uint(l_reg),__float_as_uint(l_reg),false,false);l_reg=__uint_as_float(rr[0])+__uint_as_float(rr[1]);}
  if(hi==0)wsf[32+r32]=l_reg;asm volatile("s_waitcnt lgkmcnt(0)":::"memory");
  float rli[16];
  #pragma unroll
  for(int r=0;r<16;++r)rli[r]=__builtin_amdgcn_rcpf(wsf[32+crow(r,hi)]);
  bf16*Ow=O+(rowbase+q0+wid*QBLK)*DM+h*D;
  { bf16*stg=(bf16*)(shm+LDS_OST)+wid*2048;
    #pragma unroll
    for(int r=0;r<16;++r){const int orow=crow(r,hi);
      #pragma unroll
      for(int d0=0;d0<2;++d0)stg[orow*64+d0*32+r32]=__float2bfloat16(o[d0][r]*rli[r]);}
    asm volatile("s_waitcnt lgkmcnt(0)":::"memory");
    #pragma unroll
    for(int i=0;i<4;++i){const int row=i*8+(lane>>3),ch=lane&7; const u32x4 v=*(const u32x4*)(stg+row*64+ch*8); ATTN_STORE16(Ow+(long)row*DM+ch*8,v);} }
  asm volatile("s_waitcnt lgkmcnt(0)\n\ts_barrier":::"memory");
  #undef DMA_K
  #undef DMA_V
  #undef CMASK
  #undef START
  #undef RESC
  #undef ROT
}
constexpr int ATTN_LDS_BYTES=LDS_BYTES;
struct AttnTensors { const bf16* Q; const bf16* K; const bf16* V; bf16* O; };
struct AttnUnit { int bh; int qb; };
struct StaticOrder {
  int vcu;
  __device__ __forceinline__ explicit StaticOrder(int grid,int block):vcu((grid%8==0)?(block%8)*(grid/8)+block/8:block){}
  __device__ __forceinline__ bool next(int i,AttnUnit&u)const{ if(i>=4)return false; const int x=vcu>>5, c=vcu&31; const int ul=(x&1)*128+c*4+i; u.bh=(x>>1)*4+(ul>>6); u.qb=ul&63; return true; }
  __device__ __forceinline__ void a_ready(const AttnUnit&)const{}
  __device__ __forceinline__ void done(const AttnUnit&)const{}
};
template<class Sched,int THRL=8> __device__ __forceinline__ void attn_phase(char*lds,const AttnTensors&T,const Sched&S){
  AttnUnit u;
  for(int i=0;S.next(i,u);++i){ S.a_ready(u); attn_unit<THRL>(u.bh/NHEAD,u.bh%NHEAD,u.qb,T.Q,T.K,T.V,T.O,lds); S.done(u); }
}
#undef SBAR
#undef WAIT_BAR
}
typedef unsigned short bf16;
typedef float f32x4 __attribute__((ext_vector_type(4)));
typedef float f32x2 __attribute__((ext_vector_type(2)));
typedef unsigned u32x4 __attribute__((ext_vector_type(4)));
typedef unsigned u32x2 __attribute__((ext_vector_type(2)));
#define LAS3 __attribute__((address_space(3)))

constexpr int T = 16640, NCTX = 256, NLAT = 16384, DM = 1024, FF = 4096, NQKV = 1536;
constexpr float EPS = 1e-6f;
constexpr size_t MiB = 1u << 20;
constexpr size_t WS_MOD = 0, WS_S5A = 128 * 1024, WS_S5BB = 256 * 1024, WS_ROPE = 768 * 1024;
constexpr size_t WS_WIN = 2 * MiB, WS_WGLU = 4 * MiB, WS_WOUT = 5 * MiB, WS_W1_0 = 7 * MiB, WS_W2_0 = 15 * MiB, WS_WQKV = 23 * MiB, WS_WAO = 26 * MiB, WS_W1_1 = 28 * MiB, WS_W2_1 = 36 * MiB;
constexpr size_t WS_XC = 44 * MiB, WS_H = 45 * MiB, WS_Y = 78 * MiB, WS_BIG = 111 * MiB;
constexpr size_t WS_U = WS_BIG, WS_G = 144 * MiB, WS_Z = 161 * MiB, WS_S5E = 194 * MiB, WS_S5H = 203 * MiB;
constexpr size_t WS_O = WS_BIG;
constexpr size_t WS_QKV = WS_BIG, WS_Q = 160 * MiB, WS_K = 193 * MiB, WS_V = 202 * MiB;
constexpr size_t WS_AP = 1 * MiB;
constexpr size_t WS_KS = 194 * MiB, WS_CA = 198 * MiB, WS_BA = 202 * MiB;
constexpr size_t OUT_E = 0, OUT_HIN = 40 * MiB;
constexpr int NC16 = 1040;
constexpr size_t WS_MODP = 243 * MiB;
constexpr size_t WS_CTL = 0x1C0000;
constexpr size_t WS_XB = 242 * MiB;
constexpr size_t WS_END = 246 * MiB;
constexpr int LDS_TOTAL = 143360 + 64;
constexpr size_t WS_BAR = 0x1F0000;
constexpr int NCH = 260;

struct Params { const float* in[26]; float* out; unsigned char* ws; };
typedef const __attribute__((address_space(4))) Params* KP;

__device__ __forceinline__ float wave_sum(float v) {
#pragma unroll
    for (int o = 1; o < 64; o <<= 1) v += __shfl_xor(v, o);
    return v;
}
__device__ __forceinline__ float siluf(float x) { return x / (1.f + __expf(-x)); }
__device__ __forceinline__ unsigned f2bf(float f) { unsigned u = __float_as_uint(f); return (u + 0x7fffu + ((u >> 16) & 1u)) >> 16; }
__device__ __forceinline__ unsigned pk2(float lo, float hi) { return f2bf(lo) | (f2bf(hi) << 16); }
__device__ __forceinline__ float bflo(unsigned w) { return __uint_as_float(w << 16); }
__device__ __forceinline__ float bfhi(unsigned w) { return __uint_as_float(w & 0xffff0000u); }
__device__ __forceinline__ float gelu_tanh(float x) { const float a = 0.7978845608028654f * (x + 0.044715f * x * x * x); const float th = 1.f - 2.f / (1.f + __expf(2.f * a)); return 0.5f * x * (1.f + th); }

__device__ __forceinline__ void tr_item(const float* W, int ldw, bf16* WT, int ldt, float* scr, int lane) {
#pragma unroll 16
    for (int i = 0; i < 32; ++i) { const int kk = 2 * i + (lane >> 5); scr[kk * 33 + (lane & 31)] = __builtin_nontemporal_load(W + (size_t)kk * ldw + (lane & 31)); }
    __builtin_amdgcn_wave_barrier();
    const int c = lane & 7;
#pragma unroll
    for (int j = 0; j < 4; ++j) { const int n = (lane >> 3) + 8 * j; const float* s = scr + (8 * c) * 33 + n;
        u32x4 o; o.x = pk2(s[0 * 33], s[1 * 33]); o.y = pk2(s[2 * 33], s[3 * 33]); o.z = pk2(s[4 * 33], s[5 * 33]); o.w = pk2(s[6 * 33], s[7 * 33]);
        *(u32x4*)(WT + (size_t)n * ldt + 8 * c) = o; }
    __builtin_amdgcn_wave_barrier();
}

__device__ __forceinline__ void tr_one(KP p, int it, float* scr, int lane) {
    constexpr int I_IN = 512, I_GLU = 256, I_OUT = 256, I_W1 = 2048, I_W2 = 2048, I_QKV = 768, I_AO = 512;
    int r = it; const float* W; int N, ldt; bf16* WT; bool glu = false;
    if (r < I_IN) { W = p->in[9]; N = 1024; ldt = 1024; WT = (bf16*)(p->ws + WS_WIN); }
    else if ((r -= I_IN) < I_GLU) { W = p->in[19]; N = 1024; ldt = 512; WT = (bf16*)(p->ws + WS_WGLU); glu = true; }
    else if ((r -= I_GLU) < I_OUT) { W = p->in[10]; N = 1024; ldt = 1024; WT = (bf16*)(p->ws + WS_WOUT); }
    else if ((r -= I_OUT) < I_W1) { W = p->in[7]; N = 4096; ldt = 1024; WT = (bf16*)(p->ws + WS_W1_0); }
    else if ((r -= I_W1) < I_W2) { W = p->in[8]; N = 1024; ldt = 4096; WT = (bf16*)(p->ws + WS_W2_0); }
    else if ((r -= I_W2) < I_QKV) { W = p->in[22]; N = 1536; ldt = 1024; WT = (bf16*)(p->ws + WS_WQKV); }
    else if ((r -= I_QKV) < I_AO) { W = p->in[23]; N = 1024; ldt = 1024; WT = (bf16*)(p->ws + WS_WAO); }
    else if ((r -= I_AO) < I_W1) { W = p->in[7] + (size_t)1024 * 4096; N = 4096; ldt = 1024; WT = (bf16*)(p->ws + WS_W1_1); }
    else { r -= I_W1; W = p->in[8] + (size_t)4096 * 1024; N = 1024; ldt = 4096; WT = (bf16*)(p->ws + WS_W2_1); }
    const int nblk = N / 32, kb = r / nblk, nb = r % nblk, k0 = 64 * kb, n0 = 32 * nb;
    int drow = n0;
    if (glu) { const int bj = n0 >> 9, rem = n0 & 511; drow = 256 * (rem >> 7) + 128 * bj + (rem & 127); }
    tr_item(W + (size_t)k0 * N + n0, N, WT + (size_t)drow * ldt + k0, ldt, scr, lane);
}
__device__ __forceinline__ void prologue(KP p, unsigned char* lds, int tid, int lane, int wave) {
    float* misc = (float*)(lds + 131072);
    { const float* c = p->in[1]; const float* cc = p->in[3];
      for (int i = tid; i < 1024; i += 512) { misc[i] = siluf(c[i]); misc[1024 + i] = siluf(cc[i]); } }
    __syncthreads();
    float* modv = (float*)(p->ws + WS_MOD);
    float* scr = (float*)(lds + wave * 16384);
    const int gw = blockIdx.x * 8 + wave, NGW = gridDim.x * 8, half = NGW >> 1;
    constexpr int NITEMS = 512 + 256 + 256 + 2 * (2048 + 2048) + 768 + 512;
    const int TRA = 4608;
    if (gw < half) {
        for (int wi = gw; wi < 1024; wi += half) {
            const int id = wi * 64 + lane, n = id & 1023, ib = (id >> 10) & 15, gi = id >> 14;
            const float* pw = p->in[20] + (size_t)gi * 16384 + (size_t)(ib * 8) * 128;
            const float* sc = p->in[21] + gi * 128;
            const float* wo = p->in[10] + (size_t)(512 + gi * 128) * 1024 + n;
            float acc[8];
#pragma unroll
            for (int e = 0; e < 8; ++e) acc[e] = 0.f;
#pragma unroll 8
            for (int j = 0; j < 128; ++j) { const float wv = wo[(size_t)j * 1024] * sc[j];
#pragma unroll
                for (int e = 0; e < 8; ++e) acc[e] += pw[e * 128 + j] * wv; }
            u32x4 o; o.x = pk2(acc[0], acc[1]); o.y = pk2(acc[2], acc[3]); o.z = pk2(acc[4], acc[5]); o.w = pk2(acc[6], acc[7]);
            *(u32x4*)((bf16*)(p->ws + WS_WOUT) + (size_t)n * 1024 + 512 + gi * 128 + ib * 8) = o;
        }
        for (int it = gw; it < TRA; it += half) tr_one(p, it, scr, lane);
    } else {
        const int gb = gw - half;
        for (int it = gb; it < 2 * 96 * 8; it += half) {
            const int l = it / 768, r = it % 768, cb = r >> 3, kq = r & 7;
            const float* w = p->in[4] + (size_t)l * 1024 * 6144 + cb * 64 + lane;
            float a0 = 0.f, a1 = 0.f;
#pragma unroll 32
            for (int k = kq * 128; k < kq * 128 + 128; ++k) { const float wv = __builtin_nontemporal_load(w + (size_t)k * 6144); a0 += misc[k] * wv; a1 += misc[1024 + k] * wv; }
            float* mp = (float*)(p->ws + WS_MODP) + (size_t)((l * 8 + kq) * 2) * 6144 + cb * 64 + lane; mp[0] = a0; mp[6144] = a1;
        }
        for (int it = TRA + gb; it < NITEMS; it += half) tr_one(p, it, scr, lane);
    }
    const int gt = blockIdx.x * 512 + tid, NTH = gridDim.x * 512;
    for (int id = gt; id < 4096; id += NTH) {
        const float lr = p->in[11][id], li = p->in[12][id], dt = __expf(p->in[13][id >> 6]);
        const float mag = expf(lr * dt), ar = mag * cosf(li * dt), ai = mag * sinf(li * dt);
        const float den = lr * lr + li * li;
        const float fr = ((ar - 1.f) * lr + ai * li) / den, fi = (ai * lr - (ar - 1.f) * li) / den;
        float* A = (float*)(p->ws + WS_S5A); A[2 * id] = ar; A[2 * id + 1] = ai;
        float* BB = (float*)(p->ws + WS_S5BB) + (size_t)id * 32;
        const float* br = p->in[14] + (size_t)id * 16; const float* bi = p->in[15] + (size_t)id * 16;
#pragma unroll
        for (int c = 0; c < 16; ++c) { const float x = br[c], y = bi[c]; BB[c] = fr * x - fi * y; BB[16 + c] = fr * y + fi * x; }
        const int pos = id >> 4, fq = id & 15;
        const float inv = powf(10000.f, -(float)fq / 16.f), ang = (float)pos * inv;
        float* R = (float*)(p->ws + WS_ROPE); R[2 * id] = cosf(ang); R[2 * id + 1] = sinf(ang);
    }
    for (int id = gt; id < 64 * 17 * 64; id += NTH) {
        const int pp = id & 63, d = (id >> 6) % 17, dg = id / (64 * 17);
        const float lr = p->in[11][dg * 64 + pp], li = p->in[12][dg * 64 + pp], e = (float)d * expf(p->in[13][dg]);
        const float mag = expf(lr * e), ang = li * e;
        ((f32x2*)(p->ws + WS_AP))[id] = (f32x2){mag * cosf(ang), mag * sinf(ang)};
    }
}

struct RowP { const float* xlat; const float* xctx; float* olat; float* octx; const bf16* Y; const float* gA; const float* gate;
              const float* gB; const float* shsc; bf16* H; int r0; int r1; int xb_in; int xb_out; };
struct RowRegs { f32x4 v[4]; u32x2 y[4]; };
__device__ __forceinline__ void row_load(RowRegs& R, const RowP& a, int r, int lane) {
    const bool isctx = r < NCTX;
    const float* xs = isctx ? a.xctx + (size_t)r * DM : a.xlat + (size_t)(r - NCTX) * DM;
    if (!isctx && a.xb_in) {
#pragma unroll
        for (int j = 0; j < 4; ++j) { const u32x2 w = ((const u32x2*)xs)[lane + 64 * j]; R.v[j] = (f32x4){bflo(w.x), bfhi(w.x), bflo(w.y), bfhi(w.y)}; }
    } else if (!isctx) {
#pragma unroll
        for (int j = 0; j < 4; ++j) R.v[j] = __builtin_nontemporal_load((const f32x4*)xs + lane + 64 * j);
    } else {
#pragma unroll
        for (int j = 0; j < 4; ++j) R.v[j] = ((const f32x4*)xs)[lane + 64 * j];
    }
    if (a.Y) {
#pragma unroll
        for (int j = 0; j < 4; ++j) R.y[j] = ((const u32x2*)(a.Y + (size_t)r * DM))[lane + 64 * j];
    }
}
__device__ __forceinline__ void row_finish(RowRegs& R, const RowP& a, int r, int lane) {
    const bool isctx = r < NCTX; const int vo = isctx ? 6144 : 0;
    f32x4 v[4];
#pragma unroll
    for (int j = 0; j < 4; ++j) v[j] = R.v[j];
    if (a.Y) {
        f32x4 y[4]; float ss = 0.f;
#pragma unroll
        for (int j = 0; j < 4; ++j) { const u32x2 w = R.y[j]; y[j] = (f32x4){bflo(w.x), bfhi(w.x), bflo(w.y), bfhi(w.y)};
            ss += (y[j].x * y[j].x + y[j].y * y[j].y) + (y[j].z * y[j].z + y[j].w * y[j].w); }
        const float rstd = rsqrtf(wave_sum(ss) * (1.f / DM) + EPS);
#pragma unroll
        for (int j = 0; j < 4; ++j) { const f32x4 g = ((const f32x4*)a.gA)[lane + 64 * j], gt = ((const f32x4*)(a.gate + vo))[lane + 64 * j];
            v[j] = v[j] + gt * (y[j] * rstd * g); }
    }
    if (isctx) { if (a.Y && a.octx) { float* xo = a.octx + (size_t)r * DM;
#pragma unroll
            for (int j = 0; j < 4; ++j) ((f32x4*)xo)[lane + 64 * j] = v[j]; } }
    else if (a.olat) { float* xo = a.olat + (size_t)(r - NCTX) * DM;
        if (a.xb_out) {
#pragma unroll
            for (int j = 0; j < 4; ++j) { u32x2 o; o.x = pk2(v[j].x, v[j].y); o.y = pk2(v[j].z, v[j].w); ((u32x2*)xo)[lane + 64 * j] = o; }
        } else {
#pragma unroll
            for (int j = 0; j < 4; ++j) ((f32x4*)xo)[lane + 64 * j] = v[j];
        } }
    if (a.H) {
        float ss = 0.f;
#pragma unroll
        for (int j = 0; j < 4; ++j) ss += (v[j].x * v[j].x + v[j].y * v[j].y) + (v[j].z * v[j].z + v[j].w * v[j].w);
        const float rstd = rsqrtf(wave_sum(ss) * (1.f / DM) + EPS);
#pragma unroll
        for (int j = 0; j < 4; ++j) { const f32x4 g = ((const f32x4*)a.gB)[lane + 64 * j], sh = ((const f32x4*)(a.shsc + vo))[lane + 64 * j], sc = ((const f32x4*)(a.shsc + vo + 1024))[lane + 64 * j];
            const f32x4 h = (v[j] * rstd * g) * (sc + 1.f) + sh;
            u32x2 o; o.x = pk2(h.x, h.y); o.y = pk2(h.z, h.w); ((u32x2*)(a.H + (size_t)r * DM))[lane + 64 * j] = o; }
    }
}
__device__ __forceinline__ void row_phase(const RowP& a, int lane, int wave) {
    const int gw = blockIdx.x * 8 + wave, NGW = gridDim.x * 8;
    for (int r = a.r0 + gw; r < a.r1; r += 3 * NGW) {
        const int r2 = r + NGW, r3 = r + 2 * NGW; RowRegs A, B, C;
        row_load(A, a, r, lane);
        if (r2 < a.r1) row_load(B, a, r2, lane);
        if (r3 < a.r1) row_load(C, a, r3, lane);
        row_finish(A, a, r, lane);
        if (r2 < a.r1) row_finish(B, a, r2, lane);
        if (r3 < a.r1) row_finish(C, a, r3, lane);
    }
}

__device__ __forceinline__ int s5_row(int dir, int j, int sl) { const int s = j * 64 + sl; return dir == 0 ? s : (j < 4 ? 255 - s : 16895 - s); }
__device__ __forceinline__ void s5_stage_u(const bf16* U, int row, int g, float* ut, int lane) {
    const u32x4* src = (const u32x4*)(U + (size_t)row * DM + g * 16);
    const u32x4 a = src[0], b = src[1];
    f32x4* d = (f32x4*)(ut + lane * 16);
    d[0] = (f32x4){bflo(a.x), bfhi(a.x), bflo(a.y), bfhi(a.y)}; d[1] = (f32x4){bflo(a.z), bfhi(a.z), bflo(a.w), bfhi(a.w)};
    d[2] = (f32x4){bflo(b.x), bfhi(b.x), bflo(b.y), bfhi(b.y)}; d[3] = (f32x4){bflo(b.z), bfhi(b.z), bflo(b.w), bfhi(b.w)};
}
#define S5_LOAD_BB(dir, g) do { const f32x4* bp_ = (const f32x4*)((const float*)(p->ws + WS_S5BB) + (size_t)(((dir) * 32 + (g)) * 64 + lane) * 32); \
    _Pragma("unroll") for (int q_ = 0; q_ < 4; ++q_) { const f32x4 t_ = bp_[q_]; bbr[4 * q_] = t_.x; bbr[4 * q_ + 1] = t_.y; bbr[4 * q_ + 2] = t_.z; bbr[4 * q_ + 3] = t_.w; } \
    _Pragma("unroll") for (int q_ = 0; q_ < 4; ++q_) { const f32x4 t_ = bp_[4 + q_]; bbi[4 * q_] = t_.x; bbi[4 * q_ + 1] = t_.y; bbi[4 * q_ + 2] = t_.z; bbi[4 * q_ + 3] = t_.w; } } while (0)
#define S5_STEP(utrow) do { const f32x4* up_ = (const f32x4*)(utrow); float bur_ = 0.f, bui_ = 0.f; \
    _Pragma("unroll") for (int q_ = 0; q_ < 4; ++q_) { const f32x4 u_ = up_[q_]; \
        bur_ += bbr[4 * q_] * u_.x + bbr[4 * q_ + 1] * u_.y + bbr[4 * q_ + 2] * u_.z + bbr[4 * q_ + 3] * u_.w; \
        bui_ += bbi[4 * q_] * u_.x + bbi[4 * q_ + 1] * u_.y + bbi[4 * q_ + 2] * u_.z + bbi[4 * q_ + 3] * u_.w; } \
    const float nr_ = ar * hr - ai * hi + bur_, ni_ = ar * hi + ai * hr + bui_; hr = nr_; hi = ni_; } while (0)

__device__ __forceinline__ void pool_s5a_phase(KP p, int lane, int wave, int b0, int nb) {
    const bf16* U = (const bf16*)(p->ws + WS_U); bf16* Z = (bf16*)(p->ws + WS_Z);
    const int gw = ((int)blockIdx.x - b0) * 8 + wave, NGW = nb * 8;
    for (int it = gw; it < 4 * (T / 4); it += NGW) {
        const int gi = it / (T / 4), r = 4 * (it % (T / 4)) + (lane >> 4), col = 512 + gi * 128 + (lane & 15) * 8;
        const int w = 2 << gi, lo = w >> 1, hi = w - 1 - lo;
        const int s0 = r < NCTX ? 0 : NCTX, s1 = r < NCTX ? NCTX : T;
        const int st = (r - lo) < s0 ? s0 : (r - lo), en = (r + hi + 1) > s1 ? s1 : (r + hi + 1);
        float acc[8];
#pragma unroll
        for (int e = 0; e < 8; ++e) acc[e] = 0.f;
#define POOL_ACC(W) { u32x4 xv[W]; _Pragma("unroll") for (int q = 0; q < W; ++q) { int rr = r - (W / 2) + q; rr = rr < st ? st : (rr >= en ? en - 1 : rr); xv[q] = *(const u32x4*)(U + (size_t)rr * DM + col); } \
        _Pragma("unroll") for (int q = 0; q < W; ++q) { const int rr = r - (W / 2) + q; const float m_ = (rr >= st && rr < en) ? 1.f : 0.f; const u32x4 x = xv[q]; \
            acc[0] += m_ * bflo(x.x); acc[1] += m_ * bfhi(x.x); acc[2] += m_ * bflo(x.y); acc[3] += m_ * bfhi(x.y); acc[4] += m_ * bflo(x.z); acc[5] += m_ * bfhi(x.z); acc[6] += m_ * bflo(x.w); acc[7] += m_ * bfhi(x.w); } }
        if (gi == 0) POOL_ACC(2) else if (gi == 1) POOL_ACC(4) else if (gi == 2) POOL_ACC(8) else POOL_ACC(16)
#undef POOL_ACC
        const u32x4 x = *(const u32x4*)(U + (size_t)r * DM + col);
        const float ic = 1.f / (float)(en - st);
        u32x4 o; o.x = pk2(acc[0] * ic - bflo(x.x), acc[1] * ic - bfhi(x.x)); o.y = pk2(acc[2] * ic - bflo(x.y), acc[3] * ic - bfhi(x.y));
        o.z = pk2(acc[4] * ic - bflo(x.z), acc[5] * ic - bfhi(x.z)); o.w = pk2(acc[6] * ic - bflo(x.w), acc[7] * ic - bfhi(x.w));
        *(u32x4*)(Z + (size_t)r * DM + col) = o;
    }
}
typedef short bf16x8v __attribute__((ext_vector_type(8)));
typedef float f32x16v __attribute__((ext_vector_type(16)));
__device__ __forceinline__ int crow16(int r, int hi) { return (r & 3) + 8 * (r >> 2) + 4 * hi; }
__device__ __forceinline__ size_t frag_idx(int n, int k, int KSN) { return ((size_t)(((n >> 5) * KSN + (k >> 4)) * 64 + ((k >> 3) & 1) * 32 + (n & 31))) * 8 + (k & 7); }
__device__ __forceinline__ void s5_build(KP p, int tid, int part, int b0, int nb) {
    const float* BBt = (const float*)(p->ws + WS_S5BB); const f32x2* AP = (const f32x2*)(p->ws + WS_AP);
    const int gt = ((int)blockIdx.x - b0) * 512 + tid, NTH = nb * 512;
    bf16* KS = (bf16*)(p->ws + WS_KS); bf16* CA = (bf16*)(p->ws + WS_CA); bf16* BA = (bf16*)(p->ws + WS_BA);
    if (part == 1) for (int id = gt; id < 32 * 16 * 256; id += NTH) {
        const int cp = id & 15, c = (id >> 4) & 15, d = (id >> 8) & 15, g = id >> 12;
        float L[2];
#pragma unroll
        for (int dir = 0; dir < 2; ++dir) { const int dg = dir * 32 + g; float acc = 0.f;
            const float* crp = p->in[16] + (size_t)(dg * 16 + c) * 64; const float* cip = p->in[17] + (size_t)(dg * 16 + c) * 64;
#pragma unroll 8
            for (int q = 0; q < 64; ++q) { const f32x2 P = AP[(dg * 17 + d) * 64 + q]; const float Cr = crp[q], Ci = cip[q];
                const float Br = BBt[(size_t)(dg * 64 + q) * 32 + cp], Bi = BBt[(size_t)(dg * 64 + q) * 32 + 16 + cp];
                const float wr = Cr * P.x - Ci * P.y, wi = Cr * P.y + Ci * P.x; acc += wr * Br - wi * Bi; }
            L[dir] = acc; }
        bf16* Kg = KS + (size_t)g * 65536;
        if (d == 0) { const float v = L[0] + L[1] + (c == cp ? p->in[18][g * 16 + c] : 0.f); const bf16 b = (bf16)f2bf(v);
            for (int i = 0; i < 16; ++i) Kg[frag_idx(i * 16 + c, i * 16 + cp, 16)] = b; }
        else { const bf16 bf = (bf16)f2bf(L[0]), br = (bf16)f2bf(L[1]);
            for (int i = 0; i + d < 16; ++i) { Kg[frag_idx((i + d) * 16 + c, i * 16 + cp, 16)] = bf; Kg[frag_idx(i * 16 + c, (i + d) * 16 + cp, 16)] = br; } }
    }
    if (part == 1) for (int id = gt; id < 64 * 256 * 64; id += NTH) {
        const int q = id & 63, n = (id >> 6) & 255, dg = id >> 14, t = n >> 4, c = n & 15, e = (dg < 32) ? t + 1 : 16 - t;
        const f32x2 P = AP[(dg * 17 + e) * 64 + q]; const float Cr = p->in[16][(size_t)(dg * 16 + c) * 64 + q], Ci = p->in[17][(size_t)(dg * 16 + c) * 64 + q];
        CA[(size_t)dg * 32768 + frag_idx(n, q, 8)] = (bf16)f2bf(Cr * P.x - Ci * P.y); CA[(size_t)dg * 32768 + frag_idx(n, 64 + q, 8)] = (bf16)f2bf(-(Cr * P.y + Ci * P.x));
    }
    if (part == 0) for (int id = gt; id < 64 * 64 * 256; id += NTH) {
        const int kk = id & 255, q = (id >> 8) & 63, dg = id >> 14, sdx = kk >> 4, cp = kk & 15, e = (dg < 32) ? 15 - sdx : sdx;
        const f32x2 P = AP[(dg * 17 + e) * 64 + q]; const float Br = BBt[(size_t)(dg * 64 + q) * 32 + cp], Bi = BBt[(size_t)(dg * 64 + q) * 32 + 16 + cp];
        BA[(size_t)dg * 32768 + frag_idx(q, kk, 16)] = (bf16)f2bf(P.x * Br - P.y * Bi); BA[(size_t)dg * 32768 + frag_idx(64 + q, kk, 16)] = (bf16)f2bf(P.x * Bi + P.y * Br);
    }
}
template <int NTL> __device__ __forceinline__ void s5_end_unit(KP p, int ct, int dir, int g, int nt0, int lane) {
    const bf16* U = (const bf16*)(p->ws + WS_U); const bf16* BA = (const bf16*)(p->ws + WS_BA); float* E = (float*)(p->ws + WS_Y);
    const int m = lane & 31, half = lane >> 5; const int chunk = (32 * ct + m) < NC16 ? (32 * ct + m) : NC16 - 1;
    const bf16* up = U + (size_t)(16 * chunk) * DM + 16 * g + 8 * half;
    const bf16* bp = BA + (size_t)(dir * 32 + g) * 32768 + (size_t)lane * 8;
    f32x16v acc[NTL];
#pragma unroll
    for (int nt = 0; nt < NTL; ++nt) acc[nt] = (f32x16v){};
#pragma unroll 8
    for (int ks = 0; ks < 16; ++ks) { const bf16x8v a = *(const bf16x8v*)(up + (size_t)ks * DM);
#pragma unroll
        for (int nt = 0; nt < NTL; ++nt) { const bf16x8v b = *(const bf16x8v*)(bp + (size_t)(((nt0 + nt) * 16 + ks) * 64) * 8);
            acc[nt] = __builtin_amdgcn_mfma_f32_32x32x16_bf16(a, b, acc[nt], 0, 0, 0); } }
#pragma unroll
    for (int nt = 0; nt < NTL; ++nt)
#pragma unroll
        for (int r = 0; r < 16; ++r) { const int ch = 32 * ct + crow16(r, half); if (ch < NC16) E[(size_t)((dir * NC16 + ch) * 32 + g) * 128 + 32 * (nt0 + nt) + m] = acc[nt][r]; }
}
__device__ __forceinline__ void s5_end_phase(KP p, int lane, int wave) {
    const int gw = blockIdx.x * 8 + wave, NGW = gridDim.x * 8;
    for (int unit = gw; unit < 32 * 64; unit += NGW) s5_end_unit<4>(p, unit >> 6, (unit >> 5) & 1, unit & 31, 0, lane);
    if (wave == 0) for (int tu = blockIdx.x; tu < 256; tu += gridDim.x) s5_end_unit<1>(p, 32, (tu >> 5) & 1, tu & 31, tu >> 6, lane);
}
__device__ __forceinline__ void s5_carry_phase(KP p, unsigned char* lds, int lane, int wave) {
    const float* E = (const float*)(p->ws + WS_Y); bf16* Hin = (bf16*)(p->ws + WS_H);
    float* seg = (float*)lds;
    for (int dg = blockIdx.x; dg < 64; dg += gridDim.x) {
        const int dir = dg >> 5, g = dg & 31;
        const f32x2 A16 = ((const f32x2*)(p->ws + WS_AP))[(dg * 17 + 16) * 64 + lane];
        float hr = 0.f, hi = 0.f;
        for (int jb = 0; jb < 130; jb += 26) { float er[26], ei[26];
#pragma unroll
            for (int q = 0; q < 26; ++q) { const int j = 130 * wave + jb + q, rc = dir == 0 ? j : (j < 16 ? 15 - j : 1055 - j); const float* ep = E + (size_t)((dir * NC16 + rc) * 32 + g) * 128; er[q] = ep[lane]; ei[q] = ep[64 + lane]; }
#pragma unroll
            for (int q = 0; q < 26; ++q) { const float nr = A16.x * hr - A16.y * hi + er[q], ni = A16.x * hi + A16.y * hr + ei[q]; hr = nr; hi = ni; } }
        seg[wave * 128 + lane] = hr; seg[wave * 128 + 64 + lane] = hi;
        float pr = 1.f, pi = 0.f;
        for (int q = 0; q < 130; ++q) { const float nr = pr * A16.x - pi * A16.y, ni = pr * A16.y + pi * A16.x; pr = nr; pi = ni; }
        __syncthreads();
        hr = 0.f; hi = 0.f;
        for (int w = 0; w < wave; ++w) { const float sr = seg[w * 128 + lane], si = seg[w * 128 + 64 + lane]; const float nr = pr * hr - pi * hi + sr, ni = pr * hi + pi * hr + si; hr = nr; hi = ni; }
        for (int jb = 0; jb < 130; jb += 26) { float er[26], ei[26];
#pragma unroll
            for (int q = 0; q < 26; ++q) { const int j = 130 * wave + jb + q, rc = dir == 0 ? j : (j < 16 ? 15 - j : 1055 - j); const float* ep = E + (size_t)((dir * NC16 + rc) * 32 + g) * 128; er[q] = ep[lane]; ei[q] = ep[64 + lane]; }
#pragma unroll
            for (int q = 0; q < 26; ++q) { const int j = 130 * wave + jb + q, rc = dir == 0 ? j : (j < 16 ? 15 - j : 1055 - j); bf16* hp = Hin + (size_t)(dg * NC16 + rc) * 128;
                hp[lane] = (bf16)f2bf(hr); hp[64 + lane] = (bf16)f2bf(hi);
                const float nr = A16.x * hr - A16.y * hi + er[q], ni = A16.x * hi + A16.y * hr + ei[q]; hr = nr; hi = ni; } }
        __syncthreads();
    }
}
template <int NTL> __device__ __forceinline__ void s5_out_unit(KP p, int ct, int g, int nt0, int lane) {
    const bf16* U = (const bf16*)(p->ws + WS_U); const bf16* KS = (const bf16*)(p->ws + WS_KS); const bf16* CA = (const bf16*)(p->ws + WS_CA);
    const bf16* Hin = (const bf16*)(p->ws + WS_H); bf16* G = (bf16*)(p->ws + WS_G);
    const int m = lane & 31, half = lane >> 5; const int chunk = (32 * ct + m) < NC16 ? (32 * ct + m) : NC16 - 1;
    const bf16* up = U + (size_t)(16 * chunk) * DM + 16 * g + 8 * half;
    const bf16* kp = KS + (size_t)g * 65536 + (size_t)lane * 8;
    f32x16v acc[NTL];
#pragma unroll
    for (int nt = 0; nt < NTL; ++nt) acc[nt] = (f32x16v){};
#pragma unroll 8
    for (int ks = 0; ks < 16; ++ks) { const bf16x8v a = *(const bf16x8v*)(up + (size_t)ks * DM);
#pragma unroll
        for (int nt = 0; nt < NTL; ++nt) { const bf16x8v b = *(const bf16x8v*)(kp + (size_t)(((nt0 + nt) * 16 + ks) * 64) * 8);
            acc[nt] = __builtin_amdgcn_mfma_f32_32x32x16_bf16(a, b, acc[nt], 0, 0, 0); } }
#pragma unroll 1
    for (int dir = 0; dir < 2; ++dir) { const int dg = dir * 32 + g; const bf16* hp = Hin + (size_t)(dg * NC16 + chunk) * 128 + 8 * half;
        const bf16* cp = CA + (size_t)dg * 32768 + (size_t)lane * 8;
#pragma unroll
        for (int ks = 0; ks < 8; ++ks) { const bf16x8v a = *(const bf16x8v*)(hp + 16 * ks);
#pragma unroll
            for (int nt = 0; nt < NTL; ++nt) { const bf16x8v b = *(const bf16x8v*)(cp + (size_t)(((nt0 + nt) * 8 + ks) * 64) * 8);
                acc[nt] = __builtin_amdgcn_mfma_f32_32x32x16_bf16(a, b, acc[nt], 0, 0, 0); } } }
#pragma unroll
    for (int nt = 0; nt < NTL; ++nt) { const int t = 2 * (nt0 + nt) + (m >> 4), c = m & 15;
#pragma unroll
        for (int r = 0; r < 16; ++r) { const int ch = 32 * ct + crow16(r, half); if (ch < NC16) G[(size_t)(16 * ch + t) * 512 + 16 * g + c] = (bf16)f2bf(gelu_tanh(acc[nt][r])); } }
}
__device__ __forceinline__ void s5_out_phase(KP p, int lane, int wave) {
    const int gw = blockIdx.x * 8 + wave, NGW = gridDim.x * 8;
    for (int unit = gw; unit < 32 * 64; unit += NGW) s5_out_unit<4>(p, unit >> 6, unit & 31, 4 * ((unit >> 5) & 1), lane);
    if (wave == 0) for (int tu = blockIdx.x; tu < 256; tu += gridDim.x) s5_out_unit<1>(p, 32, tu & 31, tu >> 5, lane);
}

__device__ __forceinline__ float row16_sum(float v) {
    v += __int_as_float(__builtin_amdgcn_update_dpp(0, __float_as_int(v), 0x128, 0xf, 0xf, false));
    v += __int_as_float(__builtin_amdgcn_update_dpp(0, __float_as_int(v), 0x124, 0xf, 0xf, false));
    v += __int_as_float(__builtin_amdgcn_update_dpp(0, __float_as_int(v), 0x122, 0xf, 0xf, false));
    v += __int_as_float(__builtin_amdgcn_update_dpp(0, __float_as_int(v), 0x121, 0xf, 0xf, false));
    return v;
}
__device__ __forceinline__ void qkv_post_phase(KP p, int lane, int wave) {
    const bf16* raw = (const bf16*)(p->ws + WS_QKV); bf16* Q = (bf16*)(p->ws + WS_Q); bf16* K = (bf16*)(p->ws + WS_K); bf16* V = (bf16*)(p->ws + WS_V);
    const float* R = (const float*)(p->ws + WS_ROPE);
    const int gw = blockIdx.x * 8 + wave, NGW = gridDim.x * 8;
    const int j = lane & 15, hq = lane >> 4;
    const f32x4 qn = ((const f32x4*)p->in[24])[j], kn = ((const f32x4*)p->in[25])[j];
    for (int r = gw; r < T; r += NGW) {
        const bool lat = r >= NCTX; const int tl = r - NCTX;
        const int pos = (j < 8) ? (tl >> 6) : (tl & 63);
        f32x4 cs0 = (f32x4){1.f, 0.f, 1.f, 0.f}, cs1 = cs0;
        if (lat) { const f32x4* rp = (const f32x4*)(R + (size_t)pos * 32 + 8 * (j & 3)); cs0 = rp[0]; cs1 = rp[1]; }
        const bool up = (j & 4) != 0;
        u32x2 wv[5];
#pragma unroll
        for (int pass = 0; pass < 5; ++pass) { const int col = pass < 4 ? (pass * 4 + hq) * 64 + 4 * j : 1024 + hq * 64 + 4 * j; wv[pass] = (lat || pass == 4) ? *(const u32x2*)(raw + (size_t)r * NQKV + col) : (u32x2){0u, 0u}; }
        const u32x2 vv = *(const u32x2*)(raw + (size_t)r * NQKV + 1280 + 4 * lane);
#pragma unroll
        for (int pass = 0; pass < 5; ++pass) {
            if (!lat && pass < 4) continue;
            const u32x2 w = wv[pass];
            f32x4 x = (f32x4){bflo(w.x), bfhi(w.x), bflo(w.y), bfhi(w.y)};
            float ss = (x.x * x.x + x.y * x.y) + (x.z * x.z + x.w * x.w);
            ss = row16_sum(ss);
            const float rstd = rsqrtf(ss * (1.f / 64.f) + EPS);
            x = x * rstd * (pass < 4 ? qn : kn);
            if (lat) {
                f32x4 o; o.x = __shfl_xor(x.x, 4); o.y = __shfl_xor(x.y, 4); o.z = __shfl_xor(x.z, 4); o.w = __shfl_xor(x.w, 4);
                const float sg = up ? 1.f : -1.f;
                x.x = x.x * cs0.x + sg * o.x * cs0.y; x.y = x.y * cs0.z + sg * o.y * cs0.w; x.z = x.z * cs1.x + sg * o.z * cs1.y; x.w = x.w * cs1.z + sg * o.w * cs1.w;
            }
            if (pass < 4) { x = x * attn_body::C2; u32x2 o; o.x = pk2(x.x, x.y); o.y = pk2(x.z, x.w); *(u32x2*)(Q + (size_t)r * DM + (pass * 4 + hq) * 64 + 4 * j) = o; }
            else { u32x2 o; o.x = pk2(x.x, x.y); o.y = pk2(x.z, x.w); *(u32x2*)(K + (size_t)r * 256 + hq * 64 + 4 * j) = o; }
        }
        *(u32x2*)(V + (size_t)r * 256 + 4 * lane) = vv;
    }
}


template <int KIND> __device__ __forceinline__ void skinny_gemm(unsigned char* lds, const bf16* A, const bf16* Bt, int N, int K, bf16* O, int ldc, int tid, int lane, int wave) {
    const int nct = (KIND == 3 ? N / 2 : N) / 32, nunits = 8 * nct, m = lane & 31, half = lane >> 5, kw = K >> 3;
    float* red = (float*)lds;
    for (int u = blockIdx.x; u < nunits; u += gridDim.x) {
        const int rt = u & 7, ct = u >> 3;
        const int brow0 = (KIND == 3) ? 256 * (ct >> 2) + 32 * (ct & 3) : 32 * ct;
        const bf16* ap = A + (size_t)(32 * rt + m) * K + wave * kw + 8 * half;
        const bf16* bp = Bt + (size_t)(brow0 + m) * K + wave * kw + 8 * half;
        f32x16v acc0 = (f32x16v){}, acc1 = (f32x16v){};
#pragma unroll 4
        for (int ks = 0; ks < (kw >> 4); ++ks) { const bf16x8v a = *(const bf16x8v*)(ap + 16 * ks); const bf16x8v b0 = *(const bf16x8v*)(bp + 16 * ks);
            acc0 = __builtin_amdgcn_mfma_f32_32x32x16_bf16(a, b0, acc0, 0, 0, 0);
            if (KIND == 3) { const bf16x8v b1 = *(const bf16x8v*)(bp + (size_t)128 * K + 16 * ks); acc1 = __builtin_amdgcn_mfma_f32_32x32x16_bf16(a, b1, acc1, 0, 0, 0); } }
#pragma unroll
        for (int r = 0; r < 16; ++r) { red[(wave * 2) * 1024 + r * 64 + lane] = acc0[r]; if (KIND == 3) red[(wave * 2 + 1) * 1024 + r * 64 + lane] = acc1[r]; }
        __syncthreads();
        for (int e = tid; e < 1024; e += 512) { float s0 = 0.f, s1 = 0.f;
#pragma unroll
            for (int w = 0; w < 8; ++w) { s0 += red[(w * 2) * 1024 + e]; if (KIND == 3) s1 += red[(w * 2 + 1) * 1024 + e]; }
            const int r = e >> 6, ln = e & 63, row = 32 * rt + crow16(r, ln >> 5), col = 32 * ct + (ln & 31);
            float v = s0; if (KIND == 2) { v = v > 0.f ? v * v : 0.f; } if (KIND == 3) v = s0 / (1.f + __expf(-s1));
            O[(size_t)row * ldc + col] = (bf16)f2bf(v); }
        __syncthreads();
    }
}

#define GAS __attribute__((address_space(1)))
#define LAS __attribute__((address_space(3)))
typedef GAS unsigned gu32;
typedef GAS unsigned long long gu64;
#define RLX_AGENT __ATOMIC_RELAXED, __HIP_MEMORY_SCOPE_AGENT
#define LDS_WAIT() asm volatile("s_waitcnt lgkmcnt(0)" ::: "memory")
#define VM_WAIT() asm volatile("s_waitcnt vmcnt(0)" ::: "memory")
__device__ __forceinline__ unsigned long long rt() { return __builtin_amdgcn_s_memrealtime(); }
#define XB_TMO      128
#define XB_XCNT(j)  (256  + 64 * (j))
#define XB_XSUB(j)  (1280 + 64 * (j))
#define XB_XGEN(j)  (2304 + 64 * (j))
#define XB_TOP      3328
#define XB_TOPGEN   3392
#define XCD_BAR_WORDS 3456
#define XB_SPIN_CAP (1u << 18)

__device__ __forceinline__ unsigned xb_ld(unsigned* p)              { return __hip_atomic_load(p, __ATOMIC_RELAXED, __HIP_MEMORY_SCOPE_AGENT); }
__device__ __forceinline__ unsigned xb_add(unsigned* p, unsigned v) { return __hip_atomic_fetch_add(p, v, __ATOMIC_RELAXED, __HIP_MEMORY_SCOPE_AGENT); }
__device__ __forceinline__ unsigned xb_xcc_id() { return (unsigned)__builtin_amdgcn_s_getreg((3 << 11) | 20) & 0xFu; }
#define XB_SPIN(cond, bar) do { unsigned _sp = 0; while (cond) { __builtin_amdgcn_s_sleep(1); \
    if ((++_sp & 255u) == 0u) { if (xb_ld(&(bar)[XB_TMO])) break; if (_sp > XB_SPIN_CAP) { atomicAdd(&(bar)[XB_TMO], 1u); break; } } } } while (0)

struct XcdBarrier {
    unsigned* bar; unsigned x;
    volatile LAS unsigned* st;
};

__device__ __forceinline__ XcdBarrier xcd_barrier_post(unsigned* bar, volatile LAS unsigned* st) {
    XcdBarrier b; b.bar = bar; b.x = xb_xcc_id(); b.st = st;
    if (threadIdx.x == 0) (void)xb_add(&bar[XB_XCNT(b.x)], 1u);
    return b;
}
__device__ __forceinline__ void xcd_barrier_complete(unsigned* bar, unsigned x, unsigned& nloc, unsigned& nx) {
    const unsigned G = gridDim.x * gridDim.y * gridDim.z;
    unsigned sum, cnt, mine, sp = 0u;
    for (;;) {
        sum = 0u; cnt = 0u; mine = 0u;
#pragma unroll
        for (unsigned j = 0; j < 16; ++j) { const unsigned c = xb_ld(&bar[XB_XCNT(j)]); sum += c; cnt += (c > 0u) ? 1u : 0u; mine = (j == x) ? c : mine; }
        if (sum == G) break;
        __builtin_amdgcn_s_sleep(1);
        if ((++sp & 255u) == 0u) { if (xb_ld(&bar[XB_TMO])) break; if (sp > XB_SPIN_CAP) { atomicAdd(&bar[XB_TMO], 1u); break; } }
    }
    nloc = mine > 0u ? mine : 1u; nx = cnt > 0u ? cnt : 1u;
}

__device__ __forceinline__ void xcd_barrier(const XcdBarrier& b) {
    asm volatile("s_waitcnt vmcnt(0)" ::: "memory");
    __syncthreads();
    if (threadIdx.x == 0) {
        unsigned* bar = b.bar;
        __builtin_amdgcn_s_waitcnt(0);
        unsigned nloc = b.st[0], nx = b.st[1];
        if (nloc == 0u) { xcd_barrier_complete(bar, b.x, nloc, nx); b.st[0] = nloc; b.st[1] = nx; }
        const unsigned old = xb_add(&bar[XB_XSUB(b.x)], 1u);
        const unsigned gen = old / nloc;
        if (old + 1u == (gen + 1u) * nloc) {
            __builtin_amdgcn_fence(__ATOMIC_RELEASE, "agent");
            asm volatile("s_waitcnt vmcnt(0)" ::: "memory");
            const unsigned og = xb_add(&bar[XB_TOP], 1u);
            const unsigned tg = og / nx;
            if (og + 1u == (tg + 1u) * nx) xb_add(&bar[XB_TOPGEN], 1u);
            else XB_SPIN(xb_ld(&bar[XB_TOPGEN]) == tg, bar);
            __builtin_amdgcn_fence(__ATOMIC_ACQUIRE, "agent");
            xb_add(&bar[XB_XGEN(b.x)], 1u);
            asm volatile("s_waitcnt vmcnt(0)" ::: "memory");
        } else {
            XB_SPIN(xb_ld(&bar[XB_XGEN(b.x)]) == gen, bar);
            __builtin_amdgcn_fence(__ATOMIC_ACQUIRE, "agent");
            asm volatile("s_waitcnt vmcnt(0)" ::: "memory");
        }
    }
    __syncthreads();
}

template <class Epi> __device__ __forceinline__ void run_gemm(LAS3 unsigned char* lds3, const bf16* A, const bf16* Bt, int M, int N, int K, const Epi& E) {
    pg8::Gemm g{A, Bt, M, N, K}; pg8::StaticOrder S; S.init(M, N, (int)gridDim.x, (int)blockIdx.x);
    pg8::gemm_phase<Epi, pg8::StaticOrder, true, true>(lds3, g, S, E);
}
__device__ __forceinline__ void run_gemm_fused(LAS3 unsigned char* lds3, const bf16* A, const bf16* Bt, int K, const pg8::EpiRmsRes& E) {
    pg8::Gemm g{A, Bt, NLAT, 1024, K}; pg8::StaticOrder S; S.init(NLAT, 1024, (int)gridDim.x, (int)blockIdx.x);
    pg8::gemm_phase<pg8::EpiRmsRes, pg8::StaticOrder, false, true>(lds3, g, S, E);
}
constexpr int NSTEP = 20;
__global__ void __launch_bounds__(512, 2) mega_fwd(Params p_unused) {
    extern __shared__ __attribute__((aligned(16))) unsigned char lds[];
    cg::grid_group grid = cg::this_grid();
    const size_t LO = (size_t)NCTX;
    bool again = false; (void)again;
    if (threadIdx.x < 2) ((volatile LAS unsigned*)((LAS unsigned char*)lds + 143360))[threadIdx.x] = 0u;
    __syncthreads();
    {
        KP p0 = (KP)__builtin_amdgcn_kernarg_segment_ptr();
        if (p0->ws == nullptr) grid.sync();
        (void)xcd_barrier_post((unsigned*)(p0->ws + WS_BAR), (volatile LAS unsigned*)((LAS unsigned char*)lds + 143360));
    }
#pragma unroll 1
    for (int step = 0; step < NSTEP; ++step) {
        KP p = (KP)__builtin_amdgcn_kernarg_segment_ptr();
        asm volatile("" : "+s"(p));
        int tid_ = threadIdx.x; asm volatile("" : "+v"(tid_));
        const int tid = tid_, lane = tid & 63, wave = __builtin_amdgcn_readfirstlane(tid >> 6);
        unsigned char* ws = p->ws;
        const float* modv = (const float*)(ws + WS_MOD);
        const float* ng = p->in[6];
        bf16* H = (bf16*)(ws + WS_H); bf16* Y = (bf16*)(ws + WS_Y); bf16* HID = (bf16*)(ws + WS_BIG);
        float* XC = (float*)(ws + WS_XC);
        if (step == 0) prologue(p, lds, tid, lane, wave);
        else if (step == 3) s5_end_phase(p, lane, wave);
        else if (step == 4) {
            if (blockIdx.x < 64) s5_carry_phase(p, lds, lane, wave); else { pool_s5a_phase(p, lane, wave, 64, 192); s5_build(p, tid, 1, 64, 192); }
        }
        else if (step == 5) s5_out_phase(p, lane, wave);
        else if (step == 13) qkv_post_phase(p, lane, wave);
        else if (step == 14) {
            const attn_body::AttnTensors AT{(const attn_body::bf16*)(ws + WS_Q) + LO * DM, (const attn_body::bf16*)(ws + WS_K), (const attn_body::bf16*)(ws + WS_V), (attn_body::bf16*)(ws + WS_O) + LO * DM};
            const attn_body::StaticOrder S((int)gridDim.x, (int)blockIdx.x);
            attn_body::attn_phase<attn_body::StaticOrder>((char*)lds, AT, S);
        } else if (step == 1) {
            float* ml = (float*)lds; const float* MP = (const float*)(ws + WS_MODP); const float* bias = p->in[5];
            for (int i = tid; i < 4096; i += 512) { const int v = i >> 11, c = i & 2047; float sacc = bias[c];
#pragma unroll
                for (int q = 0; q < 8; ++q) sacc += MP[(size_t)(q * 2 + v) * 6144 + c];
                ml[v * 6144 + c] = sacc; }
            for (int i = blockIdx.x * 512 + tid; i < 24576; i += gridDim.x * 512) { const int l = i / 12288, v = (i / 6144) & 1, c = i % 6144; float sacc = bias[l * 6144 + c];
#pragma unroll
                for (int q = 0; q < 8; ++q) sacc += MP[(size_t)((l * 8 + q) * 2 + v) * 6144 + c];
                ((float*)(ws + WS_MOD))[(size_t)(l * 2 + v) * 6144 + c] = sacc; }
            __syncthreads();
            const RowP ra{p->in[0], p->in[2], p->out, nullptr, nullptr, ng, modv, ng + 0 * 1024, ml, H, 0, T, 0, 1};
            row_phase(ra, lane, wave); s5_build(p, tid, 0, 0, (int)gridDim.x);
        } else if (step == 8) {
            const RowP ra{p->out, p->in[2], p->out, XC, Y, ng + 1 * 1024, modv + 2048, ng + 2 * 1024, modv + 3072, H, 0, T, 1, 1};
            row_phase(ra, lane, wave);
        } else if (step == 11) {
            const RowP ra{p->out, XC, p->out, XC, Y, ng + 3 * 1024, modv + 5120, ng + 4 * 1024, modv + 2 * 6144 + 0, H, 0, T, 1, 1};
            row_phase(ra, lane, wave);
        } else if (step == 16) {
            const RowP ra{p->out, XC, p->out, XC, Y, ng + 5 * 1024, modv + 2 * 6144 + 2048, ng + 6 * 1024, modv + 2 * 6144 + 3072, H, NCTX, T, 1, 1};
            row_phase(ra, lane, wave);
        } else if (step == 19) {
            const RowP ra{p->out, XC, p->out, XC, Y, ng + 7 * 1024, modv + 2 * 6144 + 5120, ng, modv, nullptr, NCTX, T, 1, 0};
            row_phase(ra, lane, wave);
        } else {
            int gk = 0; const bf16* gA = H; const bf16* gB = nullptr; int gN = 1024, gK = 1024; bf16* gO = Y; int gld = 1024; bool ctx = true; int gM = NLAT; size_t lo = LO;
            switch (step) {
            case 2: gB = (const bf16*)(ws + WS_WIN); gO = (bf16*)(ws + WS_U); break;
            case 6: gk = 3; gA = (const bf16*)(ws + WS_G); gB = (const bf16*)(ws + WS_WGLU); gK = 512; gO = (bf16*)(ws + WS_Z); break;
            case 7: gA = (const bf16*)(ws + WS_Z); gB = (const bf16*)(ws + WS_WOUT); break;
            case 9: gk = 2; gB = (const bf16*)(ws + WS_W1_0); gN = 4096; gO = HID; gld = 4096; ctx = false; gM = T; lo = 0; break;
            case 10: gA = HID; gB = (const bf16*)(ws + WS_W2_0); gK = 4096; break;
            case 12: gB = (const bf16*)(ws + WS_WQKV); gN = NQKV; gO = (bf16*)(ws + WS_QKV); gld = NQKV; ctx = false; gM = T; lo = 0; break;
            case 15: gA = (const bf16*)(ws + WS_O); gB = (const bf16*)(ws + WS_WAO); ctx = false; break;
            case 17: gk = 2; gB = (const bf16*)(ws + WS_W1_1); gN = 4096; gO = HID; gld = 4096; ctx = false; break;
            default: gA = HID; gB = (const bf16*)(ws + WS_W2_1); gK = 4096; ctx = false; break;
            }
            const bf16* gAl = gA + lo * (size_t)gK; bf16* gOl = gO + lo * (size_t)gld;
            if (gk == 0) { if (ctx) skinny_gemm<0>(lds, gA, gB, gN, gK, gO, gld, tid, lane, wave); pg8::EpiBf16<0> E{gOl, gld}; run_gemm((LAS3 unsigned char*)lds, gAl, gB, gM, gN, gK, E); }
            else if (gk == 2) { if (ctx) skinny_gemm<2>(lds, gA, gB, gN, gK, gO, gld, tid, lane, wave); pg8::EpiBf16<2> E{gOl, gld}; run_gemm((LAS3 unsigned char*)lds, gAl, gB, gM, gN, gK, E); }
            else { skinny_gemm<3>(lds, gA, gB, gN, gK, gO, gld, tid, lane, wave); pg8::EpiGlu E{gOl, gld}; run_gemm((LAS3 unsigned char*)lds, gAl, gB, NLAT, gN, gK, E); }
        }
        if (step != NSTEP - 1) { XcdBarrier xb; xb.bar = (unsigned*)(p->ws + WS_BAR); xb.x = xb_xcc_id(); xb.st = (volatile LAS unsigned*)((LAS unsigned char*)lds + 143360); xcd_barrier(xb); }
#ifdef PROBE_MASK
        if (((PROBE_MASK >> step) & 1) && !again) { again = true; --step; } else again = false;
#endif
    }
}

extern "C" void kernel_launch(void* const* d_in, const int* in_sizes, int n_in, void* d_out, int out_size, void* d_ws, size_t ws_size, hipStream_t stream) {
    static int grid = 0;
    if (grid == 0) {
        if (n_in != 26 || out_size != NLAT * DM || ws_size < WS_END) { fprintf(stderr, "kernel_launch: unexpected shapes (n_in %d out %d ws %zu)\n", n_in, out_size, ws_size); grid = -1; return; }
        int dev = 0, cus = 0, per_cu = 0;
        (void)hipGetDevice(&dev); (void)hipDeviceGetAttribute(&cus, hipDeviceAttributeMultiprocessorCount, dev);
        if (hipFuncSetAttribute((const void*)mega_fwd, hipFuncAttributeMaxDynamicSharedMemorySize, LDS_TOTAL) != hipSuccess) { fprintf(stderr, "kernel_launch: hipFuncSetAttribute failed\n"); grid = -1; return; }
        if (hipOccupancyMaxActiveBlocksPerMultiprocessor(&per_cu, (const void*)mega_fwd, 512, LDS_TOTAL) != hipSuccess || per_cu < 1) { fprintf(stderr, "kernel_launch: occupancy query says %d\n", per_cu); per_cu = 1; (void)hipGetLastError(); }
        grid = cus * per_cu; if (grid > 256) grid = 256;
        if (grid != 256) { fprintf(stderr, "kernel_launch: this kernel needs a 256-workgroup cooperative grid (got %d)\n", grid); grid = -1; return; }
    }
    if (grid < 0) return;
    Params p{};
    for (int i = 0; i < 26; ++i) p.in[i] = (const float*)d_in[i];
    p.out = (float*)d_out; p.ws = (unsigned char*)d_ws;
    if (hipMemsetAsync((unsigned char*)d_ws + WS_BAR, 0, XCD_BAR_WORDS * 4, stream) != hipSuccess) { fprintf(stderr, "kernel_launch: hipMemsetAsync failed\n"); return; }
    void* args[] = {&p};
    hipError_t e = hipLaunchCooperativeKernel((const void*)mega_fwd, dim3(grid), dim3(512), args, LDS_TOTAL, stream);
    if (e != hipSuccess) fprintf(stderr, "cooperative launch failed: %s (grid %d)\n", hipGetErrorString(e), grid);
}
```

```cpp
#include <hip/hip_runtime.h>
#include <hip/hip_cooperative_groups.h>
#include <cstdio>
#include <cstdint>
namespace cg = cooperative_groups;
namespace pg8 {
#define PG8_LAS __attribute__((address_space(3)))
typedef unsigned short bf16_t;
typedef short bf16x8 __attribute__((ext_vector_type(8)));
typedef float f32x4 __attribute__((ext_vector_type(4)));
typedef unsigned u32x4 __attribute__((ext_vector_type(4)));
constexpr int BM = 256, BK = 64, HALF = 128, HTB = HALF * BK * 2  , STAGE_BYTES = 8 * HTB, NXCD = 8, WGM = 8;

__host__ __device__ __forceinline__ int lds_byte(int r, int c) { const int st = (r >> 4) * 2 + (c >> 5), rr = r & 15, cc = c & 31, ob = rr * 64 + cc * 2; return st * 1024 + (ob ^ (((ob >> 9) & 1) << 5)); }
__host__ __device__ __forceinline__ void stage_rc(int b, int& R, int& C) { const int st = b / 1024, sb = b % 1024, swz = sb ^ (((sb >> 9) & 1) << 5); R = (st >> 1) * 16 + swz / 64; C = (st & 1) * 32 + (swz % 64) / 2; }
__host__ __device__ __forceinline__ int perm32(int rho) { const int n = rho >> 4, i = rho & 15; return 8 * (i >> 2) + 4 * n + (i & 3); }

struct Unit { int pm, pn; };
struct Gemm { const bf16_t* A; const bf16_t* Bt; int M, N, K; };

struct StaticOrder {
    int nM, nN, nwg, G, c;
    __host__ __device__ void init(int M, int N, int G_, int c_) { nM = M / BM; nN = N / BM; nwg = nM * nN; G = G_; c = c_; }
    __host__ __device__ bool next(int i, Unit& u) const {
        const long L = (long)i * G + c; if (L >= nwg) return false;
        int wgid = (int)L; { const int q = nwg / NXCD, r = nwg % NXCD, xcd = wgid % NXCD, off = wgid / NXCD; wgid = (xcd < r ? xcd * (q + 1) : r * (q + 1) + (xcd - r) * q) + off; }
        const int nig = WGM * nN, gid = wgid / nig, fm = gid * WGM, gsz = (nM - fm) < WGM ? (nM - fm) : WGM;
        u.pm = fm + ((wgid % nig) % gsz); u.pn = (wgid % nig) / gsz; return true;
    }
    __device__ __forceinline__ void a_ready(const Unit&) const {}
    __device__ __forceinline__ void done(const Unit&) const {}
};

__device__ __forceinline__ unsigned cvt_pk_bf16(float lo, float hi) { unsigned r; asm volatile("v_cvt_pk_bf16_f32 %0, %1, %2" : "=v"(r) : "v"(lo), "v"(hi)); return r; }
typedef float f32x2 __attribute__((ext_vector_type(2)));
template <int ACT> struct EpiBf16 {
    static constexpr bool PERM = true, AFTER_DRAIN = false;
    bf16_t* O; int ldc;
    __device__ __forceinline__ void operator()(const f32x4 (&acc)[2][2][4][2], const Unit& u, int wr, int wc, int fr, int fq) const {
        const int row0 = u.pm * BM + wr * 64 + fr; const int col0 = u.pn * BM + wc * 32 + 8 * fq;
#pragma unroll
        for (int ai = 0; ai < 2; ++ai)
#pragma unroll
            for (int m = 0; m < 4; ++m) { bf16_t* rowp = O + (size_t)(row0 + ai * HALF + m * 16) * ldc + col0;
#pragma unroll
                for (int bj = 0; bj < 2; ++bj) { f32x4 v0 = acc[ai][bj][m][0], v1 = acc[ai][bj][m][1];
                    if (ACT == 2) {
#pragma unroll
                        for (int e = 0; e < 4; ++e) { float a = v0[e] > 0.f ? v0[e] : 0.f; v0[e] = a * a; float b = v1[e] > 0.f ? v1[e] : 0.f; v1[e] = b * b; } }
                    u32x4 w; w.x = cvt_pk_bf16(v0[0], v0[1]); w.y = cvt_pk_bf16(v0[2], v0[3]); w.z = cvt_pk_bf16(v1[0], v1[1]); w.w = cvt_pk_bf16(v1[2], v1[3]);
                    *(u32x4*)(rowp + bj * HALF) = w; } }
    }
};
struct EpiGlu {
    static constexpr bool PERM = true, AFTER_DRAIN = false;
    bf16_t* O; int ldc;
    __device__ __forceinline__ void operator()(const f32x4 (&acc)[2][2][4][2], const Unit& u, int wr, int wc, int fr, int fq) const {
        const int row0 = u.pm * BM + wr * 64 + fr; const int col0 = u.pn * HALF + wc * 32 + 8 * fq;
#pragma unroll
        for (int ai = 0; ai < 2; ++ai)
#pragma unroll
            for (int m = 0; m < 4; ++m) { bf16_t* rowp = O + (size_t)(row0 + ai * HALF + m * 16) * ldc + col0;
                f32x4 v0 = acc[ai][0][m][0], v1 = acc[ai][0][m][1]; const f32x4 g0 = acc[ai][1][m][0], g1 = acc[ai][1][m][1];
#pragma unroll
                for (int e = 0; e < 4; ++e) { v0[e] = v0[e] / (1.f + __expf(-g0[e])); v1[e] = v1[e] / (1.f + __expf(-g1[e])); }
                u32x4 w; w.x = cvt_pk_bf16(v0[0], v0[1]); w.y = cvt_pk_bf16(v0[2], v0[3]); w.z = cvt_pk_bf16(v1[0], v1[1]); w.w = cvt_pk_bf16(v1[2], v1[3]);
                *(u32x4*)rowp = w; }
    }
};
struct PanelStats {
    unsigned* xbuf;
    unsigned* cnt;
    unsigned* tmo;
    int ntn; float eps;
    unsigned code;
    __device__ __forceinline__ bool run(const f32x4 (&v)[2][2][4][2], const Unit& u, int wr, int wc, int fr, int fq, PG8_LAS unsigned char* lds, int wid, int lane) const {
        typedef float f32x2v __attribute__((ext_vector_type(2)));
        PG8_LAS f32x2v* P = (PG8_LAS f32x2v*)lds;
        PG8_LAS f32x2v* S = (PG8_LAS f32x2v*)(lds + 8192);
        PG8_LAS unsigned* flag = (PG8_LAS unsigned*)(lds + 8192 + 2048);
#pragma unroll
        for (int ai = 0; ai < 2; ++ai)
#pragma unroll
            for (int m = 0; m < 4; ++m) {
                float s = 0.f;
#pragma unroll
                for (int bj = 0; bj < 2; ++bj)
#pragma unroll
                    for (int n = 0; n < 2; ++n) { const f32x4 x = v[ai][bj][m][n]; s += (x[0] + x[1]) + (x[2] + x[3]); }
                s += __shfl_xor(s, 16); s += __shfl_xor(s, 32);
                const float mw = s * (1.0f / 64.0f); float q = 0.f;
#pragma unroll
                for (int bj = 0; bj < 2; ++bj)
#pragma unroll
                    for (int n = 0; n < 2; ++n) { const f32x4 d = v[ai][bj][m][n] - mw; q += (d[0] * d[0] + d[1] * d[1]) + (d[2] * d[2] + d[3] * d[3]); }
                q += __shfl_xor(q, 16); q += __shfl_xor(q, 32);
                if (fq == 0) P[(ai * HALF + wr * 64 + m * 16 + fr) * 4 + wc] = (f32x2v){mw, q};
            }
        asm volatile("s_waitcnt lgkmcnt(0)" ::: "memory"); __builtin_amdgcn_s_barrier(); asm volatile("" ::: "memory");
#if defined(BROKEN_EXCHANGE_NO_WAIT)
#warning BROKEN CONTROL BUILD: the row-statistics exchange does not wait; results are wrong by design
        if (blockIdx.x >= 64) { const long long t0_ = clock64(); while (clock64() - t0_ < 60000) __builtin_amdgcn_s_sleep(8); }
#endif
        const int row = wid * 32 + (lane & 31);
        if (lane < 32) {
            const f32x2v a = P[row * 4 + 0], b = P[row * 4 + 1], c = P[row * 4 + 2], d = P[row * 4 + 3];
            const float mt = (a.x + b.x + c.x + d.x) * 0.25f;
            const float da = a.x - mt, db = b.x - mt, dc = c.x - mt, dd = d.x - mt;
            const float m2 = (a.y + b.y) + (c.y + d.y) + 64.0f * ((da * da + db * db) + (dc * dc + dd * dd));
            unsigned long long* slot = (unsigned long long*)xbuf + ((size_t)(u.pm * BM + row) * 4 + u.pn);
            __hip_atomic_store(slot, ((unsigned long long)__float_as_uint(m2) << 32) | __float_as_uint(mt), __ATOMIC_RELAXED, __HIP_MEMORY_SCOPE_AGENT);
        }
        asm volatile("s_waitcnt vmcnt(0)" ::: "memory");
        if (lane == 0) __hip_atomic_fetch_add(cnt + 64 * u.pm, 1u, __ATOMIC_RELAXED, __HIP_MEMORY_SCOPE_AGENT);
        if (wid == 0) {
            bool dead = false; const unsigned long long t0 = __builtin_amdgcn_s_memrealtime(); const unsigned want = 8u * (unsigned)ntn;
            for (;;) {
#if defined(BROKEN_EXCHANGE_NO_WAIT)
                break;
#endif
                if ((unsigned)__builtin_amdgcn_readfirstlane(__hip_atomic_load(cnt + 64 * u.pm, __ATOMIC_RELAXED, __HIP_MEMORY_SCOPE_AGENT)) >= want) break;
                if (__builtin_amdgcn_s_memrealtime() - t0 > 2000000ull) {
                    if (lane == 0) { unsigned expect = 0u; __hip_atomic_compare_exchange_strong(tmo + 1, &expect, code | (unsigned)(u.pm & 0xff), __ATOMIC_RELAXED, __ATOMIC_RELAXED, __HIP_MEMORY_SCOPE_AGENT);
                                     __hip_atomic_store(tmo, 1u, __ATOMIC_RELAXED, __HIP_MEMORY_SCOPE_AGENT); }
                    dead = true; break; }
                __builtin_amdgcn_s_sleep(2);
            }
            __builtin_amdgcn_fence(__ATOMIC_ACQUIRE, "agent");
            if (lane == 0) flag[0] = dead ? 1u : 0u;
        }
        asm volatile("s_waitcnt vmcnt(0) lgkmcnt(0)" ::: "memory"); __builtin_amdgcn_s_barrier(); asm volatile("" ::: "memory");
        const bool bad = flag[0] != 0u;
        if (lane < 32) {
            const unsigned long long* slot = (const unsigned long long*)xbuf + (size_t)(u.pm * BM + row) * 4; float mt[4], m2[4]; float ms = 0.f;
#pragma unroll
            for (int t = 0; t < 4; ++t) { if (t < ntn) { const unsigned long long w = __hip_atomic_load(slot + t, __ATOMIC_RELAXED, __HIP_MEMORY_SCOPE_AGENT); mt[t] = __uint_as_float((unsigned)w); m2[t] = __uint_as_float((unsigned)(w >> 32)); } else { mt[t] = 0.f; m2[t] = 0.f; } ms += mt[t]; }
            const float mean = ms / (float)ntn; float q = 0.f;
#pragma unroll
            for (int t = 0; t < 4; ++t) if (t < ntn) { const float dm = mt[t] - mean; q += m2[t] + 256.0f * dm * dm; }
            S[row] = (f32x2v){mean, 1.0f / sqrtf(q / (256.0f * (float)ntn) + mean * mean + eps)};
        }
        asm volatile("s_waitcnt lgkmcnt(0)" ::: "memory"); __builtin_amdgcn_s_barrier(); asm volatile("" ::: "memory");
        return bad;
    }
};

struct EpiRmsRes {
    static constexpr bool PERM = false, AFTER_DRAIN = true;
    const float* base; float* out; bf16_t* xn; int ldc; const float* gate; const float* gA; const float* gB; const float* sh; const float* sc; PanelStats st1, st2;
    __device__ __forceinline__ void fused(f32x4 (&acc)[2][2][4][2], const Unit& u, int wr, int wc, int fr, int fq, PG8_LAS unsigned char* lds, int wid, int lane) const {
        typedef float f32x2v __attribute__((ext_vector_type(2))); typedef unsigned u32x2v __attribute__((ext_vector_type(2)));
        const PG8_LAS f32x2v* S = (const PG8_LAS f32x2v*)(lds + 8192);
        const int col0 = u.pn * BM + wc * 32 + 4 * fq;
        f32x4 pre[4][2][2];
#pragma unroll
        for (int m = 0; m < 4; ++m) { const size_t off = (size_t)(u.pm * BM + wr * 64 + m * 16 + fr) * ldc + col0;
#pragma unroll
            for (int bj = 0; bj < 2; ++bj)
#pragma unroll
                for (int n = 0; n < 2; ++n) pre[m][bj][n] = *(const f32x4*)(base + off + bj * HALF + n * 16); }
        bool bad = st1.run(acc, u, wr, wc, fr, fq, lds, wid, lane);
        const float qnan = __builtin_nanf("");
#pragma unroll
        for (int ai = 0; ai < 2; ++ai)
#pragma unroll
            for (int m = 0; m < 4; ++m) { const int r = ai * HALF + wr * 64 + m * 16 + fr; const f32x2v sr = S[r]; const size_t off = (size_t)(u.pm * BM + r) * ldc + col0;
#pragma unroll
                for (int bj = 0; bj < 2; ++bj)
#pragma unroll
                    for (int n = 0; n < 2; ++n) { const int c = col0 + bj * HALF + n * 16; const f32x4 bs = ai == 0 ? pre[m][bj][n] : *(const f32x4*)(base + off + bj * HALF + n * 16);
                        const f32x4 gt = *(const f32x4*)(gate + c), ga = *(const f32x4*)(gA + c);
                        acc[ai][bj][m][n] = bs + gt * (acc[ai][bj][m][n] * sr.y * ga); }
                asm volatile("" : "+v"(acc[ai][0][m][0]), "+v"(acc[ai][0][m][1]), "+v"(acc[ai][1][m][0]), "+v"(acc[ai][1][m][1]));
                if (m & 1) asm volatile("" ::: "memory"); }
        const bool bad1 = bad;
        if (xn) bad = st2.run(acc, u, wr, wc, fr, fq, lds, wid, lane) || bad;
#pragma unroll
        for (int ai = 0; ai < 2; ++ai)
#pragma unroll
            for (int m = 0; m < 4; ++m) { const int r = ai * HALF + wr * 64 + m * 16 + fr; const f32x2v sr = S[r]; const size_t off = (size_t)(u.pm * BM + r) * ldc + col0;
#pragma unroll
                for (int bj = 0; bj < 2; ++bj)
#pragma unroll
                    for (int n = 0; n < 2; ++n) { const int c = col0 + bj * HALF + n * 16; const f32x4 x1 = acc[ai][bj][m][n];
                        *(f32x4*)(out + off + bj * HALF + n * 16) = bad1 ? (f32x4){qnan, qnan, qnan, qnan} : x1;
                        if (xn) { const f32x4 gb = *(const f32x4*)(gB + c), s1 = *(const f32x4*)(sc + c), s0 = *(const f32x4*)(sh + c);
                            const f32x4 o = (x1 * sr.y * gb) * (s1 + 1.0f) + s0; u32x2v w; w.x = cvt_pk_bf16(o[0], o[1]); w.y = cvt_pk_bf16(o[2], o[3]);
                            if (bad) { w.x = 0x7fc07fc0u; w.y = 0x7fc07fc0u; } *(u32x2v*)(xn + off + bj * HALF + n * 16) = w; } }
                asm volatile("" ::: "memory"); }
    }
};

template <class Epi, class Sched, bool ALIGN_EPI = false, bool SP2 = false>
__device__ __forceinline__ void gemm_phase(PG8_LAS unsigned char* lds, const Gemm g, const Sched& S, const Epi& E) {
    int tid_ = threadIdx.x; asm volatile("" : "+v"(tid_)); const int tid = tid_, wid = __builtin_amdgcn_readfirstlane(tid >> 6), lane = tid & 63, wr = wid >> 2, wc = wid & 3, fr = lane & 15, fq = lane >> 4;
    const int K = g.K, nt = K / BK;
    unsigned voffA[2], voffB[2];
#pragma unroll
    for (int i = 0; i < 2; ++i) { int R, C; stage_rc(tid * 16 + i * 8192, R, C); const int Rb = Epi::PERM ? ((R & ~31) + perm32(R & 31)) : R;
        voffA[i] = (unsigned)(R * K + C) * 2u; voffB[i] = (unsigned)(Rb * K + C) * 2u; }
    const size_t kstep = (size_t)(BK * 2);
    const size_t hstep = (size_t)HALF * K * 2;
    const size_t tstep = 2 * hstep;
    const unsigned ldsw = (unsigned)wid * 1024u;
    const int aoff = lds_byte(wr * 64 + fr, fq * 8), boff = lds_byte(wc * 32 + fr, fq * 8);
#define PG8_SA(b, h) (((b) * 2 + (h)) * HTB)
#define PG8_SB(b, h) ((4 + (b) * 2 + (h)) * HTB)
#define PG8_STAGE(bufoff, gbase, voff) do { _Pragma("unroll") for (int _i = 0; _i < 2; ++_i) \
        __builtin_amdgcn_global_load_lds((const unsigned*)((const char*)(gbase) + (voff)[_i]), (PG8_LAS unsigned*)(lds + (bufoff) + ldsw + _i * 8192), 16, 0, 0); } while (0)
#define PG8_LDA(dst, b, h) do { _Pragma("unroll") for (int m = 0; m < 4; ++m) _Pragma("unroll") for (int k = 0; k < 2; ++k) dst[m][k] = *(const PG8_LAS bf16x8*)(lds + PG8_SA(b, h) + aoff + m * 2048 + k * 1024); } while (0)
#define PG8_LDB(dst, b, h) do { _Pragma("unroll") for (int n = 0; n < 2; ++n) _Pragma("unroll") for (int k = 0; k < 2; ++k) dst[n][k] = *(const PG8_LAS bf16x8*)(lds + PG8_SB(b, h) + boff + n * 2048 + k * 1024); } while (0)
#define PG8_MMA(ai, bj, At, Bt) do { __builtin_amdgcn_s_setprio(1); _Pragma("unroll") for (int m = 0; m < 4; ++m) _Pragma("unroll") for (int n = 0; n < 2; ++n) _Pragma("unroll") for (int k = 0; k < 2; ++k) \
        acc[ai][bj][m][n] = __builtin_amdgcn_mfma_f32_16x16x32_bf16(Bt[n][k], At[m][k], acc[ai][bj][m][n], 0, 0, 0); __builtin_amdgcn_s_setprio(0); } while (0)
#define PG8_WAIT_V(n) asm volatile("s_waitcnt vmcnt(" #n ")" ::: "memory")
#define PG8_WAIT_L(n) asm volatile("s_waitcnt lgkmcnt(" #n ")" ::: "memory")
#define PG8_BAR __builtin_amdgcn_s_barrier()
#define PG8_SCHED __builtin_amdgcn_sched_barrier(0)
    Unit cur, nxt; int ui = 0;
    if (!S.next(0, cur)) return;
    f32x4 acc[2][2][4][2];
#pragma unroll
    for (int a = 0; a < 2; ++a)
#pragma unroll
        for (int b = 0; b < 2; ++b)
#pragma unroll
            for (int m = 0; m < 4; ++m)
#pragma unroll
                for (int n = 0; n < 2; ++n) acc[a][b][m][n] = (f32x4){0.f, 0.f, 0.f, 0.f};
    bf16x8 At[4][2], B0[2][2], B1[2][2];
    const char* cA = (const char*)g.A + (size_t)cur.pm * tstep; const char* cB = (const char*)g.Bt + (size_t)cur.pn * tstep;
    S.a_ready(cur);
    if constexpr (SP2) {
        PG8_STAGE(PG8_SB(0, 0), cB, voffB); PG8_STAGE(PG8_SB(0, 1), cB + hstep, voffB); PG8_STAGE(PG8_SA(0, 0), cA, voffA); PG8_STAGE(PG8_SA(0, 1), cA + hstep, voffA);
        if (wr == 1) PG8_BAR;
        PG8_WAIT_V(2); PG8_BAR;
        PG8_STAGE(PG8_SB(1, 0), cB + kstep, voffB); PG8_STAGE(PG8_SA(1, 0), cA + kstep, voffA); PG8_STAGE(PG8_SB(1, 1), cB + hstep + kstep, voffB);
        PG8_WAIT_V(6); PG8_BAR;
    } else {
        PG8_STAGE(PG8_SB(0, 0), cB, voffB); PG8_STAGE(PG8_SA(0, 0), cA, voffA); PG8_STAGE(PG8_SB(0, 1), cB + hstep, voffB); PG8_STAGE(PG8_SA(0, 1), cA + hstep, voffA);
        if (wr == 1) PG8_BAR;
        PG8_WAIT_V(4); PG8_BAR;
        PG8_STAGE(PG8_SB(1, 0), cB + kstep, voffB); PG8_STAGE(PG8_SA(1, 0), cA + kstep, voffA); PG8_STAGE(PG8_SB(1, 1), cB + hstep + kstep, voffB);
        PG8_WAIT_V(6); PG8_BAR;
    }
    for (;;) {
        const bool has_next = S.next(ui + 1, nxt);
        const char* nA = has_next ? (const char*)g.A + (size_t)nxt.pm * tstep : cA; const char* nB = has_next ? (const char*)g.Bt + (size_t)nxt.pn * tstep : cB;
        for (int t = 0; t < nt; t += 2) {
            const bool last = (t == nt - 2);
            const char* a1 = cA + (size_t)(t + 1) * kstep;
            const char* a2 = last ? nA : cA + (size_t)(t + 2) * kstep; const char* b2 = last ? nB : cB + (size_t)(t + 2) * kstep;
            const char* a3 = a2 + kstep; const char* b3 = b2 + kstep;
            if (last && has_next) S.a_ready(nxt);
            if constexpr (SP2) {
            PG8_LDB(B0, 0, 0); PG8_LDB(B1, 0, 1); PG8_SCHED; PG8_LDA(At, 0, 0); PG8_STAGE(PG8_SA(1, 1), a1 + hstep, voffA);
            PG8_WAIT_V(8); PG8_WAIT_L(0); PG8_BAR; PG8_MMA(0, 0, At, B0); PG8_MMA(0, 1, At, B1); PG8_BAR; PG8_SCHED;
            PG8_LDA(At, 0, 1); PG8_STAGE(PG8_SB(0, 0), b2, voffB); PG8_STAGE(PG8_SB(0, 1), b2 + hstep, voffB); PG8_STAGE(PG8_SA(0, 0), a2, voffA);
            PG8_WAIT_V(8); PG8_WAIT_L(0); PG8_BAR; PG8_MMA(1, 0, At, B0); PG8_MMA(1, 1, At, B1); PG8_BAR; PG8_SCHED;
            PG8_LDB(B0, 1, 0); PG8_LDB(B1, 1, 1); PG8_SCHED; PG8_LDA(At, 1, 0); PG8_STAGE(PG8_SA(0, 1), a2 + hstep, voffA);
            PG8_WAIT_V(8); PG8_WAIT_L(0); PG8_BAR; PG8_MMA(0, 0, At, B0); PG8_MMA(0, 1, At, B1); PG8_BAR; PG8_SCHED;
            PG8_LDA(At, 1, 1); PG8_STAGE(PG8_SB(1, 0), b3, voffB); PG8_STAGE(PG8_SB(1, 1), b3 + hstep, voffB); PG8_STAGE(PG8_SA(1, 0), a3, voffA);
            PG8_WAIT_V(8); PG8_WAIT_L(0); PG8_BAR; PG8_MMA(1, 0, At, B0); PG8_MMA(1, 1, At, B1); PG8_BAR; PG8_SCHED;
            } else {
            PG8_LDB(B0, 0, 0); PG8_SCHED; PG8_LDA(At, 0, 0); PG8_STAGE(PG8_SA(1, 1), a1 + hstep, voffA);
            PG8_WAIT_L(8); PG8_BAR; PG8_WAIT_L(0); PG8_MMA(0, 0, At, B0); PG8_BAR; PG8_SCHED;
            PG8_LDB(B1, 0, 1); PG8_STAGE(PG8_SB(0, 0), b2, voffB);
            PG8_BAR; PG8_WAIT_L(0); PG8_MMA(0, 1, At, B1); PG8_BAR;
            PG8_LDA(At, 0, 1); PG8_STAGE(PG8_SA(0, 0), a2, voffA);
            PG8_BAR; PG8_WAIT_L(0); PG8_MMA(1, 0, At, B0); PG8_BAR; PG8_SCHED;
            PG8_STAGE(PG8_SB(0, 1), b2 + hstep, voffB);
            PG8_WAIT_V(6); PG8_BAR; PG8_MMA(1, 1, At, B1); PG8_BAR;
            PG8_LDB(B0, 1, 0); PG8_SCHED; PG8_LDA(At, 1, 0); PG8_STAGE(PG8_SA(0, 1), a2 + hstep, voffA);
            PG8_WAIT_L(8); PG8_BAR; PG8_WAIT_L(0); PG8_MMA(0, 0, At, B0); PG8_BAR; PG8_SCHED;
            PG8_LDB(B1, 1, 1); PG8_STAGE(PG8_SB(1, 0), b3, voffB);
            PG8_BAR; PG8_WAIT_L(0); PG8_MMA(0, 1, At, B1); PG8_BAR;
            PG8_LDA(At, 1, 1); PG8_STAGE(PG8_SA(1, 0), a3, voffA);
            PG8_BAR; PG8_WAIT_L(0); PG8_MMA(1, 0, At, B0); PG8_BAR; PG8_SCHED;
            PG8_STAGE(PG8_SB(1, 1), b3 + hstep, voffB);
            PG8_WAIT_V(6); PG8_BAR; PG8_MMA(1, 1, At, B1); PG8_BAR;
            }
        }
        if constexpr (ALIGN_EPI) { if (wr == 0) PG8_BAR; }
        if constexpr (!Epi::AFTER_DRAIN) { E(acc, cur, wr, wc, fr, fq); S.done(cur); }
        if (!has_next) break;
#pragma unroll
        for (int a = 0; a < 2; ++a)
#pragma unroll
            for (int b = 0; b < 2; ++b)
#pragma unroll
                for (int m = 0; m < 4; ++m)
#pragma unroll
                    for (int n = 0; n < 2; ++n) acc[a][b][m][n] = (f32x4){0.f, 0.f, 0.f, 0.f};
        cur = nxt; cA = nA; cB = nB; ++ui;
        if constexpr (ALIGN_EPI) { if (wr == 1) PG8_BAR; }
    }
    PG8_WAIT_V(0);
    if constexpr (!ALIGN_EPI) { if (wr == 0) PG8_BAR; }
    PG8_BAR;
    if constexpr (Epi::AFTER_DRAIN) { E.fused(acc, cur, wr, wc, fr, fq, lds, wid, lane); S.done(cur); }
#undef PG8_SA
#undef PG8_SB
#undef PG8_STAGE
#undef PG8_LDA
#undef PG8_LDB
#undef PG8_MMA
#undef PG8_WAIT_V
#undef PG8_WAIT_L
#undef PG8_BAR
#undef PG8_SCHED
}
}
#include <hip/hip_bf16.h>
#include <cmath>
namespace attn_body {
using bf16=__hip_bfloat16;
using bf16x8=__attribute__((ext_vector_type(8)))short;
using s16x4=__attribute__((ext_vector_type(4)))short;
using f32x16=__attribute__((ext_vector_type(16)))float;
using u32x4=__attribute__((ext_vector_type(4)))unsigned;
constexpr int BATCH=1,NHEAD=16,SEQ=16384,D=64,DM=NHEAD*D,KVP=256,NKT=260;
constexpr int NW=8,QBLK=32,QB=QBLK*NW,KVBLK=64,NQB=SEQ/QB;
constexpr int ATTN_PITCH=DM, ATTN_UNIT_ROWS=QB;
__device__ __forceinline__ int crow(int r,int hi){return (r&3)+8*(r>>2)+4*hi;}
#define SBAR() __builtin_amdgcn_sched_barrier(0)
__device__ __forceinline__ void cmask(f32x16&p0,f32x16&p1,int jb,int qrel,int hi){
  const float NEG=-INFINITY; int kb=64*jb+4*hi;
  #pragma unroll
  for(int r=0;r<16;++r){int kv=kb+(r&3)+8*(r>>2); if(kv>qrel)p0[r]=NEG; if(kv+32>qrel)p1[r]=NEG;}
}

constexpr int NSLOT=3, SLOTB=8192;
constexpr int LDS_K=0, LDS_V=NSLOT*SLOTB, LDS_WS=2*NSLOT*SLOTB, LDS_OST=LDS_WS+NW*64*4, LDS_BYTES=LDS_OST+NW*4096;
constexpr float C2=0.125f*1.4426950408889634f;
__device__ __forceinline__ void glds16(const void*gsrc,unsigned lds_dst){unsigned keep;
  asm volatile("s_mov_b32 %0, m0\n\ts_mov_b32 m0, %2\n\ts_nop 0\n\tglobal_load_lds_dwordx4 %1, off\n\ts_mov_b32 m0, %0":"=&s"(keep):"v"(gsrc),"s"(lds_dst):"memory");}
__device__ __forceinline__ float max3f(float a,float b,float c){float r;asm("v_max3_f32 %0, %1, %2, %3":"=v"(r):"v"(a),"v"(b),"v"(c));return r;}
__device__ __forceinline__ float max2f(float a,float b){float r;asm("v_max_f32_e32 %0, %1, %2":"=v"(r):"v"(a),"v"(b));return r;}
__device__ __forceinline__ float fadd_s(float a,float b){float r;asm("v_add_f32_e32 %0, %1, %2":"=v"(r):"v"(a),"v"(b));return r;}
__device__ __forceinline__ float fsub_s(float a,float b){float r;asm("v_sub_f32_e32 %0, %1, %2":"=v"(r):"v"(a),"v"(b));return r;}
typedef float f32x2_t __attribute__((ext_vector_type(2))); typedef __bf16 bf16x2_t __attribute__((ext_vector_type(2)));
__device__ __forceinline__ unsigned cvtpk_s(float lo,float hi){f32x2_t v={lo,hi};bf16x2_t b=__builtin_convertvector(v,bf16x2_t);return __builtin_bit_cast(unsigned,b);}
#define WAIT_BAR(N) asm volatile("s_waitcnt vmcnt(" #N ") lgkmcnt(0)\n\ts_barrier":::"memory")

__device__ __forceinline__ void qkt(f32x16&p0,f32x16&p1,const char*Kslot,const bf16x8*qr,const f32x16&negm,int r32,int hi){
  const char*kb=Kslot+hi*1024+r32*16;
  #pragma unroll
  for(int d0=0;d0<4;++d0){
    const bf16x8 b0=*reinterpret_cast<const bf16x8*>(kb+d0*2048);
    const bf16x8 b1=*reinterpret_cast<const bf16x8*>(kb+d0*2048+512);
    if(d0==0){p0=__builtin_amdgcn_mfma_f32_32x32x16_bf16(b0,qr[0],negm,0,0,0);p1=__builtin_amdgcn_mfma_f32_32x32x16_bf16(b1,qr[0],negm,0,0,0);}
    else{p0=__builtin_amdgcn_mfma_f32_32x32x16_bf16(b0,qr[d0],p0,0,0,0);p1=__builtin_amdgcn_mfma_f32_32x32x16_bf16(b1,qr[d0],p1,0,0,0);}}
}
typedef __attribute__((address_space(3))) const char* lds_cptr;
typedef short v4i16_t __attribute__((ext_vector_type(4)));
__device__ __forceinline__ void kload8(bf16x8*kf,lds_cptr kp){
  kf[0]=*(const __attribute__((address_space(3))) bf16x8*)(kp);      kf[1]=*(const __attribute__((address_space(3))) bf16x8*)(kp+512);
  kf[2]=*(const __attribute__((address_space(3))) bf16x8*)(kp+2048); kf[3]=*(const __attribute__((address_space(3))) bf16x8*)(kp+2560);
  kf[4]=*(const __attribute__((address_space(3))) bf16x8*)(kp+4096); kf[5]=*(const __attribute__((address_space(3))) bf16x8*)(kp+4608);
  kf[6]=*(const __attribute__((address_space(3))) bf16x8*)(kp+6144); kf[7]=*(const __attribute__((address_space(3))) bf16x8*)(kp+6656);
}
__device__ __forceinline__ void kload2(bf16x8*kf,lds_cptr kp,int j){ kf[2*j]=*(const __attribute__((address_space(3))) bf16x8*)(kp+j*2048); kf[2*j+1]=*(const __attribute__((address_space(3))) bf16x8*)(kp+j*2048+512); }
__device__ __forceinline__ s16x4 vtr(lds_cptr p){ return __builtin_bit_cast(s16x4,__builtin_amdgcn_ds_read_tr16_b64_v4i16((__attribute__((address_space(3))) v4i16_t*)p)); }
__device__ __forceinline__ float rowmax(const f32x16&p0,const f32x16&p1){
  float a=max3f(p0[0],p0[1],p1[0]),b=max3f(p0[2],p0[3],p1[1]);a=max3f(a,p1[2],p1[3]);
  #pragma unroll
  for(int r=4;r<16;r+=4){a=max3f(a,p0[r],p0[r+1]);b=max3f(b,p0[r+2],p0[r+3]);a=max3f(a,p1[r],p1[r+1]);b=max3f(b,p1[r+2],p1[r+3]);}
  const float m=max2f(a,b);
  auto rr=__builtin_amdgcn_permlane32_swap(__float_as_uint(m),__float_as_uint(m),false,false);
  return max2f(__uint_as_float(rr[0]),__uint_as_float(rr[1]));
}
__device__ __forceinline__ void pv(f32x16*o,int vb,bf16x8 pa0,bf16x8 pa1,bf16x8 pa2,bf16x8 pa3){
  #pragma unroll
  for(int d0=0;d0<2;++d0){s16x4 lo[4],hi[4];
    #pragma unroll
    for(int ks=0;ks<4;++ks){
      asm volatile("ds_read_b64_tr_b16 %0,%1 offset:%c2":"=&v"(lo[ks]):"v"(vb),"i"(d0*4096+ks*1024):"memory");
      asm volatile("ds_read_b64_tr_b16 %0,%1 offset:%c2":"=&v"(hi[ks]):"v"(vb),"i"(d0*4096+ks*1024+512):"memory");}
    asm volatile("s_waitcnt lgkmcnt(0)":::"memory");SBAR();
    #define PK(k) (bf16x8){lo[k][0],lo[k][1],lo[k][2],lo[k][3],hi[k][0],hi[k][1],hi[k][2],hi[k][3]}
    o[d0]=__builtin_amdgcn_mfma_f32_32x32x16_bf16(pa0,PK(0),o[d0],0,0,0);
    o[d0]=__builtin_amdgcn_mfma_f32_32x32x16_bf16(pa1,PK(1),o[d0],0,0,0);
    o[d0]=__builtin_amdgcn_mfma_f32_32x32x16_bf16(pa2,PK(2),o[d0],0,0,0);
    o[d0]=__builtin_amdgcn_mfma_f32_32x32x16_bf16(pa3,PK(3),o[d0],0,0,0);
    #undef PK
  }
}

#ifndef ATTN_STORE16
#define ATTN_STORE16(p,v) (*(u32x4*)(p)=(v))
#endif
template<int THRL> __device__ __forceinline__ void attn_unit(int b,int h,int qb,const bf16*Q,const bf16*__restrict__ K,const bf16*__restrict__ V,bf16*O,char*shm){
  int tid_=threadIdx.x; asm volatile("":"+v"(tid_)); const int tid=tid_,lane=tid&63,r32=lane&31,hi=lane>>5; const int wid=__builtin_amdgcn_readfirstlane(tid>>6);
  const long rowbase=(long)b*SEQ; const int q0=qb*QB;
  const bf16*Qw=Q+(rowbase+q0+wid*QBLK)*DM+h*D;
  const bf16*Kh=K+(h>>2)*D,*Vh=V+(h>>2)*D;
  const unsigned lds0=(unsigned)(uintptr_t)shm;
  float*wsf=(float*)(shm+LDS_WS)+wid*64;
  const bf16*ksrc=Kh+(long)lane*KVP+wid*8;
  const bf16*vsrc=Vh+(long)(16*(wid&3)+(lane>>2))*KVP+(wid>>2)*32+(lane&3)*8;
  const unsigned kdst=lds0+LDS_K+wid*1024, vdst=lds0+LDS_V+wid*1024;
  #define DMA_K(t,slot) glds16(ksrc+(long)(t)*KVBLK*KVP,(unsigned)__builtin_amdgcn_readfirstlane(kdst+(slot)))
  #define DMA_V(t,slot) glds16(vsrc+(long)(t)*KVBLK*KVP,(unsigned)__builtin_amdgcn_readfirstlane(vdst+(slot)))
  const int vb0=(int)(lds0+LDS_V)+((lane>>4)&1)*32+(lane&3)*8+(4*hi+((lane&15)>>2))*64;
  const char*Kbase=shm+LDS_K; bf16x8 kf[8];
  const lds_cptr shm3=(lds_cptr)shm; const lds_cptr kp0=shm3+LDS_K+hi*1024+r32*16; const lds_cptr vp0=shm3+LDS_V+((lane>>4)&1)*32+(lane&3)*8+(4*hi+((lane&15)>>2))*64;
  const int NT=NKT;
  DMA_K(0,0);DMA_V(0,0);DMA_K(1,SLOTB);
  bf16x8 qr[4];
  #pragma unroll
  for(int d0=0;d0<4;++d0)qr[d0]=*reinterpret_cast<const bf16x8*>(&Qw[(long)r32*DM+d0*16+hi*8]);
  float mhat=0.f,l_reg=0.f;f32x16 o[2];o[0]=f32x16{};o[1]=f32x16{};f32x16 negm=f32x16{};asm volatile("":"+v"(negm));
  const int qrel=wid*QBLK+r32;
  #define CMASK(P0,P1,t) do{}while(0)
  bool resc=false;
  #define START(P0,P1) do{ const float rm=rowmax(P0,P1); resc=false; \
    { const float dl=rm; mhat=fadd_s(mhat,dl); \
      _Pragma("unroll") for(int r=0;r<16;++r){P0[r]=fsub_s(P0[r],dl);P1[r]=fsub_s(P1[r],dl);} \
      _Pragma("unroll") for(int r=0;r<16;++r)negm[r]=-mhat; asm volatile("":"+v"(negm)); } \
    _Pragma("unroll") for(int r=0;r<16;++r)P0[r]=__builtin_amdgcn_exp2f(P0[r]); }while(0)
  #define RESC() do{ if(resc){ asm volatile("s_waitcnt lgkmcnt(0)":::"memory"); \
      _Pragma("unroll") for(int d_=0;d_<2;++d_) _Pragma("unroll") for(int r=0;r<16;++r)o[d_][r]*=wsf[crow(r,hi)]; } }while(0)
  f32x16 pA0,pA1,pB0,pB1;
  int sl_prev=0,sl_cur=0,sl_next=SLOTB;
  #define ROT() do{sl_prev=sl_cur;sl_cur=sl_next;sl_next=(sl_next==(NSLOT-1)*SLOTB)?0:sl_next+SLOTB;}while(0)
  DMA_K(2,2*SLOTB);
  WAIT_BAR(3);
  qkt(pA0,pA1,Kbase,qr,negm,r32,hi);asm volatile("s_nop 15\n\ts_nop 7":"+v"(pA0),"+v"(pA1));CMASK(pA0,pA1,0);
  START(pA0,pA1);
  _Pragma("unroll") for(int r=0;r<16;++r)pA1[r]=__builtin_amdgcn_exp2f(pA1[r]);
  WAIT_BAR(0);
  DMA_K(3,0);DMA_V(1,SLOTB);
  ROT();
  kload8(kf,kp0+sl_cur);
  WAIT_BAR(2);
  s16x4 vlo[8],vhi[8]; u32x4 pw0,pw1,pw2,pw3;
  #define PKW(P,B) cvtpk_s(P[B],P[B+1])
  #define PAF(k) __builtin_bit_cast(bf16x8,pw##k)
  #define VFR(i) (bf16x8){vlo[i][0],vlo[i][1],vlo[i][2],vlo[i][3],vhi[i][0],vhi[i][1],vhi[i][2],vhi[i][3]}
  #define PIN(x) asm volatile("":"+v"(x))
  #define MX3(a,b,c) __builtin_fmaxf(__builtin_fmaxf((a),(b)),(c))
  #define GAPA(MF,A0,A1,A2,A3,W0,W1,PW) do{ MF; sacc+=A0; sacc+=A1; sacc+=A2; sacc+=A3; PIN(sacc); W0; W1; PIN(PW); SBAR(); }while(0)
  #define EX(v) __builtin_amdgcn_exp2f(v)
  #define GAPB(MF,X,B) do{ MF; X[B]=EX(X[B]); X[B+1]=EX(X[B+1]); X[B+2]=EX(X[B+2]); X[B+3]=EX(X[B+3]); PIN(X); SBAR(); }while(0)
  #define VRD(i) do{ vlo[i]=vtr(vp_+(((i)>>2)*4096+((i)&3)*1024)); vhi[i]=vtr(vp_+(((i)>>2)*4096+((i)&3)*1024+512)); }while(0)
  #define KRD(G,j) do{ if(G){ kload2(kf,kp0+sl_next,j); SBAR(); } }while(0)
  #define STEP(C0,C1,P0,P1,t,GK,GV,GL) do{ SBAR(); \
    const lds_cptr vp_=vp0+sl_prev; \
    VRD(0); SBAR(); float sacc=(P0[0]+P0[1]); \
    GAPA(C0=__builtin_amdgcn_mfma_f32_32x32x16_bf16(kf[0],qr[0],negm,0,0,0), P0[2],P0[3],P0[4],P0[5],     pw0[0]=PKW(P0,0), pw0[1]=PKW(P0,2), pw0); \
    VRD(4); SBAR(); GAPA(C1=__builtin_amdgcn_mfma_f32_32x32x16_bf16(kf[1],qr[0],negm,0,0,0), P0[6],P0[7],P0[8],P0[9],     pw0[2]=PKW(P0,4), pw0[3]=PKW(P0,6), pw0); \
    VRD(1); SBAR(); GAPA(C0=__builtin_amdgcn_mfma_f32_32x32x16_bf16(kf[2],qr[1],C0,0,0,0),   P0[10],P0[11],P0[12],P0[13], pw1[0]=PKW(P0,8), pw1[1]=PKW(P0,10), pw1); \
    VRD(5); SBAR(); GAPA(C1=__builtin_amdgcn_mfma_f32_32x32x16_bf16(kf[3],qr[1],C1,0,0,0),   P0[14],P0[15],P1[0],P1[1],   pw1[2]=PKW(P0,12),pw1[3]=PKW(P0,14), pw1); \
    VRD(2); SBAR(); GAPA(C0=__builtin_amdgcn_mfma_f32_32x32x16_bf16(kf[4],qr[2],C0,0,0,0),   P1[2],P1[3],P1[4],P1[5],     pw2[0]=PKW(P1,0), pw2[1]=PKW(P1,2), pw2); \
    VRD(6); SBAR(); GAPA(C1=__builtin_amdgcn_mfma_f32_32x32x16_bf16(kf[5],qr[2],C1,0,0,0),   P1[6],P1[7],P1[8],P1[9],     pw2[2]=PKW(P1,4), pw2[3]=PKW(P1,6), pw2); \
    VRD(3); SBAR(); GAPA(C0=__builtin_amdgcn_mfma_f32_32x32x16_bf16(kf[6],qr[3],C0,0,0,0),   P1[10],P1[11],P1[12],P1[13], pw3[0]=PKW(P1,8), pw3[1]=PKW(P1,10), pw3); \
    VRD(7); SBAR(); GAPA(C1=__builtin_amdgcn_mfma_f32_32x32x16_bf16(kf[7],qr[3],C1,0,0,0),   P1[14],P1[15],0.f,0.f,       pw3[2]=PKW(P1,12),pw3[3]=PKW(P1,14), pw3); \
    l_reg+=sacc; \
    if(GK){DMA_K((t)+3,sl_cur);} if(GV){DMA_V((t)+1,sl_next);} \
    CMASK(C0,C1,t); \
    { float a=MX3(C0[0],C0[1],C1[0]),b=MX3(C0[2],C0[3],C1[1]); a=MX3(a,C1[2],C1[3]); \
      _Pragma("unroll") for(int r=4;r<16;r+=4){a=MX3(a,C0[r],C0[r+1]);b=MX3(b,C0[r+2],C0[r+3]);a=MX3(a,C1[r],C1[r+1]);b=MX3(b,C1[r+2],C1[r+3]);} \
      float rm=__builtin_fmaxf(a,b); { auto rr=__builtin_amdgcn_permlane32_swap(__float_as_uint(rm),__float_as_uint(rm),false,false); rm=__builtin_fmaxf(__uint_as_float(rr[0]),__uint_as_float(rr[1])); } \
      resc=false; \
      if(__builtin_expect(__any(rm>(float)THRL),0)){ const float dl=__builtin_fmaxf(rm,0.f); mhat+=dl; \
        _Pragma("unroll") for(int r=0;r<16;++r){C0[r]-=dl;C1[r]-=dl;} \
        _Pragma("unroll") for(int r=0;r<16;++r)negm[r]=-mhat; asm volatile("":"+v"(negm)); \
        const float f=__builtin_amdgcn_exp2f(-dl); l_reg*=f; if(hi==0)wsf[r32]=f; resc=true; } } \
    SBAR(); \
    GAPB(o[0]=__builtin_amdgcn_mfma_f32_32x32x16_bf16(PAF(0),VFR(0),o[0],0,0,0), C0,0); \
    GAPB(o[1]=__builtin_amdgcn_mfma_f32_32x32x16_bf16(PAF(0),VFR(4),o[1],0,0,0), C0,4); \
    KRD(GL,0); GAPB(o[0]=__builtin_amdgcn_mfma_f32_32x32x16_bf16(PAF(1),VFR(1),o[0],0,0,0), C0,8); \
    KRD(GL,1); GAPB(o[1]=__builtin_amdgcn_mfma_f32_32x32x16_bf16(PAF(1),VFR(5),o[1],0,0,0), C0,12); \
    KRD(GL,2); GAPB(o[0]=__builtin_amdgcn_mfma_f32_32x32x16_bf16(PAF(2),VFR(2),o[0],0,0,0), C1,0); \
    KRD(GL,3); GAPB(o[1]=__builtin_amdgcn_mfma_f32_32x32x16_bf16(PAF(2),VFR(6),o[1],0,0,0), C1,4); \
    GAPB(o[0]=__builtin_amdgcn_mfma_f32_32x32x16_bf16(PAF(3),VFR(3),o[0],0,0,0), C1,8); \
    GAPB(o[1]=__builtin_amdgcn_mfma_f32_32x32x16_bf16(PAF(3),VFR(7),o[1],0,0,0), C1,12); \
    }while(0)
  int t=1;
  #undef CMASK
  #define CMASK(P0,P1,t) do{}while(0)
  asm volatile(".p2align 6\n\t.rept 8\n\ts_nop 0\n\t.endr":::"memory");
  for(;t+5<NT;t+=2){
    STEP(pB0,pB1,pA0,pA1,t,true,true,true);     WAIT_BAR(2); RESC(); ROT();
    STEP(pA0,pA1,pB0,pB1,t+1,true,true,true);   WAIT_BAR(2); RESC(); ROT();
  }
  #undef CMASK
  #define CMASK(P0,P1,t) do{}while(0)
  #define ENDW(tt) do{ if((tt)+3<NT){WAIT_BAR(2);} else if((tt)+2<NT){WAIT_BAR(1);} else {WAIT_BAR(0);} }while(0)
  for(;t+1<NT;t+=2){
    STEP(pB0,pB1,pA0,pA1,t,(t+3<NT),(t+1<NT),(t+1<NT));       ENDW(t);   RESC(); ROT();
    STEP(pA0,pA1,pB0,pB1,t+1,(t+4<NT),(t+2<NT),(t+2<NT));     ENDW(t+1); RESC(); ROT();
  }
  STEP(pB0,pB1,pA0,pA1,NT-1,false,false,false); RESC();
  { float sacc=pB0[0]+pB0[1]; _Pragma("unroll") for(int r=2;r<16;++r)sacc+=pB0[r]; _Pragma("unroll") for(int r=0;r<16;++r)sacc+=pB1[r]; l_reg+=sacc;
    pw0=(u32x4){PKW(pB0,0),PKW(pB0,2),PKW(pB0,4),PKW(pB0,6)};pw1=(u32x4){PKW(pB0,8),PKW(pB0,10),PKW(pB0,12),PKW(pB0,14)};pw2=(u32x4){PKW(pB1,0),PKW(pB1,2),PKW(pB1,4),PKW(pB1,6)};pw3=(u32x4){PKW(pB1,8),PKW(pB1,10),PKW(pB1,12),PKW(pB1,14)};
    SBAR(); pv(o,vb0+sl_cur,PAF(0),PAF(1),PAF(2),PAF(3)); }
  #undef PKW
  #undef PAF
  #undef VFR
  #undef PIN
  #undef MX3
  #undef GAPA
  #undef GAPB
  #undef EX
  #undef VRD
  #undef KRD
  #undef STEP
  #undef ENDW
  {auto rr=__builtin_amdgcn_permlane32_swap(__float_as_uint(l_reg),__float_as_uint(l_reg),false,false);l_reg=__uint_as_float(rr[0])+__uint_as_float(rr[1]);}
  if(hi==0)wsf[32+r32]=l_reg;asm volatile("s_waitcnt lgkmcnt(0)":::"memory");
  float rli[16];
  #pragma unroll
  for(int r=0;r<16;++r)rli[r]=__builtin_amdgcn_rcpf(wsf[32+crow(r,hi)]);
  bf16*Ow=O+(rowbase+q0+wid*QBLK)*DM+h*D;
  { bf16*stg=(bf16*)(shm+LDS_OST)+wid*2048;
    #pragma unroll
    for(int r=0;r<16;++r){const int orow=crow(r,hi);
      #pragma unroll
      for(int d0=0;d0<2;++d0)stg[orow*64+d0*32+r32]=__float2bfloat16(o[d0][r]*rli[r]);}
    asm volatile("s_waitcnt lgkmcnt(0)":::"memory");
    #pragma unroll
    for(int i=0;i<4;++i){const int row=i*8+(lane>>3),ch=lane&7; const u32x4 v=*(const u32x4*)(stg+row*64+ch*8); ATTN_STORE16(Ow+(long)row*DM+ch*8,v);} }
  asm volatile("s_waitcnt lgkmcnt(0)\n\ts_barrier":::"memory");
  #undef DMA_K
  #undef DMA_V
  #undef CMASK
  #undef START
  #undef RESC
  #undef ROT
}
constexpr int ATTN_LDS_BYTES=LDS_BYTES;
struct AttnTensors { const bf16* Q; const bf16* K; const bf16* V; bf16* O; };
struct AttnUnit { int bh; int qb; };
struct StaticOrder {
  int vcu;
  __device__ __forceinline__ explicit StaticOrder(int grid,int block):vcu((grid%8==0)?(block%8)*(grid/8)+block/8:block){}
  __device__ __forceinline__ bool next(int i,AttnUnit&u)const{ if(i>=4)return false; const int x=vcu>>5, c=vcu&31; const int ul=(x&1)*128+c*4+i; u.bh=(x>>1)*4+(ul>>6); u.qb=ul&63; return true; }
  __device__ __forceinline__ void a_ready(const AttnUnit&)const{}
  __device__ __forceinline__ void done(const AttnUnit&)const{}
};
template<class Sched,int THRL=8> __device__ __forceinline__ void attn_phase(char*lds,const AttnTensors&T,const Sched&S){
  AttnUnit u;
  for(int i=0;S.next(i,u);++i){ S.a_ready(u); attn_unit<THRL>(u.bh/NHEAD,u.bh%NHEAD,u.qb,T.Q,T.K,T.V,T.O,lds); S.done(u); }
}
#undef SBAR
#undef WAIT_BAR
}
typedef unsigned short bf16;
typedef float f32x4 __attribute__((ext_vector_type(4)));
typedef float f32x2 __attribute__((ext_vector_type(2)));
typedef unsigned u32x4 __attribute__((ext_vector_type(4)));
typedef unsigned u32x2 __attribute__((ext_vector_type(2)));
#define LAS3 __attribute__((address_space(3)))

constexpr int T = 16640, NCTX = 256, NLAT = 16384, DM = 1024, FF = 4096, NQKV = 1536;
constexpr float EPS = 1e-6f;
constexpr size_t MiB = 1u << 20;
constexpr size_t WS_MOD = 0, WS_S5A = 128 * 1024, WS_S5BB = 256 * 1024, WS_ROPE = 768 * 1024;
constexpr size_t WS_WIN = 2 * MiB, WS_WGLU = 4 * MiB, WS_WOUT = 5 * MiB, WS_W1_0 = 7 * MiB, WS_W2_0 = 15 * MiB, WS_WQKV = 23 * MiB, WS_WAO = 26 * MiB, WS_W1_1 = 28 * MiB, WS_W2_1 = 36 * MiB;
constexpr size_t WS_XC = 44 * MiB, WS_H = 45 * MiB, WS_Y = 78 * MiB, WS_BIG = 111 * MiB;
constexpr size_t WS_U = WS_BIG, WS_G = 144 * MiB, WS_Z = 161 * MiB, WS_S5E = 194 * MiB, WS_S5H = 203 * MiB;
constexpr size_t WS_O = WS_BIG;
constexpr size_t WS_QKV = WS_BIG, WS_Q = 160 * MiB, WS_K = 193 * MiB, WS_V = 202 * MiB;
constexpr size_t WS_AP = 1 * MiB;
constexpr size_t WS_KS = 194 * MiB, WS_CA = 198 * MiB, WS_BA = 202 * MiB;
constexpr size_t OUT_E = 0, OUT_HIN = 40 * MiB;
constexpr int NC16 = 1040;
constexpr size_t WS_MODP = 243 * MiB;
constexpr size_t WS_CTL = 0x1C0000;
constexpr size_t WS_XB = 242 * MiB;
constexpr size_t WS_END = 246 * MiB;
constexpr int LDS_TOTAL = 143360 + 64;
constexpr size_t WS_BAR = 0x1F0000;
constexpr int NCH = 260;

struct Params { const float* in[26]; float* out; unsigned char* ws; };
typedef const __attribute__((address_space(4))) Params* KP;

__device__ __forceinline__ float wave_sum(float v) {
#pragma unroll
    for (int o = 1; o < 64; o <<= 1) v += __shfl_xor(v, o);
    return v;
}
__device__ __forceinline__ float siluf(float x) { return x / (1.f + __expf(-x)); }
__device__ __forceinline__ unsigned f2bf(float f) { unsigned u = __float_as_uint(f); return (u + 0x7fffu + ((u >> 16) & 1u)) >> 16; }
__device__ __forceinline__ unsigned pk2(float lo, float hi) { return f2bf(lo) | (f2bf(hi) << 16); }
__device__ __forceinline__ float bflo(unsigned w) { return __uint_as_float(w << 16); }
__device__ __forceinline__ float bfhi(unsigned w) { return __uint_as_float(w & 0xffff0000u); }
__device__ __forceinline__ float gelu_tanh(float x) { const float a = 0.7978845608028654f * (x + 0.044715f * x * x * x); const float th = 1.f - 2.f / (1.f + __expf(2.f * a)); return 0.5f * x * (1.f + th); }

__device__ __forceinline__ void tr_item(const float* W, int ldw, bf16* WT, int ldt, float* scr, int lane) {
#pragma unroll 16
    for (int i = 0; i < 32; ++i) { const int kk = 2 * i + (lane >> 5); scr[kk * 33 + (lane & 31)] = __builtin_nontemporal_load(W + (size_t)kk * ldw + (lane & 31)); }
    __builtin_amdgcn_wave_barrier();
    const int c = lane & 7;
#pragma unroll
    for (int j = 0; j < 4; ++j) { const int n = (lane >> 3) + 8 * j; const float* s = scr + (8 * c) * 33 + n;
        u32x4 o; o.x = pk2(s[0 * 33], s[1 * 33]); o.y = pk2(s[2 * 33], s[3 * 33]); o.z = pk2(s[4 * 33], s[5 * 33]); o.w = pk2(s[6 * 33], s[7 * 33]);
        *(u32x4*)(WT + (size_t)n * ldt + 8 * c) = o; }
    __builtin_amdgcn_wave_barrier();
}

__device__ __forceinline__ void tr_one(KP p, int it, float* scr, int lane) {
    constexpr int I_IN = 512, I_GLU = 256, I_OUT = 256, I_W1 = 2048, I_W2 = 2048, I_QKV = 768, I_AO = 512;
    int r = it; const float* W; int N, ldt; bf16* WT; bool glu = false;
    if (r < I_IN) { W = p->in[9]; N = 1024; ldt = 1024; WT = (bf16*)(p->ws + WS_WIN); }
    else if ((r -= I_IN) < I_GLU) { W = p->in[19]; N = 1024; ldt = 512; WT = (bf16*)(p->ws + WS_WGLU); glu = true; }
    else if ((r -= I_GLU) < I_OUT) { W = p->in[10]; N = 1024; ldt = 1024; WT = (bf16*)(p->ws + WS_WOUT); }
    else if ((r -= I_OUT) < I_W1) { W = p->in[7]; N = 4096; ldt = 1024; WT = (bf16*)(p->ws + WS_W1_0); }
    else if ((r -= I_W1) < I_W2) { W = p->in[8]; N = 1024; ldt = 4096; WT = (bf16*)(p->ws + WS_W2_0); }
    else if ((r -= I_W2) < I_QKV) { W = p->in[22]; N = 1536; ldt = 1024; WT = (bf16*)(p->ws + WS_WQKV); }
    else if ((r -= I_QKV) < I_AO) { W = p->in[23]; N = 1024; ldt = 1024; WT = (bf16*)(p->ws + WS_WAO); }
    else if ((r -= I_AO) < I_W1) { W = p->in[7] + (size_t)1024 * 4096; N = 4096; ldt = 1024; WT = (bf16*)(p->ws + WS_W1_1); }
    else { r -= I_W1; W = p->in[8] + (size_t)4096 * 1024; N = 1024; ldt = 4096; WT = (bf16*)(p->ws + WS_W2_1); }
    const int nblk = N / 32, kb = r / nblk, nb = r % nblk, k0 = 64 * kb, n0 = 32 * nb;
    int drow = n0;
    if (glu) { const int bj = n0 >> 9, rem = n0 & 511; drow = 256 * (rem >> 7) + 128 * bj + (rem & 127); }
    tr_item(W + (size_t)k0 * N + n0, N, WT + (size_t)drow * ldt + k0, ldt, scr, lane);
}
__device__ __forceinline__ void prologue(KP p, unsigned char* lds, int tid, int lane, int wave) {
    float* misc = (float*)(lds + 131072);
    { const float* c = p->in[1]; const float* cc = p->in[3];
      for (int i = tid; i < 1024; i += 512) { misc[i] = siluf(c[i]); misc[1024 + i] = siluf(cc[i]); } }
    __syncthreads();
    float* modv = (float*)(p->ws + WS_MOD);
    float* scr = (float*)(lds + wave * 16384);
    const int gw = blockIdx.x * 8 + wave, NGW = gridDim.x * 8, half = NGW >> 1;
    constexpr int NITEMS = 512 + 256 + 256 + 2 * (2048 + 2048) + 768 + 512;
    const int TRA = 4608;
    if (gw < half) {
        for (int wi = gw; wi < 1024; wi += half) {
            const int id = wi * 64 + lane, n = id & 1023, ib = (id >> 10) & 15, gi = id >> 14;
            const float* pw = p->in[20] + (size_t)gi * 16384 + (size_t)(ib * 8) * 128;
            const float* sc = p->in[21] + gi * 128;
            const float* wo = p->in[10] + (size_t)(512 + gi * 128) * 1024 + n;
            float acc[8];
#pragma unroll
            for (int e = 0; e < 8; ++e) acc[e] = 0.f;
#pragma unroll 8
            for (int j = 0; j < 128; ++j) { const float wv = wo[(size_t)j * 1024] * sc[j];
#pragma unroll
                for (int e = 0; e < 8; ++e) acc[e] += pw[e * 128 + j] * wv; }
            u32x4 o; o.x = pk2(acc[0], acc[1]); o.y = pk2(acc[2], acc[3]); o.z = pk2(acc[4], acc[5]); o.w = pk2(acc[6], acc[7]);
            *(u32x4*)((bf16*)(p->ws + WS_WOUT) + (size_t)n * 1024 + 512 + gi * 128 + ib * 8) = o;
        }
        for (int it = gw; it < TRA; it += half) tr_one(p, it, scr, lane);
    } else {
        const int gb = gw - half;
        for (int it = gb; it < 2 * 96 * 8; it += half) {
            const int l = it / 768, r = it % 768, cb = r >> 3, kq = r & 7;
            const float* w = p->in[4] + (size_t)l * 1024 * 6144 + cb * 64 + lane;
            float a0 = 0.f, a1 = 0.f;
#pragma unroll 32
            for (int k = kq * 128; k < kq * 128 + 128; ++k) { const float wv = __builtin_nontemporal_load(w + (size_t)k * 6144); a0 += misc[k] * wv; a1 += misc[1024 + k] * wv; }
            float* mp = (float*)(p->ws + WS_MODP) + (size_t)((l * 8 + kq) * 2) * 6144 + cb * 64 + lane; mp[0] = a0; mp[6144] = a1;
        }
        for (int it = TRA + gb; it < NITEMS; it += half) tr_one(p, it, scr, lane);
    }
    const int gt = blockIdx.x * 512 + tid, NTH = gridDim.x * 512;
    for (int id = gt; id < 4096; id += NTH) {
        const float lr = p->in[11][id], li = p->in[12][id], dt = __expf(p->in[13][id >> 6]);
        const float mag = expf(lr * dt), ar = mag * cosf(li * dt), ai = mag * sinf(li * dt);
        const float den = lr * lr + li * li;
        const float fr = ((ar - 1.f) * lr + ai * li) / den, fi = (ai * lr - (ar - 1.f) * li) / den;
        float* A = (float*)(p->ws + WS_S5A); A[2 * id] = ar; A[2 * id + 1] = ai;
        float* BB = (float*)(p->ws + WS_S5BB) + (size_t)id * 32;
        const float* br = p->in[14] + (size_t)id * 16; const float* bi = p->in[15] + (size_t)id * 16;
#pragma unroll
        for (int c = 0; c < 16; ++c) { const float x = br[c], y = bi[c]; BB[c] = fr * x - fi * y; BB[16 + c] = fr * y + fi * x; }
        const int pos = id >> 4, fq = id & 15;
        const float inv = powf(10000.f, -(float)fq / 16.f), ang = (float)pos * inv;
        float* R = (float*)(p->ws + WS_ROPE); R[2 * id] = cosf(ang); R[2 * id + 1] = sinf(ang);
    }
    for (int id = gt; id < 64 * 17 * 64; id += NTH) {
        const int pp = id & 63, d = (id >> 6) % 17, dg = id / (64 * 17);
        const float lr = p->in[11][dg * 64 + pp], li = p->in[12][dg * 64 + pp], e = (float)d * expf(p->in[13][dg]);
        const float mag = expf(lr * e), ang = li * e;
        ((f32x2*)(p->ws + WS_AP))[id] = (f32x2){mag * cosf(ang), mag * sinf(ang)};
    }
}

struct RowP { const float* xlat; const float* xctx; float* olat; float* octx; const bf16* Y; const float* gA; const float* gate;
              const float* gB; const float* shsc; bf16* H; int r0; int r1; int xb_in; int xb_out; };
struct RowRegs { f32x4 v[4]; u32x2 y[4]; };
__device__ __forceinline__ void row_load(RowRegs& R, const RowP& a, int r, int lane) {
    const bool isctx = r < NCTX;
    const float* xs = isctx ? a.xctx + (size_t)r * DM : a.xlat + (size_t)(r - NCTX) * DM;
    if (!isctx && a.xb_in) {
#pragma unroll
        for (int j = 0; j < 4; ++j) { const u32x2 w = ((const u32x2*)xs)[lane + 64 * j]; R.v[j] = (f32x4){bflo(w.x), bfhi(w.x), bflo(w.y), bfhi(w.y)}; }
    } else if (!isctx) {
#pragma unroll
        for (int j = 0; j < 4; ++j) R.v[j] = __builtin_nontemporal_load((const f32x4*)xs + lane + 64 * j);
    } else {
#pragma unroll
        for (int j = 0; j < 4; ++j) R.v[j] = ((const f32x4*)xs)[lane + 64 * j];
    }
    if (a.Y) {
#pragma unroll
        for (int j = 0; j < 4; ++j) R.y[j] = __builtin_nontemporal_load((const u32x2*)(a.Y + (size_t)r * DM) + lane + 64 * j);
    }
}
__device__ __forceinline__ void row_finish(RowRegs& R, const RowP& a, int r, int lane) {
    const bool isctx = r < NCTX; const int vo = isctx ? 6144 : 0;
    f32x4 v[4];
#pragma unroll
    for (int j = 0; j < 4; ++j) v[j] = R.v[j];
    if (a.Y) {
        f32x4 y[4]; float ss = 0.f;
#pragma unroll
        for (int j = 0; j < 4; ++j) { const u32x2 w = R.y[j]; y[j] = (f32x4){bflo(w.x), bfhi(w.x), bflo(w.y), bfhi(w.y)};
            ss += (y[j].x * y[j].x + y[j].y * y[j].y) + (y[j].z * y[j].z + y[j].w * y[j].w); }
        const float rstd = rsqrtf(wave_sum(ss) * (1.f / DM) + EPS);
#pragma unroll
        for (int j = 0; j < 4; ++j) { const f32x4 g = ((const f32x4*)a.gA)[lane + 64 * j], gt = ((const f32x4*)(a.gate + vo))[lane + 64 * j];
            v[j] = v[j] + gt * (y[j] * rstd * g); }
    }
    if (isctx) { if (a.Y && a.octx) { float* xo = a.octx + (size_t)r * DM;
#pragma unroll
            for (int j = 0; j < 4; ++j) ((f32x4*)xo)[lane + 64 * j] = v[j]; } }
    else if (a.olat) { float* xo = a.olat + (size_t)(r - NCTX) * DM;
        if (a.xb_out) {
#pragma unroll
            for (int j = 0; j < 4; ++j) { u32x2 o; o.x = pk2(v[j].x, v[j].y); o.y = pk2(v[j].z, v[j].w); ((u32x2*)xo)[lane + 64 * j] = o; }
        } else {
#pragma unroll
            for (int j = 0; j < 4; ++j) ((f32x4*)xo)[lane + 64 * j] = v[j];
        } }
    if (a.H) {
        float ss = 0.f;
#pragma unroll
        for (int j = 0; j < 4; ++j) ss += (v[j].x * v[j].x + v[j].y * v[j].y) + (v[j].z * v[j].z + v[j].w * v[j].w);
        const float rstd = rsqrtf(wave_sum(ss) * (1.f / DM) + EPS);
#pragma unroll
        for (int j = 0; j < 4; ++j) { const f32x4 g = ((const f32x4*)a.gB)[lane + 64 * j], sh = ((const f32x4*)(a.shsc + vo))[lane + 64 * j], sc = ((const f32x4*)(a.shsc + vo + 1024))[lane + 64 * j];
            const f32x4 h = (v[j] * rstd * g) * (sc + 1.f) + sh;
            u32x2 o; o.x = pk2(h.x, h.y); o.y = pk2(h.z, h.w); ((u32x2*)(a.H + (size_t)r * DM))[lane + 64 * j] = o; }
    }
}
__device__ __forceinline__ void row_phase(const RowP& a, int lane, int wave) {
    const int gw = blockIdx.x * 8 + wave, NGW = gridDim.x * 8;
    for (int r = a.r0 + gw; r < a.r1; r += 3 * NGW) {
        const int r2 = r + NGW, r3 = r + 2 * NGW; RowRegs A, B, C;
        row_load(A, a, r, lane);
        if (r2 < a.r1) row_load(B, a, r2, lane);
        if (r3 < a.r1) row_load(C, a, r3, lane);
        row_finish(A, a, r, lane);
        if (r2 < a.r1) row_finish(B, a, r2, lane);
        if (r3 < a.r1) row_finish(C, a, r3, lane);
    }
}

__device__ __forceinline__ int s5_row(int dir, int j, int sl) { const int s = j * 64 + sl; return dir == 0 ? s : (j < 4 ? 255 - s : 16895 - s); }
__device__ __forceinline__ void s5_stage_u(const bf16* U, int row, int g, float* ut, int lane) {
    const u32x4* src = (const u32x4*)(U + (size_t)row * DM + g * 16);
    const u32x4 a = src[0], b = src[1];
    f32x4* d = (f32x4*)(ut + lane * 16);
    d[0] = (f32x4){bflo(a.x), bfhi(a.x), bflo(a.y), bfhi(a.y)}; d[1] = (f32x4){bflo(a.z), bfhi(a.z), bflo(a.w), bfhi(a.w)};
    d[2] = (f32x4){bflo(b.x), bfhi(b.x), bflo(b.y), bfhi(b.y)}; d[3] = (f32x4){bflo(b.z), bfhi(b.z), bflo(b.w), bfhi(b.w)};
}
#define S5_LOAD_BB(dir, g) do { const f32x4* bp_ = (const f32x4*)((const float*)(p->ws + WS_S5BB) + (size_t)(((dir) * 32 + (g)) * 64 + lane) * 32); \
    _Pragma("unroll") for (int q_ = 0; q_ < 4; ++q_) { const f32x4 t_ = bp_[q_]; bbr[4 * q_] = t_.x; bbr[4 * q_ + 1] = t_.y; bbr[4 * q_ + 2] = t_.z; bbr[4 * q_ + 3] = t_.w; } \
    _Pragma("unroll") for (int q_ = 0; q_ < 4; ++q_) { const f32x4 t_ = bp_[4 + q_]; bbi[4 * q_] = t_.x; bbi[4 * q_ + 1] = t_.y; bbi[4 * q_ + 2] = t_.z; bbi[4 * q_ + 3] = t_.w; } } while (0)
#define S5_STEP(utrow) do { const f32x4* up_ = (const f32x4*)(utrow); float bur_ = 0.f, bui_ = 0.f; \
    _Pragma("unroll") for (int q_ = 0; q_ < 4; ++q_) { const f32x4 u_ = up_[q_]; \
        bur_ += bbr[4 * q_] * u_.x + bbr[4 * q_ + 1] * u_.y + bbr[4 * q_ + 2] * u_.z + bbr[4 * q_ + 3] * u_.w; \
        bui_ += bbi[4 * q_] * u_.x + bbi[4 * q_ + 1] * u_.y + bbi[4 * q_ + 2] * u_.z + bbi[4 * q_ + 3] * u_.w; } \
    const float nr_ = ar * hr - ai * hi + bur_, ni_ = ar * hi + ai * hr + bui_; hr = nr_; hi = ni_; } while (0)

__device__ __forceinline__ void pool_s5a_phase(KP p, int lane, int wave, int b0, int nb) {
    const bf16* U = (const bf16*)(p->ws + WS_U); bf16* Z = (bf16*)(p->ws + WS_Z);
    const int gw = ((int)blockIdx.x - b0) * 8 + wave, NGW = nb * 8;
    for (int it = gw; it < 4 * (T / 4); it += NGW) {
        const int gi = it / (T / 4), r = 4 * (it % (T / 4)) + (lane >> 4), col = 512 + gi * 128 + (lane & 15) * 8;
        const int w = 2 << gi, lo = w >> 1, hi = w - 1 - lo;
        const int s0 = r < NCTX ? 0 : NCTX, s1 = r < NCTX ? NCTX : T;
        const int st = (r - lo) < s0 ? s0 : (r - lo), en = (r + hi + 1) > s1 ? s1 : (r + hi + 1);
        float acc[8];
#pragma unroll
        for (int e = 0; e < 8; ++e) acc[e] = 0.f;
#define POOL_ACC(W) { u32x4 xv[W]; _Pragma("unroll") for (int q = 0; q < W; ++q) { int rr = r - (W / 2) + q; rr = rr < st ? st : (rr >= en ? en - 1 : rr); xv[q] = *(const u32x4*)(U + (size_t)rr * DM + col); } \
        _Pragma("unroll") for (int q = 0; q < W; ++q) { const int rr = r - (W / 2) + q; const float m_ = (rr >= st && rr < en) ? 1.f : 0.f; const u32x4 x = xv[q]; \
            acc[0] += m_ * bflo(x.x); acc[1] += m_ * bfhi(x.x); acc[2] += m_ * bflo(x.y); acc[3] += m_ * bfhi(x.y); acc[4] += m_ * bflo(x.z); acc[5] += m_ * bfhi(x.z); acc[6] += m_ * bflo(x.w); acc[7] += m_ * bfhi(x.w); } }
        if (gi == 0) POOL_ACC(2) else if (gi == 1) POOL_ACC(4) else if (gi == 2) POOL_ACC(8) else POOL_ACC(16)
#undef POOL_ACC
        const u32x4 x = *(const u32x4*)(U + (size_t)r * DM + col);
        const float ic = 1.f / (float)(en - st);
        u32x4 o; o.x = pk2(acc[0] * ic - bflo(x.x), acc[1] * ic - bfhi(x.x)); o.y = pk2(acc[2] * ic - bflo(x.y), acc[3] * ic - bfhi(x.y));
        o.z = pk2(acc[4] * ic - bflo(x.z), acc[5] * ic - bfhi(x.z)); o.w = pk2(acc[6] * ic - bflo(x.w), acc[7] * ic - bfhi(x.w));
        *(u32x4*)(Z + (size_t)r * DM + col) = o;
    }
}
typedef short bf16x8v __attribute__((ext_vector_type(8)));
typedef float f32x16v __attribute__((ext_vector_type(16)));
__device__ __forceinline__ int crow16(int r, int hi) { return (r & 3) + 8 * (r >> 2) + 4 * hi; }
__device__ __forceinline__ size_t frag_idx(int n, int k, int KSN) { return ((size_t)(((n >> 5) * KSN + (k >> 4)) * 64 + ((k >> 3) & 1) * 32 + (n & 31))) * 8 + (k & 7); }
__device__ __forceinline__ void s5_build(KP p, int tid, int part, int b0, int nb) {
    const float* BBt = (const float*)(p->ws + WS_S5BB); const f32x2* AP = (const f32x2*)(p->ws + WS_AP);
    const int gt = ((int)blockIdx.x - b0) * 512 + tid, NTH = nb * 512;
    bf16* KS = (bf16*)(p->ws + WS_KS); bf16* CA = (bf16*)(p->ws + WS_CA); bf16* BA = (bf16*)(p->ws + WS_BA);
    if (part == 1) for (int id = gt; id < 32 * 16 * 256; id += NTH) {
        const int cp = id & 15, c = (id >> 4) & 15, d = (id >> 8) & 15, g = id >> 12;
        float L[2];
#pragma unroll
        for (int dir = 0; dir < 2; ++dir) { const int dg = dir * 32 + g; float acc = 0.f;
            const float* crp = p->in[16] + (size_t)(dg * 16 + c) * 64; const float* cip = p->in[17] + (size_t)(dg * 16 + c) * 64;
#pragma unroll 8
            for (int q = 0; q < 64; ++q) { const f32x2 P = AP[(dg * 17 + d) * 64 + q]; const float Cr = crp[q], Ci = cip[q];
                const float Br = BBt[(size_t)(dg * 64 + q) * 32 + cp], Bi = BBt[(size_t)(dg * 64 + q) * 32 + 16 + cp];
                const float wr = Cr * P.x - Ci * P.y, wi = Cr * P.y + Ci * P.x; acc += wr * Br - wi * Bi; }
            L[dir] = acc; }
        bf16* Kg = KS + (size_t)g * 65536;
        if (d == 0) { const float v = L[0] + L[1] + (c == cp ? p->in[18][g * 16 + c] : 0.f); const bf16 b = (bf16)f2bf(v);
            for (int i = 0; i < 16; ++i) Kg[frag_idx(i * 16 + c, i * 16 + cp, 16)] = b; }
        else { const bf16 bf = (bf16)f2bf(L[0]), br = (bf16)f2bf(L[1]);
            for (int i = 0; i + d < 16; ++i) { Kg[frag_idx((i + d) * 16 + c, i * 16 + cp, 16)] = bf; Kg[frag_idx(i * 16 + c, (i + d) * 16 + cp, 16)] = br; } }
    }
    if (part == 1) for (int id = gt; id < 64 * 256 * 64; id += NTH) {
        const int q = id & 63, n = (id >> 6) & 255, dg = id >> 14, t = n >> 4, c = n & 15, e = (dg < 32) ? t + 1 : 16 - t;
        const f32x2 P = AP[(dg * 17 + e) * 64 + q]; const float Cr = p->in[16][(size_t)(dg * 16 + c) * 64 + q], Ci = p->in[17][(size_t)(dg * 16 + c) * 64 + q];
        CA[(size_t)dg * 32768 + frag_idx(n, q, 8)] = (bf16)f2bf(Cr * P.x - Ci * P.y); CA[(size_t)dg * 32768 + frag_idx(n, 64 + q, 8)] = (bf16)f2bf(-(Cr * P.y + Ci * P.x));
    }
    if (part == 0) for (int id = gt; id < 64 * 64 * 256; id += NTH) {
        const int kk = id & 255, q = (id >> 8) & 63, dg = id >> 14, sdx = kk >> 4, cp = kk & 15, e = (dg < 32) ? 15 - sdx : sdx;
        const f32x2 P = AP[(dg * 17 + e) * 64 + q]; const float Br = BBt[(size_t)(dg * 64 + q) * 32 + cp], Bi = BBt[(size_t)(dg * 64 + q) * 32 + 16 + cp];
        BA[(size_t)dg * 32768 + frag_idx(q, kk, 16)] = (bf16)f2bf(P.x * Br - P.y * Bi); BA[(size_t)dg * 32768 + frag_idx(64 + q, kk, 16)] = (bf16)f2bf(P.x * Bi + P.y * Br);
    }
}
template <int NTL> __device__ __forceinline__ void s5_end_unit(KP p, int ct, int dir, int g, int nt0, int lane) {
    const bf16* U = (const bf16*)(p->ws + WS_U); const bf16* BA = (const bf16*)(p->ws + WS_BA); float* E = (float*)(p->ws + WS_Y);
    const int m = lane & 31, half = lane >> 5; const int chunk = (32 * ct + m) < NC16 ? (32 * ct + m) : NC16 - 1;
    const bf16* up = U + (size_t)(16 * chunk) * DM + 16 * g + 8 * half;
    const bf16* bp = BA + (size_t)(dir * 32 + g) * 32768 + (size_t)lane * 8;
    f32x16v acc[NTL];
#pragma unroll
    for (int nt = 0; nt < NTL; ++nt) acc[nt] = (f32x16v){};
#pragma unroll 8
    for (int ks = 0; ks < 16; ++ks) { const bf16x8v a = *(const bf16x8v*)(up + (size_t)ks * DM);
#pragma unroll
        for (int nt = 0; nt < NTL; ++nt) { const bf16x8v b = *(const bf16x8v*)(bp + (size_t)(((nt0 + nt) * 16 + ks) * 64) * 8);
            acc[nt] = __builtin_amdgcn_mfma_f32_32x32x16_bf16(a, b, acc[nt], 0, 0, 0); } }
#pragma unroll
    for (int nt = 0; nt < NTL; ++nt)
#pragma unroll
        for (int r = 0; r < 16; ++r) { const int ch = 32 * ct + crow16(r, half); if (ch < NC16) E[(size_t)((dir * NC16 + ch) * 32 + g) * 128 + 32 * (nt0 + nt) + m] = acc[nt][r]; }
}
__device__ __forceinline__ void s5_end_phase(KP p, int lane, int wave) {
    const int gw = blockIdx.x * 8 + wave, NGW = gridDim.x * 8;
    for (int unit = gw; unit < 32 * 64; unit += NGW) s5_end_unit<4>(p, unit >> 6, (unit >> 5) & 1, unit & 31, 0, lane);
    if (wave == 0) for (int tu = blockIdx.x; tu < 256; tu += gridDim.x) s5_end_unit<1>(p, 32, (tu >> 5) & 1, tu & 31, tu >> 6, lane);
}
__device__ __forceinline__ void s5_carry_phase(KP p, unsigned char* lds, int lane, int wave) {
    const float* E = (const float*)(p->ws + WS_Y); bf16* Hin = (bf16*)(p->ws + WS_H);
    float* seg = (float*)lds;
    for (int dg = blockIdx.x; dg < 64; dg += gridDim.x) {
        const int dir = dg >> 5, g = dg & 31;
        const f32x2 A16 = ((const f32x2*)(p->ws + WS_AP))[(dg * 17 + 16) * 64 + lane];
        float hr = 0.f, hi = 0.f;
        for (int jb = 0; jb < 130; jb += 26) { float er[26], ei[26];
#pragma unroll
            for (int q = 0; q < 26; ++q) { const int j = 130 * wave + jb + q, rc = dir == 0 ? j : (j < 16 ? 15 - j : 1055 - j); const float* ep = E + (size_t)((dir * NC16 + rc) * 32 + g) * 128; er[q] = ep[lane]; ei[q] = ep[64 + lane]; }
#pragma unroll
            for (int q = 0; q < 26; ++q) { const float nr = A16.x * hr - A16.y * hi + er[q], ni = A16.x * hi + A16.y * hr + ei[q]; hr = nr; hi = ni; } }
        seg[wave * 128 + lane] = hr; seg[wave * 128 + 64 + lane] = hi;
        float pr = 1.f, pi = 0.f;
        for (int q = 0; q < 130; ++q) { const float nr = pr * A16.x - pi * A16.y, ni = pr * A16.y + pi * A16.x; pr = nr; pi = ni; }
        __syncthreads();
        hr = 0.f; hi = 0.f;
        for (int w = 0; w < wave; ++w) { const float sr = seg[w * 128 + lane], si = seg[w * 128 + 64 + lane]; const float nr = pr * hr - pi * hi + sr, ni = pr * hi + pi * hr + si; hr = nr; hi = ni; }
        for (int jb = 0; jb < 130; jb += 26) { float er[26], ei[26];
#pragma unroll
            for (int q = 0; q < 26; ++q) { const int j = 130 * wave + jb + q, rc = dir == 0 ? j : (j < 16 ? 15 - j : 1055 - j); const float* ep = E + (size_t)((dir * NC16 + rc) * 32 + g) * 128; er[q] = ep[lane]; ei[q] = ep[64 + lane]; }
#pragma unroll
            for (int q = 0; q < 26; ++q) { const int j = 130 * wave + jb + q, rc = dir == 0 ? j : (j < 16 ? 15 - j : 1055 - j); bf16* hp = Hin + (size_t)(dg * NC16 + rc) * 128;
                hp[lane] = (bf16)f2bf(hr); hp[64 + lane] = (bf16)f2bf(hi);
                const float nr = A16.x * hr - A16.y * hi + er[q], ni = A16.x * hi + A16.y * hr + ei[q]; hr = nr; hi = ni; } }
        __syncthreads();
    }
}
template <int NTL> __device__ __forceinline__ void s5_out_unit(KP p, int ct, int g, int nt0, int lane) {
    const bf16* U = (const bf16*)(p->ws + WS_U); const bf16* KS = (const bf16*)(p->ws + WS_KS); const bf16* CA = (const bf16*)(p->ws + WS_CA);
    const bf16* Hin = (const bf16*)(p->ws + WS_H); bf16* G = (bf16*)(p->ws + WS_G);
    const int m = lane & 31, half = lane >> 5; const int chunk = (32 * ct + m) < NC16 ? (32 * ct + m) : NC16 - 1;
    const bf16* up = U + (size_t)(16 * chunk) * DM + 16 * g + 8 * half;
    const bf16* kp = KS + (size_t)g * 65536 + (size_t)lane * 8;
    f32x16v acc[NTL];
#pragma unroll
    for (int nt = 0; nt < NTL; ++nt) acc[nt] = (f32x16v){};
#pragma unroll 8
    for (int ks = 0; ks < 16; ++ks) { const bf16x8v a = *(const bf16x8v*)(up + (size_t)ks * DM);
#pragma unroll
        for (int nt = 0; nt < NTL; ++nt) { const bf16x8v b = *(const bf16x8v*)(kp + (size_t)(((nt0 + nt) * 16 + ks) * 64) * 8);
            acc[nt] = __builtin_amdgcn_mfma_f32_32x32x16_bf16(a, b, acc[nt], 0, 0, 0); } }
#pragma unroll 1
    for (int dir = 0; dir < 2; ++dir) { const int dg = dir * 32 + g; const bf16* hp = Hin + (size_t)(dg * NC16 + chunk) * 128 + 8 * half;
        const bf16* cp = CA + (size_t)dg * 32768 + (size_t)lane * 8;
#pragma unroll
        for (int ks = 0; ks < 8; ++ks) { const bf16x8v a = *(const bf16x8v*)(hp + 16 * ks);
#pragma unroll
            for (int nt = 0; nt < NTL; ++nt) { const bf16x8v b = *(const bf16x8v*)(cp + (size_t)(((nt0 + nt) * 8 + ks) * 64) * 8);
                acc[nt] = __builtin_amdgcn_mfma_f32_32x32x16_bf16(a, b, acc[nt], 0, 0, 0); } } }
#pragma unroll
    for (int nt = 0; nt < NTL; ++nt) { const int t = 2 * (nt0 + nt) + (m >> 4), c = m & 15;
#pragma unroll
        for (int r = 0; r < 16; ++r) { const int ch = 32 * ct + crow16(r, half); if (ch < NC16) G[(size_t)(16 * ch + t) * 512 + 16 * g + c] = (bf16)f2bf(gelu_tanh(acc[nt][r])); } }
}
__device__ __forceinline__ void s5_out_phase(KP p, int lane, int wave) {
    const int gw = blockIdx.x * 8 + wave, NGW = gridDim.x * 8;
    for (int unit = gw; unit < 32 * 64; unit += NGW) s5_out_unit<4>(p, unit >> 6, unit & 31, 4 * ((unit >> 5) & 1), lane);
    if (wave == 0) for (int tu = blockIdx.x; tu < 256; tu += gridDim.x) s5_out_unit<1>(p, 32, tu & 31, tu >> 5, lane);
}

__device__ __forceinline__ float row16_sum(float v) {
    v += __int_as_float(__builtin_amdgcn_update_dpp(0, __float_as_int(v), 0x128, 0xf, 0xf, false));
    v += __int_as_float(__builtin_amdgcn_update_dpp(0, __float_as_int(v), 0x124, 0xf, 0xf, false));
    v += __int_as_float(__builtin_amdgcn_update_dpp(0, __float_as_int(v), 0x122, 0xf, 0xf, false));
    v += __int_as_float(__builtin_amdgcn_update_dpp(0, __float_as_int(v), 0x121, 0xf, 0xf, false));
    return v;
}
__device__ __forceinline__ void qkv_post_phase(KP p, int lane, int wave) {
    const bf16* raw = (const bf16*)(p->ws + WS_QKV); bf16* Q = (bf16*)(p->ws + WS_Q); bf16* K = (bf16*)(p->ws + WS_K); bf16* V = (bf16*)(p->ws + WS_V);
    const float* R = (const float*)(p->ws + WS_ROPE);
    const int gw = blockIdx.x * 8 + wave, NGW = gridDim.x * 8;
    const int j = lane & 15, hq = lane >> 4;
    const f32x4 qn = ((const f32x4*)p->in[24])[j], kn = ((const f32x4*)p->in[25])[j];
    for (int r = gw; r < T; r += NGW) {
        const bool lat = r >= NCTX; const int tl = r - NCTX;
        const int pos = (j < 8) ? (tl >> 6) : (tl & 63);
        f32x4 cs0 = (f32x4){1.f, 0.f, 1.f, 0.f}, cs1 = cs0;
        if (lat) { const f32x4* rp = (const f32x4*)(R + (size_t)pos * 32 + 8 * (j & 3)); cs0 = rp[0]; cs1 = rp[1]; }
        const bool up = (j & 4) != 0;
        u32x2 wv[5];
#pragma unroll
        for (int pass = 0; pass < 5; ++pass) { const int col = pass < 4 ? (pass * 4 + hq) * 64 + 4 * j : 1024 + hq * 64 + 4 * j; wv[pass] = (lat || pass == 4) ? __builtin_nontemporal_load((const u32x2*)(raw + (size_t)r * NQKV + col)) : (u32x2){0u, 0u}; }
        const u32x2 vv = __builtin_nontemporal_load((const u32x2*)(raw + (size_t)r * NQKV + 1280 + 4 * lane));
#pragma unroll
        for (int pass = 0; pass < 5; ++pass) {
            if (!lat && pass < 4) continue;
            const u32x2 w = wv[pass];
            f32x4 x = (f32x4){bflo(w.x), bfhi(w.x), bflo(w.y), bfhi(w.y)};
            float ss = (x.x * x.x + x.y * x.y) + (x.z * x.z + x.w * x.w);
            ss = row16_sum(ss);
            const float rstd = rsqrtf(ss * (1.f / 64.f) + EPS);
            x = x * rstd * (pass < 4 ? qn : kn);
            if (lat) {
                f32x4 o; o.x = __shfl_xor(x.x, 4); o.y = __shfl_xor(x.y, 4); o.z = __shfl_xor(x.z, 4); o.w = __shfl_xor(x.w, 4);
                const float sg = up ? 1.f : -1.f;
                x.x = x.x * cs0.x + sg * o.x * cs0.y; x.y = x.y * cs0.z + sg * o.y * cs0.w; x.z = x.z * cs1.x + sg * o.z * cs1.y; x.w = x.w * cs1.z + sg * o.w * cs1.w;
            }
            if (pass < 4) { x = x * attn_body::C2; u32x2 o; o.x = pk2(x.x, x.y); o.y = pk2(x.z, x.w); *(u32x2*)(Q + (size_t)r * DM + (pass * 4 + hq) * 64 + 4 * j) = o; }
            else { u32x2 o; o.x = pk2(x.x, x.y); o.y = pk2(x.z, x.w); *(u32x2*)(K + (size_t)r * 256 + hq * 64 + 4 * j) = o; }
        }
        *(u32x2*)(V + (size_t)r * 256 + 4 * lane) = vv;
    }
}


template <int KIND> __device__ __forceinline__ void skinny_gemm(unsigned char* lds, const bf16* A, const bf16* Bt, int N, int K, bf16* O, int ldc, int tid, int lane, int wave) {
    const int nct = (KIND == 3 ? N / 2 : N) / 32, nunits = 8 * nct, m = lane & 31, half = lane >> 5, kw = K >> 3;
    float* red = (float*)lds;
    for (int u = blockIdx.x; u < nunits; u += gridDim.x) {
        const int rt = u & 7, ct = u >> 3;
        const int brow0 = (KIND == 3) ? 256 * (ct >> 2) + 32 * (ct & 3) : 32 * ct;
        const bf16* ap = A + (size_t)(32 * rt + m) * K + wave * kw + 8 * half;
        const bf16* bp = Bt + (size_t)(brow0 + m) * K + wave * kw + 8 * half;
        f32x16v acc0 = (f32x16v){}, acc1 = (f32x16v){};
#pragma unroll 4
        for (int ks = 0; ks < (kw >> 4); ++ks) { const bf16x8v a = *(const bf16x8v*)(ap + 16 * ks); const bf16x8v b0 = *(const bf16x8v*)(bp + 16 * ks);
            acc0 = __builtin_amdgcn_mfma_f32_32x32x16_bf16(a, b0, acc0, 0, 0, 0);
            if (KIND == 3) { const bf16x8v b1 = *(const bf16x8v*)(bp + (size_t)128 * K + 16 * ks); acc1 = __builtin_amdgcn_mfma_f32_32x32x16_bf16(a, b1, acc1, 0, 0, 0); } }
#pragma unroll
        for (int r = 0; r < 16; ++r) { red[(wave * 2) * 1024 + r * 64 + lane] = acc0[r]; if (KIND == 3) red[(wave * 2 + 1) * 1024 + r * 64 + lane] = acc1[r]; }
        __syncthreads();
        for (int e = tid; e < 1024; e += 512) { float s0 = 0.f, s1 = 0.f;
#pragma unroll
            for (int w = 0; w < 8; ++w) { s0 += red[(w * 2) * 1024 + e]; if (KIND == 3) s1 += red[(w * 2 + 1) * 1024 + e]; }
            const int r = e >> 6, ln = e & 63, row = 32 * rt + crow16(r, ln >> 5), col = 32 * ct + (ln & 31);
            float v = s0; if (KIND == 2) { v = v > 0.f ? v * v : 0.f; } if (KIND == 3) v = s0 / (1.f + __expf(-s1));
            O[(size_t)row * ldc + col] = (bf16)f2bf(v); }
        __syncthreads();
    }
}

#define GAS __attribute__((address_space(1)))
#define LAS __attribute__((address_space(3)))
typedef GAS unsigned gu32;
typedef GAS unsigned long long gu64;
#define RLX_AGENT __ATOMIC_RELAXED, __HIP_MEMORY_SCOPE_AGENT
#define LDS_WAIT() asm volatile("s_waitcnt lgkmcnt(0)" ::: "memory")
#define VM_WAIT() asm volatile("s_waitcnt vmcnt(0)" ::: "memory")
__device__ __forceinline__ unsigned long long rt() { return __builtin_amdgcn_s_memrealtime(); }
#define XB_TMO      128
#define XB_XCNT(j)  (256  + 64 * (j))
#define XB_XSUB(j)  (1280 + 64 * (j))
#define XB_XGEN(j)  (2304 + 64 * (j))
#define XB_TOP      3328
#define XB_TOPGEN   3392
#define XCD_BAR_WORDS 3456
#define XB_SPIN_CAP (1u << 18)

__device__ __forceinline__ unsigned xb_ld(unsigned* p)              { return __hip_atomic_load(p, __ATOMIC_RELAXED, __HIP_MEMORY_SCOPE_AGENT); }
__device__ __forceinline__ unsigned xb_add(unsigned* p, unsigned v) { return __hip_atomic_fetch_add(p, v, __ATOMIC_RELAXED, __HIP_MEMORY_SCOPE_AGENT); }
__device__ __forceinline__ unsigned xb_xcc_id() { return (unsigned)__builtin_amdgcn_s_getreg((3 << 11) | 20) & 0xFu; }
#define XB_SPIN(cond, bar) do { unsigned _sp = 0; while (cond) { __builtin_amdgcn_s_sleep(1); \
    if ((++_sp & 255u) == 0u) { if (xb_ld(&(bar)[XB_TMO])) break; if (_sp > XB_SPIN_CAP) { atomicAdd(&(bar)[XB_TMO], 1u); break; } } } } while (0)

struct XcdBarrier {
    unsigned* bar; unsigned x;
    volatile LAS unsigned* st;
};

__device__ __forceinline__ XcdBarrier xcd_barrier_post(unsigned* bar, volatile LAS unsigned* st) {
    XcdBarrier b; b.bar = bar; b.x = xb_xcc_id(); b.st = st;
    if (threadIdx.x == 0) (void)xb_add(&bar[XB_XCNT(b.x)], 1u);
    return b;
}
__device__ __forceinline__ void xcd_barrier_complete(unsigned* bar, unsigned x, unsigned& nloc, unsigned& nx) {
    const unsigned G = gridDim.x * gridDim.y * gridDim.z;
    unsigned sum, cnt, mine, sp = 0u;
    for (;;) {
        sum = 0u; cnt = 0u; mine = 0u;
#pragma unroll
        for (unsigned j = 0; j < 16; ++j) { const unsigned c = xb_ld(&bar[XB_XCNT(j)]); sum += c; cnt += (c > 0u) ? 1u : 0u; mine = (j == x) ? c : mine; }
        if (sum == G) break;
        __builtin_amdgcn_s_sleep(1);
        if ((++sp & 255u) == 0u) { if (xb_ld(&bar[XB_TMO])) break; if (sp > XB_SPIN_CAP) { atomicAdd(&bar[XB_TMO], 1u); break; } }
    }
    nloc = mine > 0u ? mine : 1u; nx = cnt > 0u ? cnt : 1u;
}

__device__ __forceinline__ void xcd_barrier(const XcdBarrier& b) {
    asm volatile("s_waitcnt vmcnt(0)" ::: "memory");
    __syncthreads();
    if (threadIdx.x == 0) {
        unsigned* bar = b.bar;
        __builtin_amdgcn_s_waitcnt(0);
        unsigned nloc = b.st[0], nx = b.st[1];
        if (nloc == 0u) { xcd_barrier_complete(bar, b.x, nloc, nx); b.st[0] = nloc; b.st[1] = nx; }
        const unsigned old = xb_add(&bar[XB_XSUB(b.x)], 1u);
        const unsigned gen = old / nloc;
        if (old + 1u == (gen + 1u) * nloc) {
            __builtin_amdgcn_fence(__ATOMIC_RELEASE, "agent");
            asm volatile("s_waitcnt vmcnt(0)" ::: "memory");
            const unsigned og = xb_add(&bar[XB_TOP], 1u);
            const unsigned tg = og / nx;
            if (og + 1u == (tg + 1u) * nx) xb_add(&bar[XB_TOPGEN], 1u);
            else XB_SPIN(xb_ld(&bar[XB_TOPGEN]) == tg, bar);
            __builtin_amdgcn_fence(__ATOMIC_ACQUIRE, "agent");
            xb_add(&bar[XB_XGEN(b.x)], 1u);
            asm volatile("s_waitcnt vmcnt(0)" ::: "memory");
        } else {
            XB_SPIN(xb_ld(&bar[XB_XGEN(b.x)]) == gen, bar);
            __builtin_amdgcn_fence(__ATOMIC_ACQUIRE, "agent");
            asm volatile("s_waitcnt vmcnt(0)" ::: "memory");
        }
    }
    __syncthreads();
}

template <class Epi> __device__ __forceinline__ void run_gemm(LAS3 unsigned char* lds3, const bf16* A, const bf16* Bt, int M, int N, int K, const Epi& E) {
    pg8::Gemm g{A, Bt, M, N, K}; pg8::StaticOrder S; S.init(M, N, (int)gridDim.x, (int)blockIdx.x);
    pg8::gemm_phase<Epi, pg8::StaticOrder, true, true>(lds3, g, S, E);
}
__device__ __forceinline__ void run_gemm_fused(LAS3 unsigned char* lds3, const bf16* A, const bf16* Bt, int K, const pg8::EpiRmsRes& E) {
    pg8::Gemm g{A, Bt, NLAT, 1024, K}; pg8::StaticOrder S; S.init(NLAT, 1024, (int)gridDim.x, (int)blockIdx.x);
    pg8::gemm_phase<pg8::EpiRmsRes, pg8::StaticOrder, false, true>(lds3, g, S, E);
}
constexpr int NSTEP = 20;
__global__ void __launch_bounds__(512, 2) mega_fwd(Params p_unused) {
    extern __shared__ __attribute__((aligned(16))) unsigned char lds[];
    cg::grid_group grid = cg::this_grid();
    const size_t LO = (size_t)NCTX;
    bool again = false; (void)again;
    if (threadIdx.x < 2) ((volatile LAS unsigned*)((LAS unsigned char*)lds + 143360))[threadIdx.x] = 0u;
    __syncthreads();
    {
        KP p0 = (KP)__builtin_amdgcn_kernarg_segment_ptr();
        if (p0->ws == nullptr) grid.sync();
        (void)xcd_barrier_post((unsigned*)(p0->ws + WS_BAR), (volatile LAS unsigned*)((LAS unsigned char*)lds + 143360));
    }
#pragma unroll 1
    for (int step = 0; step < NSTEP; ++step) {
        KP p = (KP)__builtin_amdgcn_kernarg_segment_ptr();
        asm volatile("" : "+s"(p));
        int tid_ = threadIdx.x; asm volatile("" : "+v"(tid_));
        const int tid = tid_, lane = tid & 63, wave = __builtin_amdgcn_readfirstlane(tid >> 6);
        unsigned char* ws = p->ws;
        const float* modv = (const float*)(ws + WS_MOD);
        const float* ng = p->in[6];
        bf16* H = (bf16*)(ws + WS_H); bf16* Y = (bf16*)(ws + WS_Y); bf16* HID = (bf16*)(ws + WS_BIG);
        float* XC = (float*)(ws + WS_XC);
        if (step == 0) prologue(p, lds, tid, lane, wave);
        else if (step == 3) s5_end_phase(p, lane, wave);
        else if (step == 4) {
            if (blockIdx.x < 64) s5_carry_phase(p, lds, lane, wave); else { pool_s5a_phase(p, lane, wave, 64, 192); s5_build(p, tid, 1, 64, 192); }
        }
        else if (step == 5) s5_out_phase(p, lane, wave);
        else if (step == 13) qkv_post_phase(p, lane, wave);
        else if (step == 14) {
            const attn_body::AttnTensors AT{(const attn_body::bf16*)(ws + WS_Q) + LO * DM, (const attn_body::bf16*)(ws + WS_K), (const attn_body::bf16*)(ws + WS_V), (attn_body::bf16*)(ws + WS_O) + LO * DM};
            const attn_body::StaticOrder S((int)gridDim.x, (int)blockIdx.x);
            attn_body::attn_phase<attn_body::StaticOrder>((char*)lds, AT, S);
        } else if (step == 1) {
            float* ml = (float*)lds; const float* MP = (const float*)(ws + WS_MODP); const float* bias = p->in[5];
            for (int i = tid; i < 4096; i += 512) { const int v = i >> 11, c = i & 2047; float sacc = bias[c];
#pragma unroll
                for (int q = 0; q < 8; ++q) sacc += MP[(size_t)(q * 2 + v) * 6144 + c];
                ml[v * 6144 + c] = sacc; }
            for (int i = blockIdx.x * 512 + tid; i < 24576; i += gridDim.x * 512) { const int l = i / 12288, v = (i / 6144) & 1, c = i % 6144; float sacc = bias[l * 6144 + c];
#pragma unroll
                for (int q = 0; q < 8; ++q) sacc += MP[(size_t)((l * 8 + q) * 2 + v) * 6144 + c];
                ((float*)(ws + WS_MOD))[(size_t)(l * 2 + v) * 6144 + c] = sacc; }
            __syncthreads();
            const RowP ra{p->in[0], p->in[2], p->out, nullptr, nullptr, ng, modv, ng + 0 * 1024, ml, H, 0, T, 0, 1};
            row_phase(ra, lane, wave); s5_build(p, tid, 0, 0, (int)gridDim.x);
        } else if (step == 8) {
            const RowP ra{p->out, p->in[2], p->out, XC, Y, ng + 1 * 1024, modv + 2048, ng + 2 * 1024, modv + 3072, H, 0, T, 1, 1};
            row_phase(ra, lane, wave);
        } else if (step == 11) {
            const RowP ra{p->out, XC, p->out, XC, Y, ng + 3 * 1024, modv + 5120, ng + 4 * 1024, modv + 2 * 6144 + 0, H, 0, T, 1, 1};
            row_phase(ra, lane, wave);
        } else if (step == 16) {
            const RowP ra{p->out, XC, p->out, XC, Y, ng + 5 * 1024, modv + 2 * 6144 + 2048, ng + 6 * 1024, modv + 2 * 6144 + 3072, H, NCTX, T, 1, 1};
            row_phase(ra, lane, wave);
        } else if (step == 19) {
            const RowP ra{p->out, XC, p->out, XC, Y, ng + 7 * 1024, modv + 2 * 6144 + 5120, ng, modv, nullptr, NCTX, T, 1, 0};
            row_phase(ra, lane, wave);
        } else {
            int gk = 0; const bf16* gA = H; const bf16* gB = nullptr; int gN = 1024, gK = 1024; bf16* gO = Y; int gld = 1024; bool ctx = true; int gM = NLAT; size_t lo = LO;
            switch (step) {
            case 2: gB = (const bf16*)(ws + WS_WIN); gO = (bf16*)(ws + WS_U); break;
            case 6: gk = 3; gA = (const bf16*)(ws + WS_G); gB = (const bf16*)(ws + WS_WGLU); gK = 512; gO = (bf16*)(ws + WS_Z); break;
            case 7: gA = (const bf16*)(ws + WS_Z); gB = (const bf16*)(ws + WS_WOUT); break;
            case 9: gk = 2; gB = (const bf16*)(ws + WS_W1_0); gN = 4096; gO = HID; gld = 4096; ctx = false; gM = T; lo = 0; break;
            case 10: gA = HID; gB = (const bf16*)(ws + WS_W2_0); gK = 4096; break;
            case 12: gB = (const bf16*)(ws + WS_WQKV); gN = NQKV; gO = (bf16*)(ws + WS_QKV); gld = NQKV; ctx = false; gM = T; lo = 0; break;
            case 15: gA = (const bf16*)(ws + WS_O); gB = (const bf16*)(ws + WS_WAO); ctx = false; break;
            case 17: gk = 2; gB = (const bf16*)(ws + WS_W1_1); gN = 4096; gO = HID; gld = 4096; ctx = false; break;
            default: gA = HID; gB = (const bf16*)(ws + WS_W2_1); gK = 4096; ctx = false; break;
            }
            const bf16* gAl = gA + lo * (size_t)gK; bf16* gOl = gO + lo * (size_t)gld;
            if (gk == 0) { if (ctx) skinny_gemm<0>(lds, gA, gB, gN, gK, gO, gld, tid, lane, wave); pg8::EpiBf16<0> E{gOl, gld}; run_gemm((LAS3 unsigned char*)lds, gAl, gB, gM, gN, gK, E); }
            else if (gk == 2) { if (ctx) skinny_gemm<2>(lds, gA, gB, gN, gK, gO, gld, tid, lane, wave); pg8::EpiBf16<2> E{gOl, gld}; run_gemm((LAS3 unsigned char*)lds, gAl, gB, gM, gN, gK, E); }
            else { skinny_gemm<3>(lds, gA, gB, gN, gK, gO, gld, tid, lane, wave); pg8::EpiGlu E{gOl, gld}; run_gemm((LAS3 unsigned char*)lds, gAl, gB, NLAT, gN, gK, E); }
        }
        if (step != NSTEP - 1) { XcdBarrier xb; xb.bar = (unsigned*)(p->ws + WS_BAR); xb.x = xb_xcc_id(); xb.st = (volatile LAS unsigned*)((LAS unsigned char*)lds + 143360); xcd_barrier(xb); }
#ifdef PROBE_MASK
        if (((PROBE_MASK >> step) & 1) && !again) { again = true; --step; } else again = false;
#endif
    }
}

extern "C" void kernel_launch(void* const* d_in, const int* in_sizes, int n_in, void* d_out, int out_size, void* d_ws, size_t ws_size, hipStream_t stream) {
    static int grid = 0;
    if (grid == 0) {
        if (n_in != 26 || out_size != NLAT * DM || ws_size < WS_END) { fprintf(stderr, "kernel_launch: unexpected shapes (n_in %d out %d ws %zu)\n", n_in, out_size, ws_size); grid = -1; return; }
        int dev = 0, cus = 0, per_cu = 0;
        (void)hipGetDevice(&dev); (void)hipDeviceGetAttribute(&cus, hipDeviceAttributeMultiprocessorCount, dev);
        if (hipFuncSetAttribute((const void*)mega_fwd, hipFuncAttributeMaxDynamicSharedMemorySize, LDS_TOTAL) != hipSuccess) { fprintf(stderr, "kernel_launch: hipFuncSetAttribute failed\n"); grid = -1; return; }
        if (hipOccupancyMaxActiveBlocksPerMultiprocessor(&per_cu, (const void*)mega_fwd, 512, LDS_TOTAL) != hipSuccess || per_cu < 1) { fprintf(stderr, "kernel_launch: occupancy query says %d\n", per_cu); per_cu = 1; (void)hipGetLastError(); }
        grid = cus * per_cu; if (grid > 256) grid = 256;
        if (grid != 256) { fprintf(stderr, "kernel_launch: this kernel needs a 256-workgroup cooperative grid (got %d)\n", grid); grid = -1; return; }
    }
    if (grid < 0) return;
    Params p{};
    for (int i = 0; i < 26; ++i) p.in[i] = (const float*)d_in[i];
    p.out = (float*)d_out; p.ws = (unsigned char*)d_ws;
    if (hipMemsetAsync((unsigned char*)d_ws + WS_BAR, 0, XCD_BAR_WORDS * 4, stream) != hipSuccess) { fprintf(stderr, "kernel_launch: hipMemsetAsync failed\n"); return; }
    void* args[] = {&p};
    hipError_t e = hipLaunchCooperativeKernel((const void*)mega_fwd, dim3(grid), dim3(512), args, LDS_TOTAL, stream);
    if (e != hipSuccess) fprintf(stderr, "cooperative launch failed: %s (grid %d)\n", hipGetErrorString(e), grid);
}
```
